# Optimizing an MI355X kernel written in HIP

```python
import jax, jax.numpy as jnp
from jax import lax
import numpy as np

D_MODEL = 1024
BATCH = 8
SEQ = 4096
DEPTH = 2

SB_HEAD_DIM = 64
SB_HEADS = D_MODEL // 128
SB_WIDTH = SB_HEADS * SB_HEAD_DIM
BLOCK_Q = 128
RET_HEADS = D_MODEL // 256
RET_QK_DIM = 128
RET_V_DIM = 2 * RET_QK_DIM
RET_QK_WIDTH = RET_HEADS * RET_QK_DIM
RET_V_WIDTH = RET_HEADS * RET_V_DIM
RET_CHUNK = 128
ROPE_BASE = 10000.0
SPLIT_SIZES = (SB_WIDTH, SB_WIDTH, SB_WIDTH,
               RET_QK_WIDTH, RET_QK_WIDTH, RET_V_WIDTH,
               RET_V_WIDTH,
               2 * D_MODEL)
IN_COLS = sum(SPLIT_SIZES)
SPLIT_POINTS = tuple(int(v) for v in np.cumsum(SPLIT_SIZES)[:-1])
D_FF = ((8 * D_MODEL // 3 + 127) // 128) * 128
CONV_WIDTH = 3
EPS = 1e-6

kernel_name = "hybrid_stickbreaking_retention_convffn"


def rms_norm(x, g):
    xf = x.astype(jnp.float32)
    y = xf * lax.rsqrt(jnp.mean(xf * xf, axis=-1, keepdims=True) + EPS)
    return (y * g.astype(jnp.float32)).astype(x.dtype)


def rotary(t, pos):
    half = t.shape[-1] // 2
    inv = ROPE_BASE ** (-jnp.arange(half, dtype=jnp.float32) / half)
    ang = pos[:, None] * inv[None, :]
    cos = jnp.cos(ang)[None, :, None, :]
    sin = jnp.sin(ang)[None, :, None, :]
    t = t.astype(jnp.float32)
    t1, t2 = t[..., :half], t[..., half:]
    return jnp.concatenate([t1 * cos - t2 * sin, t1 * sin + t2 * cos], axis=-1)


def stick_breaking_attention(q, k, v):
    S = q.shape[2]
    scale = q.shape[-1] ** -0.5
    outs = []
    for i in range(S // BLOCK_Q):
        end = (i + 1) * BLOCK_Q
        qs = q[:, :, i * BLOCK_Q:end]
        kk, vv = k[:, :, :end], v[:, :, :end]
        z = jnp.einsum('bhqd,bhkd->bhqk', qs, kk).astype(jnp.float32) * scale
        t_idx = i * BLOCK_Q + jnp.arange(BLOCK_Q)[:, None]
        s_idx = jnp.arange(end)[None, :]
        mask = s_idx < t_idx
        log_keep = jnp.where(mask, jax.nn.log_sigmoid(-z), 0.0)
        suffix = lax.cumsum(log_keep, axis=3, reverse=True) - log_keep
        a = jnp.where(mask, jnp.exp(jax.nn.log_sigmoid(z) + suffix), 0.0)
        outs.append(jnp.einsum('bhqk,bhkd->bhqd', a, vv.astype(jnp.float32)))
    return jnp.concatenate(outs, axis=2)


def retention_chunkwise(q, k, v, log_gamma):
    B, H, S, dk = q.shape
    dv = v.shape[-1]
    C = RET_CHUNK
    nC = S // C
    qc = q.reshape(B, H, nC, C, dk)
    kc = k.reshape(B, H, nC, C, dk)
    vc = v.reshape(B, H, nC, C, dv)
    pos = jnp.arange(C, dtype=jnp.float32)
    lg = log_gamma[:, None, None]
    diff = pos[:, None] - pos[None, :]
    decay = jnp.where(diff >= 0, jnp.exp(jnp.maximum(diff, 0.0) * lg), 0.0)
    scores = jnp.einsum('bhcnd,bhcmd->bhcnm', qc, kc) * decay[None, :, None]
    inner = jnp.einsum('bhcnm,bhcme->bhcne', scores, vc)
    zeta = jnp.exp((C - 1 - pos)[None, :] * log_gamma[:, None])
    xi = jnp.exp((pos + 1)[None, :] * log_gamma[:, None])
    chunk_decay = jnp.exp(C * log_gamma)[None, :, None, None]
    kv = jnp.einsum('bhcmd,bhcme->cbhde', kc * zeta[None, :, None, :, None], vc)

    def step(state, kv_c):
        return state * chunk_decay + kv_c, state

    _, prev_states = lax.scan(step, jnp.zeros((B, H, dk, dv), jnp.float32), kv)
    cross = jnp.einsum('bhcnd,cbhde->bhcne', qc, prev_states) * xi[None, :, None, :, None]
    return (inner + cross).reshape(B, H, S, dv)


def head_group_norm(o, g):
    mu = jnp.mean(o, axis=-1, keepdims=True)
    var = jnp.mean(jnp.square(o - mu), axis=-1, keepdims=True)
    y = (o - mu) * lax.rsqrt(var + EPS)
    B, S = o.shape[:2]
    return y.reshape(B, S, -1) * g.astype(jnp.float32)


def hybrid_mixer(x, norm_g, w_in, b_gate, sb_w_out, ret_norm_g, ret_w_out, w_o):
    B, S, _ = x.shape
    h = rms_norm(x, norm_g)
    proj = h @ w_in
    q_sb, k_sb, v_sb, q_r, k_r, v_r, g_r, gates = jnp.split(proj, SPLIT_POINTS, axis=-1)

    def heads(t, n):
        return t.reshape(B, S, n, -1).transpose(0, 2, 1, 3)

    o_sb = stick_breaking_attention(heads(q_sb, SB_HEADS), heads(k_sb, SB_HEADS), heads(v_sb, SB_HEADS))
    o_sb = o_sb.transpose(0, 2, 1, 3).reshape(B, S, SB_WIDTH).astype(x.dtype)
    y_a = o_sb @ sb_w_out

    pos = jnp.arange(S, dtype=jnp.float32)
    qr = rotary(q_r.reshape(B, S, RET_HEADS, RET_QK_DIM), pos).transpose(0, 2, 1, 3)
    kr = (rotary(k_r.reshape(B, S, RET_HEADS, RET_QK_DIM), pos) * RET_QK_DIM ** -0.5).transpose(0, 2, 1, 3)
    vr = heads(v_r, RET_HEADS).astype(jnp.float32)
    log_gamma = jnp.log1p(-jnp.exp2(-5.0 - jnp.arange(RET_HEADS, dtype=jnp.float32)))
    o_r = retention_chunkwise(qr, kr, vr, log_gamma).transpose(0, 2, 1, 3)
    o_r = head_group_norm(o_r, ret_norm_g) * jax.nn.silu(g_r.astype(jnp.float32))
    y_b = o_r.astype(x.dtype) @ ret_w_out

    gate = jax.nn.sigmoid((gates + b_gate).astype(jnp.float32))
    g_a, g_b = gate[..., :D_MODEL], gate[..., D_MODEL:]
    merged = (g_a * y_a.astype(jnp.float32) + g_b * y_b.astype(jnp.float32)).astype(x.dtype)
    return merged @ w_o


def conv_ffn(x, norm_g, w_up, conv_w, conv_b, w_down):
    h = rms_norm(x, norm_g)
    a, b = jnp.split(h @ w_up, 2, axis=-1)
    a = lax.conv_general_dilated(a, conv_w[:, None, :], window_strides=(1,),
                                 padding=[(CONV_WIDTH - 1, 0)],
                                 dimension_numbers=('NWC', 'WIO', 'NWC'),
                                 feature_group_count=D_FF) + conv_b
    return (jax.nn.silu(a) * b) @ w_down


def setup_inputs(seed: int = 0) -> dict:
    key = jax.random.key(seed)
    ks = jax.random.split(key, 16)
    f32 = jnp.float32

    def dense(k, shape, fan_in):
        return jax.random.normal(k, shape, f32) * fan_in ** -0.5

    def gain(k, shape):
        return 1.0 + 0.02 * jax.random.normal(k, shape, f32)

    return {
        "x": jax.random.normal(ks[0], (BATCH, SEQ, D_MODEL), f32),
        "attn_norm": gain(ks[1], (DEPTH, D_MODEL)),
        "w_in": dense(ks[2], (DEPTH, D_MODEL, IN_COLS), D_MODEL),
        "b_gate": 0.02 * jax.random.normal(ks[3], (DEPTH, 2 * D_MODEL), f32),
        "sb_w_out": dense(ks[4], (DEPTH, SB_WIDTH, D_MODEL), SB_WIDTH),
        "ret_norm": gain(ks[5], (DEPTH, RET_V_WIDTH)),
        "ret_w_out": dense(ks[6], (DEPTH, RET_V_WIDTH, D_MODEL), RET_V_WIDTH),
        "w_o": dense(ks[7], (DEPTH, D_MODEL, D_MODEL), D_MODEL),
        "ffn_norm": gain(ks[8], (DEPTH, D_MODEL)),
        "w_up": dense(ks[9], (DEPTH, D_MODEL, 2 * D_FF), D_MODEL),
        "conv_w": dense(ks[10], (DEPTH, CONV_WIDTH, D_FF), CONV_WIDTH),
        "conv_b": 0.02 * jax.random.normal(ks[11], (DEPTH, D_FF), f32),
        "w_down": dense(ks[12], (DEPTH, D_FF, D_MODEL), D_FF),
        "final_norm": gain(ks[13], (D_MODEL,)),
    }


def reference(x, attn_norm, w_in, b_gate, sb_w_out, ret_norm, ret_w_out, w_o,
              ffn_norm, w_up, conv_w, conv_b, w_down, final_norm):
    for l in range(DEPTH):
        x = x + hybrid_mixer(x, attn_norm[l], w_in[l], b_gate[l], sb_w_out[l],
                             ret_norm[l], ret_w_out[l], w_o[l]).astype(x.dtype)
        x = x + conv_ffn(x, ffn_norm[l], w_up[l], conv_w[l], conv_b[l], w_down[l]).astype(x.dtype)
    return rms_norm(x, final_norm)
```

```cpp
#include <hip/hip_runtime.h>
#include <hip/hip_cooperative_groups.h>
#include <cstdio>
#include <cstdint>
namespace cg = cooperative_groups;

#define LAS __attribute__((address_space(3)))
typedef unsigned short bf16_t;
typedef short bf16x8 __attribute__((ext_vector_type(8)));
typedef short s16x4 __attribute__((ext_vector_type(4)));
typedef float f32x2 __attribute__((ext_vector_type(2)));
typedef float f32x4 __attribute__((ext_vector_type(4)));
typedef float f32x16 __attribute__((ext_vector_type(16)));
typedef unsigned u32x4 __attribute__((ext_vector_type(4)));
typedef unsigned u32x2 __attribute__((ext_vector_type(2)));

constexpr int M = 32768, D = 1024, SEQ = 4096, FF = 2816;
constexpr int IN_COLS = 6656, PA_LD = 3584, PB_LD = 3072, U_LD = 5632;
constexpr float EPS = 1e-6f;
constexpr float LOG2E = 1.4426950408889634f;

constexpr size_t MiB = 1u << 20;
constexpr size_t WS_SSQ = 0;
constexpr size_t WS_ROPE = 1 * MiB;
constexpr size_t WS_WIN = 3 * MiB;
constexpr size_t WS_WCAT = 16 * MiB;
constexpr size_t WS_WO = 19 * MiB;
constexpr size_t WS_XN = 21 * MiB;
constexpr size_t WS_PROJ = 85 * MiB;
constexpr size_t WS_PB = WS_PROJ + 224 * MiB;
constexpr size_t WS_WUP = WS_PROJ + 352 * MiB;
constexpr size_t WS_WDN = WS_WUP + 11 * MiB;
constexpr size_t WS_END = WS_PROJ + 416 * MiB;

__device__ __forceinline__ unsigned pk_bf16(float lo, float hi) {
    typedef __bf16 b2 __attribute__((ext_vector_type(2))); f32x2 v = {lo, hi}; b2 b = __builtin_convertvector(v, b2); return __builtin_bit_cast(unsigned, b);
}
__device__ __forceinline__ float bf_lo(unsigned w) { return __uint_as_float(w << 16); }
__device__ __forceinline__ float bf_hi(unsigned w) { return __uint_as_float(w & 0xffff0000u); }
__device__ __forceinline__ float sigmoidf_(float x) { return __builtin_amdgcn_rcpf(1.f + __builtin_amdgcn_exp2f(-x * LOG2E)); }
__device__ __forceinline__ float wave_sum(float v) {
#pragma unroll
    for (int o = 1; o < 64; o <<= 1) v += __shfl_xor(v, o);
    return v;
}

namespace pg8 {
constexpr int BM = 256, BK = 64, HALF = 128, HTB = HALF * BK * 2, STAGE_BYTES = 8 * HTB, NXCD = 8, WGM = 8;
__host__ __device__ __forceinline__ int lds_byte(int r, int c) { const int st = (r >> 4) * 2 + (c >> 5), rr = r & 15, cc = c & 31, ob = rr * 64 + cc * 2; return st * 1024 + (ob ^ (((ob >> 9) & 1) << 5)); }
__host__ __device__ __forceinline__ void stage_rc(int b, int& R, int& C) { const int st = b / 1024, sb = b % 1024, swz = sb ^ (((sb >> 9) & 1) << 5); R = (st >> 1) * 16 + swz / 64; C = (st & 1) * 32 + (swz % 64) / 2; }
__host__ __device__ __forceinline__ int perm32(int rho) { const int n = rho >> 4, i = rho & 15; return 8 * (i >> 2) + 4 * n + (i & 3); }

struct Unit { int pm, pn; };
struct Gemm { const bf16_t* A; const bf16_t* Bt; int lda, ldb, M, N, K; };

struct StaticOrder {
    int nM, nN, nwg, G, c;
    __device__ void init(int M_, int N_, int G_, int c_) { nM = M_ / BM; nN = N_ / BM; nwg = nM * nN; G = G_; c = c_; }
    __device__ bool next(int i, Unit& u) const {
        const long L = (long)i * G + c; if (L >= nwg) return false;
        int wgid = (int)L; { const int q = nwg / NXCD, r = nwg % NXCD, xcd = wgid % NXCD, off = wgid / NXCD; wgid = (xcd < r ? xcd * (q + 1) : r * (q + 1) + (xcd - r) * q) + off; }
        const int nig = WGM * nN, gid = wgid / nig, fm = gid * WGM, gsz = (nM - fm) < WGM ? (nM - fm) : WGM;
        u.pm = fm + ((wgid % nig) % gsz); u.pn = (wgid % nig) / gsz; return true;
    }
};

template <class Epi>
__device__ __forceinline__ void gemm_phase(LAS unsigned char* lds, const Gemm g, const StaticOrder& S, const Epi& E) {
    int tid_ = threadIdx.x; asm volatile("" : "+v"(tid_));
    const int tid = tid_, wid = __builtin_amdgcn_readfirstlane(tid >> 6), lane = tid & 63, wr = wid >> 2, wc = wid & 3, fr = lane & 15, fq = lane >> 4;
    const int K = g.K, nt = K / BK;
    unsigned voffA[2], voffB[2];
#pragma unroll
    for (int i = 0; i < 2; ++i) { int R, C; stage_rc(tid * 16 + i * 8192, R, C); const int Rb = (R & ~31) + perm32(R & 31);
        voffA[i] = (unsigned)(R * g.lda + C) * 2u; voffB[i] = (unsigned)(Rb * g.ldb + C) * 2u; }
    const size_t kstep = (size_t)(BK * 2);
    const size_t hstepA = (size_t)HALF * g.lda * 2, hstepB = (size_t)HALF * g.ldb * 2;
    const size_t tstepA = 2 * hstepA, tstepB = 2 * hstepB;
    const unsigned ldsw = (unsigned)wid * 1024u;
    const int aoff = lds_byte(wr * 64 + fr, fq * 8), boff = lds_byte(wc * 32 + fr, fq * 8);
#define PG8_SA(b, h) (((b) * 2 + (h)) * HTB)
#define PG8_SB(b, h) ((4 + (b) * 2 + (h)) * HTB)
#define PG8_STAGE(bufoff, gbase, voff) do { _Pragma("unroll") for (int _i = 0; _i < 2; ++_i) \
        __builtin_amdgcn_global_load_lds((const unsigned*)((const char*)(gbase) + (voff)[_i]), (LAS unsigned*)(lds + (bufoff) + ldsw + _i * 8192), 16, 0, 0); } while (0)
#define PG8_LDA(dst, b, h) do { _Pragma("unroll") for (int m = 0; m < 4; ++m) _Pragma("unroll") for (int k = 0; k < 2; ++k) dst[m][k] = *(const LAS bf16x8*)(lds + PG8_SA(b, h) + aoff + m * 2048 + k * 1024); } while (0)
#define PG8_LDB(dst, b, h) do { _Pragma("unroll") for (int n = 0; n < 2; ++n) _Pragma("unroll") for (int k = 0; k < 2; ++k) dst[n][k] = *(const LAS bf16x8*)(lds + PG8_SB(b, h) + boff + n * 2048 + k * 1024); } while (0)
#define PG8_MMA(ai, bj, At, Bt) do { __builtin_amdgcn_s_setprio(1); _Pragma("unroll") for (int m = 0; m < 4; ++m) _Pragma("unroll") for (int n = 0; n < 2; ++n) _Pragma("unroll") for (int k = 0; k < 2; ++k) \
        acc[ai][bj][m][n] = __builtin_amdgcn_mfma_f32_16x16x32_bf16(Bt[n][k], At[m][k], acc[ai][bj][m][n], 0, 0, 0); __builtin_amdgcn_s_setprio(0); } while (0)
#define PG8_WAIT_V(n) asm volatile("s_waitcnt vmcnt(" #n ")" ::: "memory")
#define PG8_WAIT_L(n) asm volatile("s_waitcnt lgkmcnt(" #n ")" ::: "memory")
#define PG8_BAR __builtin_amdgcn_s_barrier()
#define PG8_SCHED __builtin_amdgcn_sched_barrier(0)
    Unit cur, nxt; int ui = 0;
    if (!S.next(0, cur)) return;
    f32x4 acc[2][2][4][2];
#pragma unroll
    for (int a = 0; a < 2; ++a)
#pragma unroll
        for (int b = 0; b < 2; ++b)
#pragma unroll
            for (int m = 0; m < 4; ++m)
#pragma unroll
                for (int n = 0; n < 2; ++n) acc[a][b][m][n] = (f32x4){0.f, 0.f, 0.f, 0.f};
    bf16x8 At[4][2], B0[2][2], B1[2][2];
    const char* cA = (const char*)g.A + (size_t)cur.pm * tstepA; const char* cB = (const char*)g.Bt + (size_t)cur.pn * tstepB;
    PG8_STAGE(PG8_SB(0, 0), cB, voffB); PG8_STAGE(PG8_SB(0, 1), cB + hstepB, voffB); PG8_STAGE(PG8_SA(0, 0), cA, voffA); PG8_STAGE(PG8_SA(0, 1), cA + hstepA, voffA);
    if (wr == 1) PG8_BAR;
    PG8_WAIT_V(2); PG8_BAR;
    PG8_STAGE(PG8_SB(1, 0), cB + kstep, voffB); PG8_STAGE(PG8_SA(1, 0), cA + kstep, voffA); PG8_STAGE(PG8_SB(1, 1), cB + hstepB + kstep, voffB);
    PG8_WAIT_V(6); PG8_BAR;
    for (;;) {
        const bool has_next = S.next(ui + 1, nxt);
        const char* nA = has_next ? (const char*)g.A + (size_t)nxt.pm * tstepA : cA; const char* nB = has_next ? (const char*)g.Bt + (size_t)nxt.pn * tstepB : cB;
        for (int t = 0; t < nt; t += 2) {
            const bool last = (t == nt - 2);
            const char* a1 = cA + (size_t)(t + 1) * kstep;
            const char* a2 = last ? nA : cA + (size_t)(t + 2) * kstep; const char* b2 = last ? nB : cB + (size_t)(t + 2) * kstep;
            const char* a3 = a2 + kstep; const char* b3 = b2 + kstep;
            PG8_LDB(B0, 0, 0); PG8_LDB(B1, 0, 1); PG8_SCHED; PG8_LDA(At, 0, 0); PG8_STAGE(PG8_SA(1, 1), a1 + hstepA, voffA);
            PG8_WAIT_V(8); PG8_WAIT_L(0); PG8_BAR; PG8_MMA(0, 0, At, B0); PG8_MMA(0, 1, At, B1); PG8_BAR; PG8_SCHED;
            PG8_LDA(At, 0, 1); PG8_STAGE(PG8_SB(0, 0), b2, voffB); PG8_STAGE(PG8_SB(0, 1), b2 + hstepB, voffB); PG8_STAGE(PG8_SA(0, 0), a2, voffA);
            PG8_WAIT_V(8); PG8_WAIT_L(0); PG8_BAR; PG8_MMA(1, 0, At, B0); PG8_MMA(1, 1, At, B1); PG8_BAR; PG8_SCHED;
            PG8_LDB(B0, 1, 0); PG8_LDB(B1, 1, 1); PG8_SCHED; PG8_LDA(At, 1, 0); PG8_STAGE(PG8_SA(0, 1), a2 + hstepA, voffA);
            PG8_WAIT_V(8); PG8_WAIT_L(0); PG8_BAR; PG8_MMA(0, 0, At, B0); PG8_MMA(0, 1, At, B1); PG8_BAR; PG8_SCHED;
            PG8_LDA(At, 1, 1); PG8_STAGE(PG8_SB(1, 0), b3, voffB); PG8_STAGE(PG8_SB(1, 1), b3 + hstepB, voffB); PG8_STAGE(PG8_SA(1, 0), a3, voffA);
            PG8_WAIT_V(8); PG8_WAIT_L(0); PG8_BAR; PG8_MMA(1, 0, At, B0); PG8_MMA(1, 1, At, B1); PG8_BAR; PG8_SCHED;
        }
        if (wr == 0) PG8_BAR;
        E(acc, cur, wr, wc, fr, fq);
        if (!has_next) break;
#pragma unroll
        for (int a = 0; a < 2; ++a)
#pragma unroll
            for (int b = 0; b < 2; ++b)
#pragma unroll
                for (int m = 0; m < 4; ++m)
#pragma unroll
                    for (int n = 0; n < 2; ++n) acc[a][b][m][n] = (f32x4){0.f, 0.f, 0.f, 0.f};
        cur = nxt; cA = nA; cB = nB; ++ui;
        if (wr == 1) PG8_BAR;
    }
    PG8_WAIT_V(0);
    PG8_BAR;
#undef PG8_SA
#undef PG8_SB
#undef PG8_STAGE
#undef PG8_LDA
#undef PG8_LDB
#undef PG8_MMA
#undef PG8_WAIT_V
#undef PG8_WAIT_L
#undef PG8_BAR
#undef PG8_SCHED
}
}

struct EpiP {
    const float* ssq;
    bf16_t* PA; bf16_t* PB;
    const f32x4* rope;
    const float* bgate;
    const float* xin; float* xout; bf16_t* XN; const float* gnext; float* ssq_out;
    bf16_t* U;
};
template <int MODE> struct Epi {
    EpiP p;
    __device__ __forceinline__ void operator()(const f32x4 (&acc)[2][2][4][2], const pg8::Unit& u, int wr, int wc, int fr, int fq) const {
        const int pn = u.pn;
        const int rowb = u.pm * 256 + wr * 64 + fr;
        const int colw = wc * 32 + 8 * fq;
        if constexpr (MODE == 1) {
            bf16_t* O; int ldc, cb;
            if (pn < 14) { O = p.PA; ldc = PA_LD; cb = pn * 256; } else { O = p.PB; ldc = PB_LD; cb = (pn - 14) * 256; }
            const int kind = (pn < 2) ? 1 : (pn >= 6 && pn < 8) ? 2 : (pn >= 8 && pn < 10) ? 3 : 0;
#pragma unroll
            for (int ai = 0; ai < 2; ++ai)
#pragma unroll
                for (int m = 0; m < 4; ++m) {
                    const int row = rowb + ai * 128 + m * 16;
                    float sc = __builtin_amdgcn_rsqf(p.ssq[row] * (1.f / 1024.f) + EPS);
                    if (kind == 1) sc *= 0.125f * LOG2E;
#pragma unroll
                    for (int bj = 0; bj < 2; ++bj) {
                        f32x4 v0 = acc[ai][bj][m][0] * sc, v1 = acc[ai][bj][m][1] * sc;
                        if (kind >= 2) {
                            const int head = (pn - (kind == 2 ? 6 : 8)) * 2 + bj;
                            const float lg = __builtin_log2f(1.f - __builtin_exp2f(-5.f - (float)head));
                            const float e = (float)((row & 127) + 1) * lg;
                            const float dsc = (kind == 2) ? __builtin_amdgcn_exp2f(e) * 0.08838834764831845f : __builtin_amdgcn_exp2f(-e);
                            const f32x4* rp = p.rope + ((size_t)(row & 4095) * 64 + wc * 16 + 4 * fq) / 2;
                            const f32x4 c01 = rp[0], c23 = rp[1];
                            f32x4 w0, w1;
                            w0[0] = (v0[0] * c01[0] - v0[1] * c01[1]) * dsc; w0[1] = (v0[0] * c01[1] + v0[1] * c01[0]) * dsc;
                            w0[2] = (v0[2] * c01[2] - v0[3] * c01[3]) * dsc; w0[3] = (v0[2] * c01[3] + v0[3] * c01[2]) * dsc;
                            w1[0] = (v1[0] * c23[0] - v1[1] * c23[1]) * dsc; w1[1] = (v1[0] * c23[1] + v1[1] * c23[0]) * dsc;
                            w1[2] = (v1[2] * c23[2] - v1[3] * c23[3]) * dsc; w1[3] = (v1[2] * c23[3] + v1[3] * c23[2]) * dsc;
                            v0 = w0; v1 = w1;
                        }
                        u32x4 w; w.x = pk_bf16(v0[0], v0[1]); w.y = pk_bf16(v0[2], v0[3]); w.z = pk_bf16(v1[0], v1[1]); w.w = pk_bf16(v1[2], v1[3]);
                        *(u32x4*)(O + (size_t)row * ldc + cb + bj * 128 + colw) = w;
                    }
                }
        } else if constexpr (MODE == 2 || MODE == 3) {
            const int goff = (MODE == 2) ? 1024 : 2048, boff = (MODE == 2) ? 0 : 1024;
            f32x4 bb[2][2];
#pragma unroll
            for (int bj = 0; bj < 2; ++bj) { const int col = pn * 256 + bj * 128 + colw; bb[bj][0] = *(const f32x4*)(p.bgate + boff + col); bb[bj][1] = *(const f32x4*)(p.bgate + boff + col + 4); }
#pragma unroll
            for (int ai = 0; ai < 2; ++ai)
#pragma unroll
                for (int m = 0; m < 4; ++m) {
                    const int row = rowb + ai * 128 + m * 16;
#pragma unroll
                    for (int bj = 0; bj < 2; ++bj) {
                        const int col = pn * 256 + bj * 128 + colw;
                        const u32x4 gw = *(const u32x4*)(p.PB + (size_t)row * PB_LD + goff + col);
                        f32x4 g0, g1;
                        g0[0] = bf_lo(gw.x); g0[1] = bf_hi(gw.x); g0[2] = bf_lo(gw.y); g0[3] = bf_hi(gw.y);
                        g1[0] = bf_lo(gw.z); g1[1] = bf_hi(gw.z); g1[2] = bf_lo(gw.w); g1[3] = bf_hi(gw.w);
                        g0 += bb[bj][0]; g1 += bb[bj][1];
                        f32x4 v0 = acc[ai][bj][m][0], v1 = acc[ai][bj][m][1];
#pragma unroll
                        for (int k = 0; k < 4; ++k) { v0[k] *= sigmoidf_(g0[k]); v1[k] *= sigmoidf_(g1[k]); }
                        if constexpr (MODE == 3) {
                            const u32x4 tw = *(const u32x4*)(p.PA + (size_t)row * PA_LD + 512 + col);
                            v0[0] += bf_lo(tw.x); v0[1] += bf_hi(tw.x); v0[2] += bf_lo(tw.y); v0[3] += bf_hi(tw.y);
                            v1[0] += bf_lo(tw.z); v1[1] += bf_hi(tw.z); v1[2] += bf_lo(tw.w); v1[3] += bf_hi(tw.w);
                        }
                        u32x4 w; w.x = pk_bf16(v0[0], v0[1]); w.y = pk_bf16(v0[2], v0[3]); w.z = pk_bf16(v1[0], v1[1]); w.w = pk_bf16(v1[2], v1[3]);
                        *(u32x4*)(p.PA + (size_t)row * PA_LD + (MODE == 2 ? 512 : 1536) + col) = w;
                    }
                }
        } else if constexpr (MODE == 4) {
            f32x4 gg[2][2];
#pragma unroll
            for (int bj = 0; bj < 2; ++bj) { const int col = pn * 256 + bj * 128 + colw; gg[bj][0] = *(const f32x4*)(p.gnext + col); gg[bj][1] = *(const f32x4*)(p.gnext + col + 4); }
#pragma unroll
            for (int ai = 0; ai < 2; ++ai)
#pragma unroll
                for (int m = 0; m < 4; ++m) {
                    const int row = rowb + ai * 128 + m * 16;
                    float ss = 0.f;
#pragma unroll
                    for (int bj = 0; bj < 2; ++bj) {
                        const int col = pn * 256 + bj * 128 + colw;
                        const size_t off = (size_t)row * D + col;
                        f32x4 x0 = *(const f32x4*)(p.xin + off), x1 = *(const f32x4*)(p.xin + off + 4);
                        x0 += acc[ai][bj][m][0]; x1 += acc[ai][bj][m][1];
                        *(f32x4*)(p.xout + off) = x0; *(f32x4*)(p.xout + off + 4) = x1;
                        ss += (x0[0] * x0[0] + x0[1] * x0[1]) + (x0[2] * x0[2] + x0[3] * x0[3]) + (x1[0] * x1[0] + x1[1] * x1[1]) + (x1[2] * x1[2] + x1[3] * x1[3]);
                        x0 *= gg[bj][0]; x1 *= gg[bj][1];
                        u32x4 w; w.x = pk_bf16(x0[0], x0[1]); w.y = pk_bf16(x0[2], x0[3]); w.z = pk_bf16(x1[0], x1[1]); w.w = pk_bf16(x1[2], x1[3]);
                        *(u32x4*)(p.XN + off) = w;
                    }
                    ss += __shfl_xor(ss, 16); ss += __shfl_xor(ss, 32);
                    if (fq == 0) unsafeAtomicAdd(p.ssq_out + row, ss);
                }
        } else {
#pragma unroll
            for (int ai = 0; ai < 2; ++ai)
#pragma unroll
                for (int m = 0; m < 4; ++m) {
                    const int row = rowb + ai * 128 + m * 16;
                    const float sc = __builtin_amdgcn_rsqf(p.ssq[row] * (1.f / 1024.f) + EPS);
#pragma unroll
                    for (int bj = 0; bj < 2; ++bj) {
                        const f32x4 v0 = acc[ai][bj][m][0] * sc, v1 = acc[ai][bj][m][1] * sc;
                        u32x4 w; w.x = pk_bf16(v0[0], v0[1]); w.y = pk_bf16(v0[2], v0[3]); w.z = pk_bf16(v1[0], v1[1]); w.w = pk_bf16(v1[2], v1[3]);
                        *(u32x4*)(p.U + (size_t)row * U_LD + pn * 256 + bj * 128 + colw) = w;
                    }
                }
        }
    }
};

namespace sb {
constexpr int PITCH = PA_LD, NW = 8, QB = 256, KVBLK = 64;
constexpr int NSLOT = 3, SLOTB = 8192;
constexpr int LDS_K = 0, LDS_V = NSLOT * SLOTB, LDS_OST = 2 * NSLOT * SLOTB, LDS_BYTES = LDS_OST + NW * 4096;
__device__ __forceinline__ void glds16(const void* gsrc, unsigned lds_dst) { unsigned keep;
    asm volatile("s_mov_b32 %0, m0\n\ts_mov_b32 m0, %2\n\ts_nop 0\n\tglobal_load_lds_dwordx4 %1, off\n\ts_mov_b32 m0, %0" : "=&s"(keep) : "v"(gsrc), "s"(lds_dst) : "memory"); }
__device__ __forceinline__ int crow(int r, int hi) { return (r & 3) + 8 * (r >> 2) + 4 * hi; }
typedef short v4i16_t __attribute__((ext_vector_type(4)));
__device__ __forceinline__ s16x4 vtr(const LAS char* p) { return __builtin_bit_cast(s16x4, __builtin_amdgcn_ds_read_tr16_b64_v4i16((LAS v4i16_t*)p)); }

__device__ __forceinline__ void unit(int b, int h, int qb, bf16_t* PA, LAS char* shm) {
    int tid_ = threadIdx.x; asm volatile("" : "+v"(tid_));
    const int tid = tid_, lane = tid & 63, r32 = lane & 31, hi = lane >> 5; const int wid = __builtin_amdgcn_readfirstlane(tid >> 6);
    const long rowbase = (long)b * SEQ; const int q0 = qb * QB;
    const bf16_t* Qw = PA + (rowbase + q0 + wid * 32) * PITCH + h * 64;
    const bf16_t* Kh = PA + rowbase * PITCH + 512 + h * 64;
    const bf16_t* Vh = PA + rowbase * PITCH + 1024 + h * 64;
    const unsigned lds0 = (unsigned)(uintptr_t)shm;
    const int kperm = ((lane >> 2) & 1) * 32 + (lane >> 5) * 16 + ((lane & 31) >> 3) * 4 + (lane & 3);
    const bf16_t* ksrc = Kh + (long)kperm * PITCH + wid * 8;
    const bf16_t* vsrc = Vh + (long)(16 * (wid & 3) + (lane >> 2)) * PITCH + (wid >> 2) * 32 + (lane & 3) * 8;
    const unsigned kdst = lds0 + LDS_K + wid * 1024, vdst = lds0 + LDS_V + wid * 1024;
#define DMA_KV(t, slot) do { glds16(ksrc + (long)(t) * KVBLK * PITCH, (unsigned)__builtin_amdgcn_readfirstlane(kdst + (slot))); \
                             glds16(vsrc + (long)(t) * KVBLK * PITCH, (unsigned)__builtin_amdgcn_readfirstlane(vdst + (slot))); } while (0)
    const int NT = (q0 + QB) / KVBLK;
    bf16x8 qr[4];
#pragma unroll
    for (int d0 = 0; d0 < 4; ++d0) qr[d0] = *reinterpret_cast<const bf16x8*>(&Qw[(long)r32 * PITCH + d0 * 16 + hi * 8]);
    DMA_KV(NT - 1, 0); DMA_KV(NT - 2, SLOTB);
    f32x16 o[2]; o[0] = f32x16{}; o[1] = f32x16{};
    float carry = 1.f;
    const int qrel = wid * 32 + r32;
    const LAS char* kp0 = shm + LDS_K + hi * 1024 + r32 * 16;
    const LAS char* vp0 = shm + LDS_V + (32 * hi + ((lane & 15) >> 2)) * 64 + ((lane >> 4) & 1) * 32 + (lane & 3) * 8;
    int slot = 0, slot2 = 2 * SLOTB;
    for (int t = NT - 1; t >= 0; --t) {
        if (t >= 1) asm volatile("s_waitcnt vmcnt(2) lgkmcnt(0)\n\ts_barrier" ::: "memory");
        else        asm volatile("s_waitcnt vmcnt(0) lgkmcnt(0)\n\ts_barrier" ::: "memory");
        if (t >= 2) DMA_KV(t - 2, slot2);
        const int jb = t - (NT - 4);
        if (jb <= (wid >> 1)) {
            f32x16 p0 = f32x16{}, p1 = f32x16{};
            const LAS char* kb = kp0 + slot;
#pragma unroll
            for (int d0 = 0; d0 < 4; ++d0) {
                const bf16x8 b0 = *(const LAS bf16x8*)(kb + d0 * 2048);
                const bf16x8 b1 = *(const LAS bf16x8*)(kb + d0 * 2048 + 512);
                p0 = __builtin_amdgcn_mfma_f32_32x32x16_bf16(b0, qr[d0], p0, 0, 0, 0);
                p1 = __builtin_amdgcn_mfma_f32_32x32x16_bf16(b1, qr[d0], p1, 0, 0, 0);
            }
#pragma unroll
            for (int r = 0; r < 16; ++r) { p0[r] = __builtin_amdgcn_rcpf(1.f + __builtin_amdgcn_exp2f(p0[r])); p1[r] = __builtin_amdgcn_rcpf(1.f + __builtin_amdgcn_exp2f(p1[r])); }
            if (jb == (wid >> 1)) {
                const int kb0 = 64 * jb + 32 * hi;
#pragma unroll
                for (int r = 0; r < 16; ++r) { if (kb0 + r >= qrel) p0[r] = 1.f; if (kb0 + 16 + r >= qrel) p1[r] = 1.f; }
            }
            float T = 1.f;
#pragma unroll
            for (int r = 15; r >= 0; --r) { const float Tn = T * p1[r]; p1[r] = T - Tn; T = Tn; }
#pragma unroll
            for (int r = 15; r >= 0; --r) { const float Tn = T * p0[r]; p0[r] = T - Tn; T = Tn; }
            const float Tp = __shfl_xor(T, 32);
            const float base = carry * (hi == 0 ? Tp : 1.f);
            carry = carry * T * Tp;
#pragma unroll
            for (int r = 0; r < 16; ++r) { p0[r] *= base; p1[r] *= base; }
            u32x4 pw0, pw1, pw2, pw3;
            pw0 = (u32x4){pk_bf16(p0[0], p0[1]), pk_bf16(p0[2], p0[3]), pk_bf16(p0[4], p0[5]), pk_bf16(p0[6], p0[7])};
            pw1 = (u32x4){pk_bf16(p0[8], p0[9]), pk_bf16(p0[10], p0[11]), pk_bf16(p0[12], p0[13]), pk_bf16(p0[14], p0[15])};
            pw2 = (u32x4){pk_bf16(p1[0], p1[1]), pk_bf16(p1[2], p1[3]), pk_bf16(p1[4], p1[5]), pk_bf16(p1[6], p1[7])};
            pw3 = (u32x4){pk_bf16(p1[8], p1[9]), pk_bf16(p1[10], p1[11]), pk_bf16(p1[12], p1[13]), pk_bf16(p1[14], p1[15])};
            const LAS char* vb = vp0 + slot;
#pragma unroll
            for (int d0 = 0; d0 < 2; ++d0) {
                s16x4 lo[4], hh[4];
#pragma unroll
                for (int ks = 0; ks < 4; ++ks) { lo[ks] = vtr(vb + d0 * 4096 + ks * 512); hh[ks] = vtr(vb + d0 * 4096 + ks * 512 + 256); }
#define PKV(k) (bf16x8){lo[k][0], lo[k][1], lo[k][2], lo[k][3], hh[k][0], hh[k][1], hh[k][2], hh[k][3]}
                o[d0] = __builtin_amdgcn_mfma_f32_32x32x16_bf16(__builtin_bit_cast(bf16x8, pw0), PKV(0), o[d0], 0, 0, 0);
                o[d0] = __builtin_amdgcn_mfma_f32_32x32x16_bf16(__builtin_bit_cast(bf16x8, pw1), PKV(1), o[d0], 0, 0, 0);
                o[d0] = __builtin_amdgcn_mfma_f32_32x32x16_bf16(__builtin_bit_cast(bf16x8, pw2), PKV(2), o[d0], 0, 0, 0);
                o[d0] = __builtin_amdgcn_mfma_f32_32x32x16_bf16(__builtin_bit_cast(bf16x8, pw3), PKV(3), o[d0], 0, 0, 0);
#undef PKV
            }
        }
        slot2 = slot; slot = (slot == (NSLOT - 1) * SLOTB) ? 0 : slot + SLOTB;
    }
    bf16_t* Ow = PA + (rowbase + q0 + wid * 32) * PITCH + h * 64;
    {
        LAS bf16_t* stg = (LAS bf16_t*)(shm + LDS_OST) + wid * 2048;
#pragma unroll
        for (int r = 0; r < 16; ++r) { const int orow = crow(r, hi);
#pragma unroll
            for (int d0 = 0; d0 < 2; ++d0) stg[orow * 64 + d0 * 32 + r32] = (bf16_t)(pk_bf16(o[d0][r], 0.f) & 0xffffu); }
        asm volatile("s_waitcnt lgkmcnt(0)" ::: "memory");
#pragma unroll
        for (int i = 0; i < 4; ++i) { const int row = i * 8 + (lane >> 3), ch = lane & 7; const u32x4 v = *(const LAS u32x4*)(stg + row * 64 + ch * 8); *(u32x4*)(Ow + (long)row * PITCH + ch * 8) = v; }
    }
    asm volatile("s_waitcnt vmcnt(0) lgkmcnt(0)\n\ts_barrier" ::: "memory");
#undef DMA_KV
}
}

namespace ret {
constexpr int RS = 272;
constexpr int L_Q = 0, L_K = 128 * RS, L_P = 2 * 128 * RS, L_V = 3 * 128 * RS, L_S = L_V + 128 * 64, LDS_BYTES = L_S + 2 * 32 * RS;
typedef short v4i16_t __attribute__((ext_vector_type(4)));
__device__ __forceinline__ s16x4 vtr(const LAS char* p) { return __builtin_bit_cast(s16x4, __builtin_amdgcn_ds_read_tr16_b64_v4i16((LAS v4i16_t*)p)); }
__device__ __forceinline__ bf16x8 cat(s16x4 a, s16x4 b) { return (bf16x8){a[0], a[1], a[2], a[3], b[0], b[1], b[2], b[3]}; }

__device__ __forceinline__ void item(int b, int h, int sl, bf16_t* PA, LAS char* shm) {
    int tid_ = threadIdx.x; asm volatile("" : "+v"(tid_));
    const int tid = tid_, lane = tid & 63, fr = lane & 15, fq = lane >> 4; const int wid = __builtin_amdgcn_readfirstlane(tid >> 6);
    const size_t rowbase = (size_t)b * SEQ;
    const bf16_t* Qg = PA + rowbase * PA_LD + 1536 + h * 128;
    const bf16_t* Kg = PA + rowbase * PA_LD + 2048 + h * 128;
    bf16_t* Vg = PA + rowbase * PA_LD + 2560 + h * 256 + sl * 32;
    const float lg = __builtin_log2f(1.f - __builtin_exp2f(-5.f - (float)h));
    const float gam128 = __builtin_exp2f(128.f * lg);
    for (int i = tid; i < 32 * RS / 4; i += 512) ((LAS unsigned*)(shm + L_S))[i] = 0u;
    u32x4 qreg[4], kreg[4], vreg;
#define RET_LOAD(c) do { _Pragma("unroll") for (int i = 0; i < 4; ++i) { const int id = tid + 512 * i, row = id >> 4, ch = id & 15; \
            qreg[i] = *(const u32x4*)(Qg + (size_t)((c) * 128 + row) * PA_LD + ch * 8); kreg[i] = *(const u32x4*)(Kg + (size_t)((c) * 128 + row) * PA_LD + ch * 8); } \
        vreg = *(const u32x4*)(Vg + (size_t)((c) * 128 + (tid >> 2)) * PA_LD + (tid & 3) * 8); } while (0)
    RET_LOAD(0);
    f32x4 st[2]; st[0] = (f32x4){0.f, 0.f, 0.f, 0.f}; st[1] = st[0];
    for (int c = 0; c < 32; ++c) {
#pragma unroll
        for (int i = 0; i < 4; ++i) { const int id = tid + 512 * i, row = id >> 4, ch = id & 15;
            *(LAS u32x4*)(shm + L_Q + row * RS + ch * 16) = qreg[i]; *(LAS u32x4*)(shm + L_K + row * RS + ch * 16) = kreg[i]; }
        *(LAS u32x4*)(shm + L_V + (tid >> 2) * 64 + (tid & 3) * 16) = vreg;
        __syncthreads();
        if (c + 1 < 32) RET_LOAD(c + 1);
        const LAS char* Scur = shm + L_S + (c & 1) * 32 * RS; LAS char* Snxt = shm + L_S + ((c + 1) & 1) * 32 * RS;
        {
            bf16x8 bq[4];
#pragma unroll
            for (int ks = 0; ks < 4; ++ks) bq[ks] = *(const LAS bf16x8*)(shm + L_Q + (16 * wid + fr) * RS + (ks * 32 + 8 * fq) * 2);
            const int n = 16 * wid + fr;
#pragma unroll
            for (int mb = 0; mb < 8; ++mb) {
                f32x4 a4 = (f32x4){0.f, 0.f, 0.f, 0.f};
#pragma unroll
                for (int ks = 0; ks < 4; ++ks) { const bf16x8 ak = *(const LAS bf16x8*)(shm + L_K + (16 * mb + fr) * RS + (ks * 32 + 8 * fq) * 2);
                    a4 = __builtin_amdgcn_mfma_f32_16x16x32_bf16(ak, bq[ks], a4, 0, 0, 0); }
                const int m0 = 16 * mb + 4 * fq;
#pragma unroll
                for (int k = 0; k < 4; ++k) if (m0 + k > n) a4[k] = 0.f;
                u32x2 w; w.x = pk_bf16(a4[0], a4[1]); w.y = pk_bf16(a4[2], a4[3]);
                *(LAS u32x2*)(shm + L_P + n * RS + m0 * 2) = w;
            }
        }
        {
            f32x4 kv[2]; kv[0] = (f32x4){0.f, 0.f, 0.f, 0.f}; kv[1] = kv[0];
#pragma unroll
            for (int ks = 0; ks < 4; ++ks) {
                const int r0 = 32 * ks + 8 * fq + (fr >> 2);
                const LAS char* ka = shm + L_K + r0 * RS + (16 * wid + 4 * (fr & 3)) * 2;
                const bf16x8 af = cat(vtr(ka), vtr(ka + 4 * RS));
#pragma unroll
                for (int eb = 0; eb < 2; ++eb) {
                    const LAS char* va = shm + L_V + r0 * 64 + (16 * eb + 4 * (fr & 3)) * 2;
                    const bf16x8 bfv = cat(vtr(va), vtr(va + 4 * 64));
                    kv[eb] = __builtin_amdgcn_mfma_f32_16x16x32_bf16(af, bfv, kv[eb], 0, 0, 0);
                }
            }
#pragma unroll
            for (int eb = 0; eb < 2; ++eb) {
                st[eb] = (st[eb] + kv[eb]) * gam128;
                u32x2 w; w.x = pk_bf16(st[eb][0], st[eb][1]); w.y = pk_bf16(st[eb][2], st[eb][3]);
                *(LAS u32x2*)(Snxt + (16 * eb + fr) * RS + (16 * wid + 4 * fq) * 2) = w;
            }
        }
        __syncthreads();
        {
            f32x4 oa[2]; oa[0] = (f32x4){0.f, 0.f, 0.f, 0.f}; oa[1] = oa[0];
#pragma unroll
            for (int ks = 0; ks < 4; ++ks) {
                const bf16x8 bp = *(const LAS bf16x8*)(shm + L_P + (16 * wid + fr) * RS + (ks * 32 + 8 * fq) * 2);
                const bf16x8 bq = *(const LAS bf16x8*)(shm + L_Q + (16 * wid + fr) * RS + (ks * 32 + 8 * fq) * 2);
                const int r0 = 32 * ks + 8 * fq + (fr >> 2);
#pragma unroll
                for (int eb = 0; eb < 2; ++eb) {
                    const LAS char* va = shm + L_V + r0 * 64 + (16 * eb + 4 * (fr & 3)) * 2;
                    const bf16x8 av = cat(vtr(va), vtr(va + 4 * 64));
                    oa[eb] = __builtin_amdgcn_mfma_f32_16x16x32_bf16(av, bp, oa[eb], 0, 0, 0);
                    const bf16x8 as = *(const LAS bf16x8*)(Scur + (16 * eb + fr) * RS + (ks * 32 + 8 * fq) * 2);
                    oa[eb] = __builtin_amdgcn_mfma_f32_16x16x32_bf16(as, bq, oa[eb], 0, 0, 0);
                }
            }
#pragma unroll
            for (int eb = 0; eb < 2; ++eb) {
                u32x2 w; w.x = pk_bf16(oa[eb][0], oa[eb][1]); w.y = pk_bf16(oa[eb][2], oa[eb][3]);
                *(u32x2*)(Vg + (size_t)(c * 128 + 16 * wid + fr) * PA_LD + 16 * eb + 4 * fq) = w;
            }
        }
        __syncthreads();
    }
#undef RET_LOAD
}
}

struct Args { const float* in[14]; float* out; unsigned char* ws; };

__device__ __forceinline__ int rope_prow(int n) { if (n >= 1536 && n < 2560) { const int j = (n - 1536) & 127, base = n - j; return base + (j < 64 ? 2 * j : 2 * (j - 64) + 1); } return n; }
__device__ __forceinline__ void transpose_item(const float* W, int K, int N, bf16_t* WT, int ldt, int koff, bool perm, LAS float* scr, int item, int lane) {
    const int nblk = N / 32, kb = item / nblk, nb = item % nblk, k0 = 64 * kb, n0 = 32 * nb;
#pragma unroll 8
    for (int i = 0; i < 32; ++i) { const int kk = 2 * i + (lane >> 5); scr[kk * 33 + (lane & 31)] = W[(size_t)(k0 + kk) * N + n0 + (lane & 31)]; }
    asm volatile("s_waitcnt lgkmcnt(0)" ::: "memory");
    const int c = lane & 7;
#pragma unroll
    for (int j = 0; j < 4; ++j) { const int n = (lane >> 3) + 8 * j; const LAS float* s = scr + (8 * c) * 33 + n;
        u32x4 o; o.x = pk_bf16(s[0 * 33], s[1 * 33]); o.y = pk_bf16(s[2 * 33], s[3 * 33]); o.z = pk_bf16(s[4 * 33], s[5 * 33]); o.w = pk_bf16(s[6 * 33], s[7 * 33]);
        const int dr = perm ? rope_prow(n0 + n) : (n0 + n);
        *(u32x4*)(WT + (size_t)dr * ldt + koff + k0 + 8 * c) = o; }
    asm volatile("s_waitcnt lgkmcnt(0)" ::: "memory");
}
__device__ __forceinline__ void convert_mixer(const Args& a, int l, LAS unsigned char* lds, int gw, int NGW, int wave, int lane) {
    LAS float* scr = (LAS float*)(lds + wave * 16384);
    bf16_t* win = (bf16_t*)(a.ws + WS_WIN); bf16_t* wcat = (bf16_t*)(a.ws + WS_WCAT); bf16_t* wo = (bf16_t*)(a.ws + WS_WO);
    const float* w_in = a.in[2] + (size_t)l * D * IN_COLS; const float* sbw = a.in[4] + (size_t)l * 512 * D;
    const float* rw = a.in[6] + (size_t)l * D * D; const float* w_o = a.in[7] + (size_t)l * D * D;
    constexpr int I0 = (D / 64) * (IN_COLS / 32), I1 = (512 / 64) * (D / 32), I2 = (D / 64) * (D / 32), I3 = I2;
    for (int it = gw; it < I0 + I1 + I2 + I3; it += NGW) {
        int r = it;
        if (r < I0) { transpose_item(w_in, D, IN_COLS, win, D, 0, true, scr, r, lane); continue; } r -= I0;
        if (r < I1) { transpose_item(sbw, 512, D, wcat, 1536, 0, false, scr, r, lane); continue; } r -= I1;
        if (r < I2) { transpose_item(rw, D, D, wcat, 1536, 512, false, scr, r, lane); continue; } r -= I2;
        transpose_item(w_o, D, D, wo, D, 0, false, scr, r, lane);
    }
}
__device__ __forceinline__ void convert_ffn(const Args& a, int l, LAS unsigned char* lds, int gw, int NGW, int wave, int lane) {
    LAS float* scr = (LAS float*)(lds + wave * 16384);
    bf16_t* wup = (bf16_t*)(a.ws + WS_WUP); bf16_t* wdn = (bf16_t*)(a.ws + WS_WDN);
    const float* w_up = a.in[9] + (size_t)l * D * U_LD; const float* w_dn = a.in[12] + (size_t)l * FF * D;
    constexpr int I0 = (D / 64) * (U_LD / 32), I1 = (FF / 64) * (D / 32);
    for (int it = gw; it < I0 + I1; it += NGW) {
        int r = it;
        if (r < I0) { transpose_item(w_up, D, U_LD, wup, D, 0, false, scr, r, lane); continue; } r -= I0;
        transpose_item(w_dn, FF, D, wdn, FF, 0, false, scr, r, lane);
    }
}

__global__ void __launch_bounds__(512, 2) fwd_kernel(Args a) {
    extern __shared__ __attribute__((aligned(16))) unsigned char lds_raw[];
    LAS unsigned char* lds = (LAS unsigned char*)lds_raw;
    cg::grid_group grid = cg::this_grid();
    const int G = gridDim.x, bx = blockIdx.x;
    const int vcu = (G % 8 == 0) ? (bx % 8) * (G / 8) + bx / 8 : bx;
    const int NGW = G * 8, NGT = G * 512;
#define PHASE_IDS() int tid_ = threadIdx.x; asm volatile("" : "+v"(tid_)); const int tid = tid_, lane = tid & 63, wave = __builtin_amdgcn_readfirstlane(tid >> 6); \
    const int gw = vcu * 8 + wave, gtid = bx * 512 + tid; (void)gw; (void)gtid; (void)lane;
    unsigned char* ws = a.ws;
    float* ssq = (float*)(ws + WS_SSQ);
    f32x4* rope = (f32x4*)(ws + WS_ROPE);
    bf16_t* win = (bf16_t*)(ws + WS_WIN); bf16_t* wcat = (bf16_t*)(ws + WS_WCAT); bf16_t* wo = (bf16_t*)(ws + WS_WO);
    bf16_t* XN = (bf16_t*)(ws + WS_XN); bf16_t* PA = (bf16_t*)(ws + WS_PROJ); bf16_t* PB = (bf16_t*)(ws + WS_PB); bf16_t* U = (bf16_t*)(ws + WS_PROJ);
    bf16_t* wup = (bf16_t*)(ws + WS_WUP); bf16_t* wdn = (bf16_t*)(ws + WS_WDN);
    const float* x = a.in[0]; float* out = a.out;

    {
    PHASE_IDS();
    convert_mixer(a, 0, lds, gw, NGW, wave, lane);
    for (int i = gtid; i < 4096 * 64; i += NGT) {
        const int pos = i >> 6, k = i & 63;
        const float inv = __builtin_exp2f(-(float)k * (13.287712379549449f / 64.f));
        const double ang = (double)((float)pos * inv);
        double rev = ang * 0.15915494309189535; rev -= __builtin_rint(rev);
        f32x2 cs; cs.x = __builtin_amdgcn_cosf((float)rev); cs.y = __builtin_amdgcn_sinf((float)rev);
        ((f32x2*)rope)[i] = cs;
    }
    for (int i = gtid; i < 4 * M; i += NGT) ssq[M + i] = 0.f;
    {
        const float* g0 = a.in[1];
        for (int m = gw; m < M; m += NGW) {
            const f32x4* xr = (const f32x4*)(x + (size_t)m * D) + lane; const f32x4* gr = (const f32x4*)g0 + lane;
            f32x4 v[4]; float s = 0.f;
#pragma unroll
            for (int j = 0; j < 4; ++j) { v[j] = xr[64 * j]; s += (v[j][0] * v[j][0] + v[j][1] * v[j][1]) + (v[j][2] * v[j][2] + v[j][3] * v[j][3]); }
            s = wave_sum(s);
            if (lane == 0) ssq[m] = s;
            u32x2* o8 = (u32x2*)(XN + (size_t)m * D) + lane;
#pragma unroll
            for (int j = 0; j < 4; ++j) { const f32x4 w = v[j] * gr[64 * j]; u32x2 o; o.x = pk_bf16(w[0], w[1]); o.y = pk_bf16(w[2], w[3]); o8[64 * j] = o; }
        }
    }
    }
    grid.sync();

#pragma unroll 1
    for (int l = 0; l < 2; ++l) {
        const float* bgate = a.in[3] + (size_t)l * 2048;
        {
            pg8::Gemm g{XN, win, D, D, M, IN_COLS, D}; pg8::StaticOrder S; S.init(M, IN_COLS, G, bx);
            Epi<1> E; E.p = EpiP{}; E.p.ssq = ssq + (size_t)(2 * l) * M; E.p.PA = PA; E.p.PB = PB; E.p.rope = rope;
            pg8::gemm_phase(lds, g, S, E);
        }
        grid.sync();
        for (int j = vcu; j < 256; j += G) ret::item(j >> 5, (j >> 3) & 3, j & 7, PA, (LAS char*)lds);
        for (int j = vcu; j < 256; j += G) {
            const int bh = j >> 2, s = j & 3;
            sb::unit(bh >> 3, bh & 7, 15 - s, PA, (LAS char*)lds);
            sb::unit(bh >> 3, bh & 7, 8 + s, PA, (LAS char*)lds);
            sb::unit(bh >> 3, bh & 7, 7 - s, PA, (LAS char*)lds);
            sb::unit(bh >> 3, bh & 7, s, PA, (LAS char*)lds);
        }
        grid.sync();
        {
            PHASE_IDS();
            const float* rg = a.in[5] + (size_t)l * D;
            for (int m = gw; m < M; m += NGW) {
                bf16_t* op = PA + (size_t)m * PA_LD + 2560 + 16 * lane; const bf16_t* gp = PB + (size_t)m * PB_LD + 16 * lane;
                const u32x4 o0 = *(const u32x4*)op, o1 = *(const u32x4*)(op + 8), g0 = *(const u32x4*)gp, g1 = *(const u32x4*)(gp + 8);
                float v[16], gv[16];
                v[0] = bf_lo(o0.x); v[1] = bf_hi(o0.x); v[2] = bf_lo(o0.y); v[3] = bf_hi(o0.y); v[4] = bf_lo(o0.z); v[5] = bf_hi(o0.z); v[6] = bf_lo(o0.w); v[7] = bf_hi(o0.w);
                v[8] = bf_lo(o1.x); v[9] = bf_hi(o1.x); v[10] = bf_lo(o1.y); v[11] = bf_hi(o1.y); v[12] = bf_lo(o1.z); v[13] = bf_hi(o1.z); v[14] = bf_lo(o1.w); v[15] = bf_hi(o1.w);
                gv[0] = bf_lo(g0.x); gv[1] = bf_hi(g0.x); gv[2] = bf_lo(g0.y); gv[3] = bf_hi(g0.y); gv[4] = bf_lo(g0.z); gv[5] = bf_hi(g0.z); gv[6] = bf_lo(g0.w); gv[7] = bf_hi(g0.w);
                gv[8] = bf_lo(g1.x); gv[9] = bf_hi(g1.x); gv[10] = bf_lo(g1.y); gv[11] = bf_hi(g1.y); gv[12] = bf_lo(g1.z); gv[13] = bf_hi(g1.z); gv[14] = bf_lo(g1.w); gv[15] = bf_hi(g1.w);
                float s = 0.f;
#pragma unroll
                for (int k = 0; k < 16; ++k) s += v[k];
#pragma unroll
                for (int o = 1; o < 16; o <<= 1) s += __shfl_xor(s, o);
                const float mu = s * (1.f / 256.f); float q = 0.f;
#pragma unroll
                for (int k = 0; k < 16; ++k) { v[k] -= mu; q += v[k] * v[k]; }
#pragma unroll
                for (int o = 1; o < 16; o <<= 1) q += __shfl_xor(q, o);
                const float rstd = __builtin_amdgcn_rsqf(q * (1.f / 256.f) + EPS);
                const f32x4* rgp = (const f32x4*)(rg + 16 * lane);
                unsigned w[8];
#pragma unroll
                for (int k4 = 0; k4 < 4; ++k4) { const f32x4 gg = rgp[k4];
                    float y[4];
#pragma unroll
                    for (int k = 0; k < 4; ++k) { const float gx = gv[4 * k4 + k]; y[k] = v[4 * k4 + k] * rstd * gg[k] * gx * sigmoidf_(gx); }
                    w[2 * k4] = pk_bf16(y[0], y[1]); w[2 * k4 + 1] = pk_bf16(y[2], y[3]); }
                *(u32x4*)op = (u32x4){w[0], w[1], w[2], w[3]}; *(u32x4*)(op + 8) = (u32x4){w[4], w[5], w[6], w[7]};
            }
            __syncthreads();
            pg8::Gemm g{PA, wcat, PA_LD, 1536, M, D, 512}; pg8::StaticOrder S; S.init(M, D, G, bx);
            Epi<2> E; E.p = EpiP{}; E.p.PA = PA; E.p.PB = PB; E.p.bgate = bgate;
            pg8::gemm_phase(lds, g, S, E);
        }
        grid.sync();
        {
            pg8::Gemm g{PA + 2560, wcat + 512, PA_LD, 1536, M, D, D}; pg8::StaticOrder S; S.init(M, D, G, bx);
            Epi<3> E; E.p = EpiP{}; E.p.PA = PA; E.p.PB = PB; E.p.bgate = bgate;
            pg8::gemm_phase(lds, g, S, E);
        }
        grid.sync();
        {
            PHASE_IDS();
            convert_ffn(a, l, lds, gw, NGW, wave, lane);
            __syncthreads();
            pg8::Gemm g{PA + 1536, wo, PA_LD, D, M, D, D}; pg8::StaticOrder S; S.init(M, D, G, bx);
            Epi<4> E; E.p = EpiP{}; E.p.xin = (l == 0) ? x : out; E.p.xout = out; E.p.XN = XN; E.p.gnext = a.in[8] + (size_t)l * D; E.p.ssq_out = ssq + (size_t)(2 * l + 1) * M;
            pg8::gemm_phase(lds, g, S, E);
        }
        grid.sync();
        {
            PHASE_IDS();
            if (l == 0) { convert_mixer(a, 1, lds, gw, NGW, wave, lane); __syncthreads(); }
            pg8::Gemm g{XN, wup, D, D, M, U_LD, D}; pg8::StaticOrder S; S.init(M, U_LD, G, bx);
            Epi<5> E; E.p = EpiP{}; E.p.ssq = ssq + (size_t)(2 * l + 1) * M; E.p.U = U;
            pg8::gemm_phase(lds, g, S, E);
        }
        grid.sync();
        {
            PHASE_IDS();
            const float* cw = a.in[10] + (size_t)l * 3 * FF; const float* cb = a.in[11] + (size_t)l * FF;
            constexpr int NCH = FF / 8, NIT = (M / 8) * NCH;
            for (int it = gtid; it < NIT; it += NGT) {
                const int sbd = it / NCH, ch = it - sbd * NCH, r0 = sbd * 8, c0 = ch * 8;
                float w0[8], w1[8], w2[8], bsv[8];
#pragma unroll
                for (int k = 0; k < 8; ++k) { w0[k] = cw[c0 + k]; w1[k] = cw[FF + c0 + k]; w2[k] = cw[2 * FF + c0 + k]; bsv[k] = cb[c0 + k]; }
                float a2[8], a1[8];
                if ((r0 & 4095) == 0) {
#pragma unroll
                    for (int k = 0; k < 8; ++k) { a2[k] = 0.f; a1[k] = 0.f; }
                } else {
                    const u32x4 p2 = *(const u32x4*)(U + (size_t)(r0 - 2) * U_LD + c0), p1 = *(const u32x4*)(U + (size_t)(r0 - 1) * U_LD + c0);
                    a2[0] = bf_lo(p2.x); a2[1] = bf_hi(p2.x); a2[2] = bf_lo(p2.y); a2[3] = bf_hi(p2.y); a2[4] = bf_lo(p2.z); a2[5] = bf_hi(p2.z); a2[6] = bf_lo(p2.w); a2[7] = bf_hi(p2.w);
                    a1[0] = bf_lo(p1.x); a1[1] = bf_hi(p1.x); a1[2] = bf_lo(p1.y); a1[3] = bf_hi(p1.y); a1[4] = bf_lo(p1.z); a1[5] = bf_hi(p1.z); a1[6] = bf_lo(p1.w); a1[7] = bf_hi(p1.w);
                }
#pragma unroll
                for (int r = 0; r < 8; ++r) {
                    bf16_t* up = U + (size_t)(r0 + r) * U_LD + c0;
                    const u32x4 pa = *(const u32x4*)up, pb = *(const u32x4*)(up + FF);
                    float a0[8], bv[8], y[8];
                    a0[0] = bf_lo(pa.x); a0[1] = bf_hi(pa.x); a0[2] = bf_lo(pa.y); a0[3] = bf_hi(pa.y); a0[4] = bf_lo(pa.z); a0[5] = bf_hi(pa.z); a0[6] = bf_lo(pa.w); a0[7] = bf_hi(pa.w);
                    bv[0] = bf_lo(pb.x); bv[1] = bf_hi(pb.x); bv[2] = bf_lo(pb.y); bv[3] = bf_hi(pb.y); bv[4] = bf_lo(pb.z); bv[5] = bf_hi(pb.z); bv[6] = bf_lo(pb.w); bv[7] = bf_hi(pb.w);
#pragma unroll
                    for (int k = 0; k < 8; ++k) { const float cv = w0[k] * a2[k] + w1[k] * a1[k] + w2[k] * a0[k] + bsv[k]; y[k] = cv * sigmoidf_(cv) * bv[k]; a2[k] = a1[k]; a1[k] = a0[k]; }
                    *(u32x4*)(up + FF) = (u32x4){pk_bf16(y[0], y[1]), pk_bf16(y[2], y[3]), pk_bf16(y[4], y[5]), pk_bf16(y[6], y[7])};
                }
            }
        }
        grid.sync();
        {
            pg8::Gemm g{U + FF, wdn, U_LD, FF, M, D, FF}; pg8::StaticOrder S; S.init(M, D, G, bx);
            Epi<4> E; E.p = EpiP{}; E.p.xin = out; E.p.xout = out; E.p.XN = XN; E.p.gnext = (l == 0) ? a.in[1] + D : a.in[13]; E.p.ssq_out = ssq + (size_t)(2 * l + 2) * M;
            pg8::gemm_phase(lds, g, S, E);
        }
        grid.sync();
    }
    {
        PHASE_IDS();
        const float* gf = a.in[13]; const float* sq = ssq + (size_t)4 * M;
        for (int m = gw; m < M; m += NGW) {
            f32x4* xr = (f32x4*)(out + (size_t)m * D) + lane; const f32x4* gr = (const f32x4*)gf + lane;
            const float rs = __builtin_amdgcn_rsqf(sq[m] * (1.f / 1024.f) + EPS);
#pragma unroll
            for (int j = 0; j < 4; ++j) { const f32x4 v = xr[64 * j]; xr[64 * j] = v * rs * gr[64 * j]; }
        }
    }
}

constexpr int LDS_BYTES = 131072 + 1024;
static_assert(ret::LDS_BYTES <= 131072 && sb::LDS_BYTES <= 131072 && pg8::STAGE_BYTES <= 131072, "LDS map");

extern "C" void kernel_launch(void* const* d_in, const int* in_sizes, int n_in, void* d_out, int out_size, void* d_ws, size_t ws_size, hipStream_t stream) {
    static int grid = 0;
    if (grid == 0) {
        int dev = 0, cus = 0, per_cu = 0;
        hipGetDevice(&dev);
        hipDeviceGetAttribute(&cus, hipDeviceAttributeMultiprocessorCount, dev);
        hipFuncSetAttribute((const void*)fwd_kernel, hipFuncAttributeMaxDynamicSharedMemorySize, LDS_BYTES);
        hipOccupancyMaxActiveBlocksPerMultiprocessor(&per_cu, (const void*)fwd_kernel, 512, LDS_BYTES);
        (void)hipGetLastError();
        if (per_cu < 1) per_cu = 1;
        if (cus < 1) cus = 256;
        grid = cus;
        if (ws_size < WS_END) fprintf(stderr, "kernel_launch: workspace too small: %zu < %zu\n", ws_size, (size_t)WS_END);
    }
    Args a{};
    for (int i = 0; i < 14; ++i) a.in[i] = (const float*)d_in[i];
    a.out = (float*)d_out; a.ws = (unsigned char*)d_ws;
    void* args[] = {&a};
    hipError_t e = hipLaunchCooperativeKernel((const void*)fwd_kernel, dim3(grid), dim3(512), args, LDS_BYTES, stream);
    if (e != hipSuccess) fprintf(stderr, "cooperative launch failed: %s (grid %d)\n", hipGetErrorString(e), grid);
}
```

```cpp
#include <hip/hip_runtime.h>
#include <hip/hip_cooperative_groups.h>
#include <cstdio>
#include <cstdint>
namespace cg = cooperative_groups;

#define LAS __attribute__((address_space(3)))
typedef unsigned short bf16_t;
typedef short bf16x8 __attribute__((ext_vector_type(8)));
typedef short s16x4 __attribute__((ext_vector_type(4)));
typedef float f32x2 __attribute__((ext_vector_type(2)));
typedef float f32x4 __attribute__((ext_vector_type(4)));
typedef float f32x16 __attribute__((ext_vector_type(16)));
typedef unsigned u32x4 __attribute__((ext_vector_type(4)));
typedef unsigned u32x2 __attribute__((ext_vector_type(2)));

constexpr int M = 32768, D = 1024, SEQ = 4096, FF = 2816;
constexpr int IN_COLS = 6656, PA_LD = 3584, PB_LD = 3072, U_LD = 5632;
constexpr float EPS = 1e-6f;
constexpr float LOG2E = 1.4426950408889634f;

constexpr size_t MiB = 1u << 20;
constexpr size_t WS_SSQ = 0;
constexpr size_t WS_ROPE = 1 * MiB;
constexpr size_t WS_WIN = 3 * MiB;
constexpr size_t WS_WCAT = 16 * MiB;
constexpr size_t WS_WO = 19 * MiB;
constexpr size_t WS_XN = 21 * MiB;
constexpr size_t WS_PROJ = 85 * MiB;
constexpr size_t WS_PB = WS_PROJ + 224 * MiB;
constexpr size_t WS_WUP = WS_PROJ + 352 * MiB;
constexpr size_t WS_WDN = WS_WUP + 11 * MiB;
constexpr size_t WS_END0 = WS_PROJ + 416 * MiB;
constexpr size_t WS_SP = WS_END0;
constexpr size_t WS_YB = WS_SP + 8 * 6656 * 4;
constexpr size_t WS_UU = WS_YB + 8 * 1024 * 4;
constexpr size_t WS_END = WS_UU + 8 * 5632 * 4;

__device__ __forceinline__ unsigned pk_bf16(float lo, float hi) {
    typedef __bf16 b2 __attribute__((ext_vector_type(2))); f32x2 v = {lo, hi}; b2 b = __builtin_convertvector(v, b2); return __builtin_bit_cast(unsigned, b);
}
__device__ __forceinline__ float bf_lo(unsigned w) { return __uint_as_float(w << 16); }
__device__ __forceinline__ float bf_hi(unsigned w) { return __uint_as_float(w & 0xffff0000u); }
__device__ __forceinline__ float sigmoidf_(float x) { return __builtin_amdgcn_rcpf(1.f + __builtin_amdgcn_exp2f(-x * LOG2E)); }
__device__ __forceinline__ float wave_sum(float v) {
#pragma unroll
    for (int o = 1; o < 64; o <<= 1) v += __shfl_xor(v, o);
    return v;
}

namespace pg8 {
constexpr int BM = 256, BK = 64, HALF = 128, HTB = HALF * BK * 2, STAGE_BYTES = 8 * HTB, NXCD = 8, WGM = 8;
__host__ __device__ __forceinline__ int lds_byte(int r, int c) { const int st = (r >> 4) * 2 + (c >> 5), rr = r & 15, cc = c & 31, ob = rr * 64 + cc * 2; return st * 1024 + (ob ^ (((ob >> 9) & 1) << 5)); }
__host__ __device__ __forceinline__ void stage_rc(int b, int& R, int& C) { const int st = b / 1024, sb = b % 1024, swz = sb ^ (((sb >> 9) & 1) << 5); R = (st >> 1) * 16 + swz / 64; C = (st & 1) * 32 + (swz % 64) / 2; }
__host__ __device__ __forceinline__ int perm32(int rho) { const int n = rho >> 4, i = rho & 15; return 8 * (i >> 2) + 4 * n + (i & 3); }

struct Unit { int pm, pn; };
struct Gemm { const bf16_t* A; const bf16_t* Bt; int lda, ldb, M, N, K; };

struct StaticOrder {
    int nM, nN, nwg, G, c;
    __device__ void init(int M_, int N_, int G_, int c_) { nM = M_ / BM; nN = N_ / BM; nwg = nM * nN; G = G_; c = c_; }
    __device__ bool next(int i, Unit& u) const {
        const long L = (long)i * G + c; if (L >= nwg) return false;
        int wgid = (int)L; { const int q = nwg / NXCD, r = nwg % NXCD, xcd = wgid % NXCD, off = wgid / NXCD; wgid = (xcd < r ? xcd * (q + 1) : r * (q + 1) + (xcd - r) * q) + off; }
        const int nig = WGM * nN, gid = wgid / nig, fm = gid * WGM, gsz = (nM - fm) < WGM ? (nM - fm) : WGM;
        u.pm = fm + ((wgid % nig) % gsz); u.pn = (wgid % nig) / gsz; return true;
    }
};

template <class Epi>
__device__ __forceinline__ void gemm_phase(LAS unsigned char* lds, const Gemm g, const StaticOrder& S, const Epi& E) {
    int tid_ = threadIdx.x; asm volatile("" : "+v"(tid_));
    const int tid = tid_, wid = __builtin_amdgcn_readfirstlane(tid >> 6), lane = tid & 63, wr = wid >> 2, wc = wid & 3, fr = lane & 15, fq = lane >> 4;
    const int K = g.K, nt = K / BK;
    unsigned voffA[2], voffB[2];
#pragma unroll
    for (int i = 0; i < 2; ++i) { int R, C; stage_rc(tid * 16 + i * 8192, R, C); const int Rb = (R & ~31) + perm32(R & 31);
        voffA[i] = (unsigned)(R * g.lda + C) * 2u; voffB[i] = (unsigned)(Rb * g.ldb + C) * 2u; }
    const size_t kstep = (size_t)(BK * 2);
    const size_t hstepA = (size_t)HALF * g.lda * 2, hstepB = (size_t)HALF * g.ldb * 2;
    const size_t tstepA = 2 * hstepA, tstepB = 2 * hstepB;
    const unsigned ldsw = (unsigned)wid * 1024u;
    const int aoff = lds_byte(wr * 64 + fr, fq * 8), boff = lds_byte(wc * 32 + fr, fq * 8);
#define PG8_SA(b, h) (((b) * 2 + (h)) * HTB)
#define PG8_SB(b, h) ((4 + (b) * 2 + (h)) * HTB)
#define PG8_STAGE(bufoff, gbase, voff) do { _Pragma("unroll") for (int _i = 0; _i < 2; ++_i) \
        __builtin_amdgcn_global_load_lds((const unsigned*)((const char*)(gbase) + (voff)[_i]), (LAS unsigned*)(lds + (bufoff) + ldsw + _i * 8192), 16, 0, 0); } while (0)
#define PG8_LDA(dst, b, h) do { _Pragma("unroll") for (int m = 0; m < 4; ++m) _Pragma("unroll") for (int k = 0; k < 2; ++k) dst[m][k] = *(const LAS bf16x8*)(lds + PG8_SA(b, h) + aoff + m * 2048 + k * 1024); } while (0)
#define PG8_LDB(dst, b, h) do { _Pragma("unroll") for (int n = 0; n < 2; ++n) _Pragma("unroll") for (int k = 0; k < 2; ++k) dst[n][k] = *(const LAS bf16x8*)(lds + PG8_SB(b, h) + boff + n * 2048 + k * 1024); } while (0)
#define PG8_MMA(ai, bj, At, Bt) do { __builtin_amdgcn_s_setprio(1); _Pragma("unroll") for (int m = 0; m < 4; ++m) _Pragma("unroll") for (int n = 0; n < 2; ++n) _Pragma("unroll") for (int k = 0; k < 2; ++k) \
        acc[ai][bj][m][n] = __builtin_amdgcn_mfma_f32_16x16x32_bf16(Bt[n][k], At[m][k], acc[ai][bj][m][n], 0, 0, 0); __builtin_amdgcn_s_setprio(0); } while (0)
#define PG8_WAIT_V(n) asm volatile("s_waitcnt vmcnt(" #n ")" ::: "memory")
#define PG8_WAIT_L(n) asm volatile("s_waitcnt lgkmcnt(" #n ")" ::: "memory")
#define PG8_BAR __builtin_amdgcn_s_barrier()
#define PG8_SCHED __builtin_amdgcn_sched_barrier(0)
    Unit cur, nxt; int ui = 0;
    if (!S.next(0, cur)) return;
    f32x4 acc[2][2][4][2];
#pragma unroll
    for (int a = 0; a < 2; ++a)
#pragma unroll
        for (int b = 0; b < 2; ++b)
#pragma unroll
            for (int m = 0; m < 4; ++m)
#pragma unroll
                for (int n = 0; n < 2; ++n) acc[a][b][m][n] = (f32x4){0.f, 0.f, 0.f, 0.f};
    bf16x8 At[4][2], B0[2][2], B1[2][2];
    const char* cA = (const char*)g.A + (size_t)cur.pm * tstepA; const char* cB = (const char*)g.Bt + (size_t)cur.pn * tstepB;
    PG8_STAGE(PG8_SB(0, 0), cB, voffB); PG8_STAGE(PG8_SB(0, 1), cB + hstepB, voffB); PG8_STAGE(PG8_SA(0, 0), cA, voffA); PG8_STAGE(PG8_SA(0, 1), cA + hstepA, voffA);
    if (wr == 1) PG8_BAR;
    PG8_WAIT_V(2); PG8_BAR;
    PG8_STAGE(PG8_SB(1, 0), cB + kstep, voffB); PG8_STAGE(PG8_SA(1, 0), cA + kstep, voffA); PG8_STAGE(PG8_SB(1, 1), cB + hstepB + kstep, voffB);
    PG8_WAIT_V(6); PG8_BAR;
    for (;;) {
        const bool has_next = S.next(ui + 1, nxt);
        const char* nA = has_next ? (const char*)g.A + (size_t)nxt.pm * tstepA : cA; const char* nB = has_next ? (const char*)g.Bt + (size_t)nxt.pn * tstepB : cB;
        for (int t = 0; t < nt; t += 2) {
            const bool last = (t == nt - 2);
            const char* a1 = cA + (size_t)(t + 1) * kstep;
            const char* a2 = last ? nA : cA + (size_t)(t + 2) * kstep; const char* b2 = last ? nB : cB + (size_t)(t + 2) * kstep;
            const char* a3 = a2 + kstep; const char* b3 = b2 + kstep;
            PG8_LDB(B0, 0, 0); PG8_LDB(B1, 0, 1); PG8_SCHED; PG8_LDA(At, 0, 0); PG8_STAGE(PG8_SA(1, 1), a1 + hstepA, voffA);
            PG8_WAIT_V(8); PG8_WAIT_L(0); PG8_BAR; PG8_MMA(0, 0, At, B0); PG8_MMA(0, 1, At, B1); PG8_BAR; PG8_SCHED;
            PG8_LDA(At, 0, 1); PG8_STAGE(PG8_SB(0, 0), b2, voffB); PG8_STAGE(PG8_SB(0, 1), b2 + hstepB, voffB); PG8_STAGE(PG8_SA(0, 0), a2, voffA);
            PG8_WAIT_V(8); PG8_WAIT_L(0); PG8_BAR; PG8_MMA(1, 0, At, B0); PG8_MMA(1, 1, At, B1); PG8_BAR; PG8_SCHED;
            PG8_LDB(B0, 1, 0); PG8_LDB(B1, 1, 1); PG8_SCHED; PG8_LDA(At, 1, 0); PG8_STAGE(PG8_SA(0, 1), a2 + hstepA, voffA);
            PG8_WAIT_V(8); PG8_WAIT_L(0); PG8_BAR; PG8_MMA(0, 0, At, B0); PG8_MMA(0, 1, At, B1); PG8_BAR; PG8_SCHED;
            PG8_LDA(At, 1, 1); PG8_STAGE(PG8_SB(1, 0), b3, voffB); PG8_STAGE(PG8_SB(1, 1), b3 + hstepB, voffB); PG8_STAGE(PG8_SA(1, 0), a3, voffA);
            PG8_WAIT_V(8); PG8_WAIT_L(0); PG8_BAR; PG8_MMA(1, 0, At, B0); PG8_MMA(1, 1, At, B1); PG8_BAR; PG8_SCHED;
        }
        if (wr == 0) PG8_BAR;
        E(acc, cur, wr, wc, fr, fq);
        if (!has_next) break;
#pragma unroll
        for (int a = 0; a < 2; ++a)
#pragma unroll
            for (int b = 0; b < 2; ++b)
#pragma unroll
                for (int m = 0; m < 4; ++m)
#pragma unroll
                    for (int n = 0; n < 2; ++n) acc[a][b][m][n] = (f32x4){0.f, 0.f, 0.f, 0.f};
        cur = nxt; cA = nA; cB = nB; ++ui;
        if (wr == 1) PG8_BAR;
    }
    PG8_WAIT_V(0);
    PG8_BAR;
#undef PG8_SA
#undef PG8_SB
#undef PG8_STAGE
#undef PG8_LDA
#undef PG8_LDB
#undef PG8_MMA
#undef PG8_WAIT_V
#undef PG8_WAIT_L
#undef PG8_BAR
#undef PG8_SCHED
}
}

struct EpiP {
    const float* ssq;
    bf16_t* PA; bf16_t* PB;
    const f32x4* rope;
    const float* bgate;
    const float* xin; float* xout; bf16_t* XN; const float* gnext; float* ssq_out;
    bf16_t* U;
};
template <int MODE> struct Epi {
    EpiP p;
    __device__ __forceinline__ void operator()(const f32x4 (&acc)[2][2][4][2], const pg8::Unit& u, int wr, int wc, int fr, int fq) const {
        const int pn = u.pn;
        const int rowb = u.pm * 256 + wr * 64 + fr;
        const int colw = wc * 32 + 8 * fq;
        if constexpr (MODE == 1) {
            bf16_t* O; int ldc, cb;
            if (pn < 14) { O = p.PA; ldc = PA_LD; cb = pn * 256; } else { O = p.PB; ldc = PB_LD; cb = (pn - 14) * 256; }
            const int kind = (pn < 2) ? 1 : (pn >= 6 && pn < 8) ? 2 : (pn >= 8 && pn < 10) ? 3 : 0;
#pragma unroll
            for (int ai = 0; ai < 2; ++ai)
#pragma unroll
                for (int m = 0; m < 4; ++m) {
                    const int row = rowb + ai * 128 + m * 16;
                    float sc = __builtin_amdgcn_rsqf(p.ssq[row] * (1.f / 1024.f) + EPS);
                    if (kind == 1) sc *= 0.125f * LOG2E;
#pragma unroll
                    for (int bj = 0; bj < 2; ++bj) {
                        f32x4 v0 = acc[ai][bj][m][0] * sc, v1 = acc[ai][bj][m][1] * sc;
                        if (kind >= 2) {
                            const int head = (pn - (kind == 2 ? 6 : 8)) * 2 + bj;
                            const float lg = __builtin_log2f(1.f - __builtin_exp2f(-5.f - (float)head));
                            const float e = (float)((row & 127) + 1) * lg;
                            const float dsc = (kind == 2) ? __builtin_amdgcn_exp2f(e) * 0.08838834764831845f : __builtin_amdgcn_exp2f(-e);
                            const f32x4* rp = p.rope + ((size_t)(row & 4095) * 64 + wc * 16 + 4 * fq) / 2;
                            const f32x4 c01 = rp[0], c23 = rp[1];
                            f32x4 w0, w1;
                            w0[0] = (v0[0] * c01[0] - v0[1] * c01[1]) * dsc; w0[1] = (v0[0] * c01[1] + v0[1] * c01[0]) * dsc;
                            w0[2] = (v0[2] * c01[2] - v0[3] * c01[3]) * dsc; w0[3] = (v0[2] * c01[3] + v0[3] * c01[2]) * dsc;
                            w1[0] = (v1[0] * c23[0] - v1[1] * c23[1]) * dsc; w1[1] = (v1[0] * c23[1] + v1[1] * c23[0]) * dsc;
                            w1[2] = (v1[2] * c23[2] - v1[3] * c23[3]) * dsc; w1[3] = (v1[2] * c23[3] + v1[3] * c23[2]) * dsc;
                            v0 = w0; v1 = w1;
                        }
                        u32x4 w; w.x = pk_bf16(v0[0], v0[1]); w.y = pk_bf16(v0[2], v0[3]); w.z = pk_bf16(v1[0], v1[1]); w.w = pk_bf16(v1[2], v1[3]);
                        *(u32x4*)(O + (size_t)row * ldc + cb + bj * 128 + colw) = w;
                    }
                }
        } else if constexpr (MODE == 2 || MODE == 3) {
            const int goff = (MODE == 2) ? 1024 : 2048, boff = (MODE == 2) ? 0 : 1024;
            f32x4 bb[2][2];
#pragma unroll
            for (int bj = 0; bj < 2; ++bj) { const int col = pn * 256 + bj * 128 + colw; bb[bj][0] = *(const f32x4*)(p.bgate + boff + col); bb[bj][1] = *(const f32x4*)(p.bgate + boff + col + 4); }
#pragma unroll
            for (int ai = 0; ai < 2; ++ai)
#pragma unroll
                for (int m = 0; m < 4; ++m) {
                    const int row = rowb + ai * 128 + m * 16;
#pragma unroll
                    for (int bj = 0; bj < 2; ++bj) {
                        const int col = pn * 256 + bj * 128 + colw;
                        const u32x4 gw = *(const u32x4*)(p.PB + (size_t)row * PB_LD + goff + col);
                        f32x4 g0, g1;
                        g0[0] = bf_lo(gw.x); g0[1] = bf_hi(gw.x); g0[2] = bf_lo(gw.y); g0[3] = bf_hi(gw.y);
                        g1[0] = bf_lo(gw.z); g1[1] = bf_hi(gw.z); g1[2] = bf_lo(gw.w); g1[3] = bf_hi(gw.w);
                        g0 += bb[bj][0]; g1 += bb[bj][1];
                        f32x4 v0 = acc[ai][bj][m][0], v1 = acc[ai][bj][m][1];
#pragma unroll
                        for (int k = 0; k < 4; ++k) { v0[k] *= sigmoidf_(g0[k]); v1[k] *= sigmoidf_(g1[k]); }
                        if constexpr (MODE == 3) {
                            const u32x4 tw = *(const u32x4*)(p.PA + (size_t)row * PA_LD + 512 + col);
                            v0[0] += bf_lo(tw.x); v0[1] += bf_hi(tw.x); v0[2] += bf_lo(tw.y); v0[3] += bf_hi(tw.y);
                            v1[0] += bf_lo(tw.z); v1[1] += bf_hi(tw.z); v1[2] += bf_lo(tw.w); v1[3] += bf_hi(tw.w);
                        }
                        u32x4 w; w.x = pk_bf16(v0[0], v0[1]); w.y = pk_bf16(v0[2], v0[3]); w.z = pk_bf16(v1[0], v1[1]); w.w = pk_bf16(v1[2], v1[3]);
                        *(u32x4*)(p.PA + (size_t)row * PA_LD + (MODE == 2 ? 512 : 1536) + col) = w;
                    }
                }
        } else if constexpr (MODE == 4) {
            f32x4 gg[2][2];
#pragma unroll
            for (int bj = 0; bj < 2; ++bj) { const int col = pn * 256 + bj * 128 + colw; gg[bj][0] = *(const f32x4*)(p.gnext + col); gg[bj][1] = *(const f32x4*)(p.gnext + col + 4); }
#pragma unroll
            for (int ai = 0; ai < 2; ++ai)
#pragma unroll
                for (int m = 0; m < 4; ++m) {
                    const int row = rowb + ai * 128 + m * 16;
                    const bool keep = (row & 4095) != 0;
                    float ss = 0.f;
#pragma unroll
                    for (int bj = 0; bj < 2; ++bj) {
                        const int col = pn * 256 + bj * 128 + colw;
                        const size_t off = (size_t)row * D + col;
                        f32x4 x0 = *(const f32x4*)(p.xin + off), x1 = *(const f32x4*)(p.xin + off + 4);
                        x0 += acc[ai][bj][m][0]; x1 += acc[ai][bj][m][1];
                        if (keep) { *(f32x4*)(p.xout + off) = x0; *(f32x4*)(p.xout + off + 4) = x1; }
                        ss += (x0[0] * x0[0] + x0[1] * x0[1]) + (x0[2] * x0[2] + x0[3] * x0[3]) + (x1[0] * x1[0] + x1[1] * x1[1]) + (x1[2] * x1[2] + x1[3] * x1[3]);
                        x0 *= gg[bj][0]; x1 *= gg[bj][1];
                        u32x4 w; w.x = pk_bf16(x0[0], x0[1]); w.y = pk_bf16(x0[2], x0[3]); w.z = pk_bf16(x1[0], x1[1]); w.w = pk_bf16(x1[2], x1[3]);
                        if (keep) *(u32x4*)(p.XN + off) = w;
                    }
                    ss += __shfl_xor(ss, 16); ss += __shfl_xor(ss, 32);
                    if (fq == 0 && keep) unsafeAtomicAdd(p.ssq_out + row, ss);
                }
        } else {
#pragma unroll
            for (int ai = 0; ai < 2; ++ai)
#pragma unroll
                for (int m = 0; m < 4; ++m) {
                    const int row = rowb + ai * 128 + m * 16;
                    const float sc = __builtin_amdgcn_rsqf(p.ssq[row] * (1.f / 1024.f) + EPS);
#pragma unroll
                    for (int bj = 0; bj < 2; ++bj) {
                        const f32x4 v0 = acc[ai][bj][m][0] * sc, v1 = acc[ai][bj][m][1] * sc;
                        u32x4 w; w.x = pk_bf16(v0[0], v0[1]); w.y = pk_bf16(v0[2], v0[3]); w.z = pk_bf16(v1[0], v1[1]); w.w = pk_bf16(v1[2], v1[3]);
                        *(u32x4*)(p.U + (size_t)row * U_LD + pn * 256 + bj * 128 + colw) = w;
                    }
                }
        }
    }
};

namespace sb {
constexpr int PITCH = PA_LD, NW = 8, QB = 256, KVBLK = 64;
constexpr int NSLOT = 3, SLOTB = 8192;
constexpr int LDS_K = 0, LDS_V = NSLOT * SLOTB, LDS_OST = 2 * NSLOT * SLOTB, LDS_BYTES = LDS_OST + NW * 4096;
__device__ __forceinline__ void glds16(const void* gsrc, unsigned lds_dst) { unsigned keep;
    asm volatile("s_mov_b32 %0, m0\n\ts_mov_b32 m0, %2\n\ts_nop 0\n\tglobal_load_lds_dwordx4 %1, off\n\ts_mov_b32 m0, %0" : "=&s"(keep) : "v"(gsrc), "s"(lds_dst) : "memory"); }
__device__ __forceinline__ int crow(int r, int hi) { return (r & 3) + 8 * (r >> 2) + 4 * hi; }
typedef short v4i16_t __attribute__((ext_vector_type(4)));
__device__ __forceinline__ s16x4 vtr(const LAS char* p) { return __builtin_bit_cast(s16x4, __builtin_amdgcn_ds_read_tr16_b64_v4i16((LAS v4i16_t*)p)); }

__device__ __forceinline__ void unit(int b, int h, int qb, bf16_t* PA, LAS char* shm) {
    int tid_ = threadIdx.x; asm volatile("" : "+v"(tid_));
    const int tid = tid_, lane = tid & 63, r32 = lane & 31, hi = lane >> 5; const int wid = __builtin_amdgcn_readfirstlane(tid >> 6);
    const long rowbase = (long)b * SEQ; const int q0 = qb * QB;
    const bf16_t* Qw = PA + (rowbase + q0 + wid * 32) * PITCH + h * 64;
    const bf16_t* Kh = PA + rowbase * PITCH + 512 + h * 64;
    const bf16_t* Vh = PA + rowbase * PITCH + 1024 + h * 64;
    const unsigned lds0 = (unsigned)(uintptr_t)shm;
    const int kperm = ((lane >> 2) & 1) * 32 + (lane >> 5) * 16 + ((lane & 31) >> 3) * 4 + (lane & 3);
    const bf16_t* ksrc = Kh + (long)kperm * PITCH + wid * 8;
    const bf16_t* vsrc = Vh + (long)(16 * (wid & 3) + (lane >> 2)) * PITCH + (wid >> 2) * 32 + (lane & 3) * 8;
    const unsigned kdst = lds0 + LDS_K + wid * 1024, vdst = lds0 + LDS_V + wid * 1024;
#define DMA_KV(t, slot) do { glds16(ksrc + (long)(t) * KVBLK * PITCH, (unsigned)__builtin_amdgcn_readfirstlane(kdst + (slot))); \
                             glds16(vsrc + (long)(t) * KVBLK * PITCH, (unsigned)__builtin_amdgcn_readfirstlane(vdst + (slot))); } while (0)
    const int NT = (q0 + QB) / KVBLK;
    bf16x8 qr[4];
#pragma unroll
    for (int d0 = 0; d0 < 4; ++d0) qr[d0] = *reinterpret_cast<const bf16x8*>(&Qw[(long)r32 * PITCH + d0 * 16 + hi * 8]);
    DMA_KV(NT - 1, 0); DMA_KV(NT - 2, SLOTB);
    f32x16 o[2]; o[0] = f32x16{}; o[1] = f32x16{};
    float carry = 1.f;
    const int qrel = wid * 32 + r32;
    const LAS char* kp0 = shm + LDS_K + hi * 1024 + r32 * 16;
    const LAS char* vp0 = shm + LDS_V + (32 * hi + ((lane & 15) >> 2)) * 64 + ((lane >> 4) & 1) * 32 + (lane & 3) * 8;
    int slot = 0, slot2 = 2 * SLOTB;
    for (int t = NT - 1; t >= 0; --t) {
        if (t >= 1) asm volatile("s_waitcnt vmcnt(2) lgkmcnt(0)\n\ts_barrier" ::: "memory");
        else        asm volatile("s_waitcnt vmcnt(0) lgkmcnt(0)\n\ts_barrier" ::: "memory");
        if (t >= 2) DMA_KV(t - 2, slot2);
        const int jb = t - (NT - 4);
        if (jb <= (wid >> 1)) {
            f32x16 p0 = f32x16{}, p1 = f32x16{};
            const LAS char* kb = kp0 + slot;
#pragma unroll
            for (int d0 = 0; d0 < 4; ++d0) {
                const bf16x8 b0 = *(const LAS bf16x8*)(kb + d0 * 2048);
                const bf16x8 b1 = *(const LAS bf16x8*)(kb + d0 * 2048 + 512);
                p0 = __builtin_amdgcn_mfma_f32_32x32x16_bf16(b0, qr[d0], p0, 0, 0, 0);
                p1 = __builtin_amdgcn_mfma_f32_32x32x16_bf16(b1, qr[d0], p1, 0, 0, 0);
            }
#pragma unroll
            for (int r = 0; r < 16; ++r) { p0[r] = __builtin_amdgcn_rcpf(1.f + __builtin_amdgcn_exp2f(p0[r])); p1[r] = __builtin_amdgcn_rcpf(1.f + __builtin_amdgcn_exp2f(p1[r])); }
            if (jb == (wid >> 1)) {
                const int kb0 = 64 * jb + 32 * hi;
#pragma unroll
                for (int r = 0; r < 16; ++r) { if (kb0 + r >= qrel) p0[r] = 1.f; if (kb0 + 16 + r >= qrel) p1[r] = 1.f; }
            }
            float T = 1.f;
#pragma unroll
            for (int r = 15; r >= 0; --r) { const float Tn = T * p1[r]; p1[r] = T - Tn; T = Tn; }
#pragma unroll
            for (int r = 15; r >= 0; --r) { const float Tn = T * p0[r]; p0[r] = T - Tn; T = Tn; }
            const float Tp = __shfl_xor(T, 32);
            const float base = carry * (hi == 0 ? Tp : 1.f);
            carry = carry * T * Tp;
#pragma unroll
            for (int r = 0; r < 16; ++r) { p0[r] *= base; p1[r] *= base; }
            u32x4 pw0, pw1, pw2, pw3;
            pw0 = (u32x4){pk_bf16(p0[0], p0[1]), pk_bf16(p0[2], p0[3]), pk_bf16(p0[4], p0[5]), pk_bf16(p0[6], p0[7])};
            pw1 = (u32x4){pk_bf16(p0[8], p0[9]), pk_bf16(p0[10], p0[11]), pk_bf16(p0[12], p0[13]), pk_bf16(p0[14], p0[15])};
            pw2 = (u32x4){pk_bf16(p1[0], p1[1]), pk_bf16(p1[2], p1[3]), pk_bf16(p1[4], p1[5]), pk_bf16(p1[6], p1[7])};
            pw3 = (u32x4){pk_bf16(p1[8], p1[9]), pk_bf16(p1[10], p1[11]), pk_bf16(p1[12], p1[13]), pk_bf16(p1[14], p1[15])};
            const LAS char* vb = vp0 + slot;
#pragma unroll
            for (int d0 = 0; d0 < 2; ++d0) {
                s16x4 lo[4], hh[4];
#pragma unroll
                for (int ks = 0; ks < 4; ++ks) { lo[ks] = vtr(vb + d0 * 4096 + ks * 512); hh[ks] = vtr(vb + d0 * 4096 + ks * 512 + 256); }
#define PKV(k) (bf16x8){lo[k][0], lo[k][1], lo[k][2], lo[k][3], hh[k][0], hh[k][1], hh[k][2], hh[k][3]}
                o[d0] = __builtin_amdgcn_mfma_f32_32x32x16_bf16(__builtin_bit_cast(bf16x8, pw0), PKV(0), o[d0], 0, 0, 0);
                o[d0] = __builtin_amdgcn_mfma_f32_32x32x16_bf16(__builtin_bit_cast(bf16x8, pw1), PKV(1), o[d0], 0, 0, 0);
                o[d0] = __builtin_amdgcn_mfma_f32_32x32x16_bf16(__builtin_bit_cast(bf16x8, pw2), PKV(2), o[d0], 0, 0, 0);
                o[d0] = __builtin_amdgcn_mfma_f32_32x32x16_bf16(__builtin_bit_cast(bf16x8, pw3), PKV(3), o[d0], 0, 0, 0);
#undef PKV
            }
        }
        slot2 = slot; slot = (slot == (NSLOT - 1) * SLOTB) ? 0 : slot + SLOTB;
    }
    bf16_t* Ow = PA + (rowbase + q0 + wid * 32) * PITCH + h * 64;
    {
        LAS bf16_t* stg = (LAS bf16_t*)(shm + LDS_OST) + wid * 2048;
#pragma unroll
        for (int r = 0; r < 16; ++r) { const int orow = crow(r, hi);
#pragma unroll
            for (int d0 = 0; d0 < 2; ++d0) stg[orow * 64 + d0 * 32 + r32] = (bf16_t)(pk_bf16(o[d0][r], 0.f) & 0xffffu); }
        asm volatile("s_waitcnt lgkmcnt(0)" ::: "memory");
#pragma unroll
        for (int i = 0; i < 4; ++i) { const int row = i * 8 + (lane >> 3), ch = lane & 7; const u32x4 v = *(const LAS u32x4*)(stg + row * 64 + ch * 8); *(u32x4*)(Ow + (long)row * PITCH + ch * 8) = v; }
    }
    asm volatile("s_waitcnt vmcnt(0) lgkmcnt(0)\n\ts_barrier" ::: "memory");
#undef DMA_KV
}
}

namespace ret {
constexpr int RS = 272;
constexpr int L_Q = 0, L_K = 128 * RS, L_P = 2 * 128 * RS, L_V = 3 * 128 * RS, L_S = L_V + 128 * 64, LDS_BYTES = L_S + 2 * 32 * RS;
typedef short v4i16_t __attribute__((ext_vector_type(4)));
__device__ __forceinline__ s16x4 vtr(const LAS char* p) { return __builtin_bit_cast(s16x4, __builtin_amdgcn_ds_read_tr16_b64_v4i16((LAS v4i16_t*)p)); }
__device__ __forceinline__ bf16x8 cat(s16x4 a, s16x4 b) { return (bf16x8){a[0], a[1], a[2], a[3], b[0], b[1], b[2], b[3]}; }

__device__ __forceinline__ void item(int b, int h, int sl, bf16_t* PA, LAS char* shm) {
    int tid_ = threadIdx.x; asm volatile("" : "+v"(tid_));
    const int tid = tid_, lane = tid & 63, fr = lane & 15, fq = lane >> 4; const int wid = __builtin_amdgcn_readfirstlane(tid >> 6);
    const size_t rowbase = (size_t)b * SEQ;
    const bf16_t* Qg = PA + rowbase * PA_LD + 1536 + h * 128;
    const bf16_t* Kg = PA + rowbase * PA_LD + 2048 + h * 128;
    bf16_t* Vg = PA + rowbase * PA_LD + 2560 + h * 256 + sl * 32;
    const float lg = __builtin_log2f(1.f - __builtin_exp2f(-5.f - (float)h));
    const float gam128 = __builtin_exp2f(128.f * lg);
    for (int i = tid; i < 32 * RS / 4; i += 512) ((LAS unsigned*)(shm + L_S))[i] = 0u;
    u32x4 qreg[4], kreg[4], vreg;
#define RET_LOAD(c) do { _Pragma("unroll") for (int i = 0; i < 4; ++i) { const int id = tid + 512 * i, row = id >> 4, ch = id & 15; \
            qreg[i] = *(const u32x4*)(Qg + (size_t)((c) * 128 + row) * PA_LD + ch * 8); kreg[i] = *(const u32x4*)(Kg + (size_t)((c) * 128 + row) * PA_LD + ch * 8); } \
        vreg = *(const u32x4*)(Vg + (size_t)((c) * 128 + (tid >> 2)) * PA_LD + (tid & 3) * 8); } while (0)
    RET_LOAD(0);
    f32x4 st[2]; st[0] = (f32x4){0.f, 0.f, 0.f, 0.f}; st[1] = st[0];
    for (int c = 0; c < 32; ++c) {
#pragma unroll
        for (int i = 0; i < 4; ++i) { const int id = tid + 512 * i, row = id >> 4, ch = id & 15;
            *(LAS u32x4*)(shm + L_Q + row * RS + ch * 16) = qreg[i]; *(LAS u32x4*)(shm + L_K + row * RS + ch * 16) = kreg[i]; }
        *(LAS u32x4*)(shm + L_V + (tid >> 2) * 64 + (tid & 3) * 16) = vreg;
        __syncthreads();
        if (c + 1 < 32) RET_LOAD(c + 1);
        const LAS char* Scur = shm + L_S + (c & 1) * 32 * RS; LAS char* Snxt = shm + L_S + ((c + 1) & 1) * 32 * RS;
        {
            bf16x8 bq[4];
#pragma unroll
            for (int ks = 0; ks < 4; ++ks) bq[ks] = *(const LAS bf16x8*)(shm + L_Q + (16 * wid + fr) * RS + (ks * 32 + 8 * fq) * 2);
            const int n = 16 * wid + fr;
#pragma unroll
            for (int mb = 0; mb < 8; ++mb) {
                f32x4 a4 = (f32x4){0.f, 0.f, 0.f, 0.f};
#pragma unroll
                for (int ks = 0; ks < 4; ++ks) { const bf16x8 ak = *(const LAS bf16x8*)(shm + L_K + (16 * mb + fr) * RS + (ks * 32 + 8 * fq) * 2);
                    a4 = __builtin_amdgcn_mfma_f32_16x16x32_bf16(ak, bq[ks], a4, 0, 0, 0); }
                const int m0 = 16 * mb + 4 * fq;
#pragma unroll
                for (int k = 0; k < 4; ++k) if (m0 + k > n) a4[k] = 0.f;
                u32x2 w; w.x = pk_bf16(a4[0], a4[1]); w.y = pk_bf16(a4[2], a4[3]);
                *(LAS u32x2*)(shm + L_P + n * RS + m0 * 2) = w;
            }
        }
        {
            f32x4 kv[2]; kv[0] = (f32x4){0.f, 0.f, 0.f, 0.f}; kv[1] = kv[0];
#pragma unroll
            for (int ks = 0; ks < 4; ++ks) {
                const int r0 = 32 * ks + 8 * fq + (fr >> 2);
                const LAS char* ka = shm + L_K + r0 * RS + (16 * wid + 4 * (fr & 3)) * 2;
                const bf16x8 af = cat(vtr(ka), vtr(ka + 4 * RS));
#pragma unroll
                for (int eb = 0; eb < 2; ++eb) {
                    const LAS char* va = shm + L_V + r0 * 64 + (16 * eb + 4 * (fr & 3)) * 2;
                    const bf16x8 bfv = cat(vtr(va), vtr(va + 4 * 64));
                    kv[eb] = __builtin_amdgcn_mfma_f32_16x16x32_bf16(af, bfv, kv[eb], 0, 0, 0);
                }
            }
#pragma unroll
            for (int eb = 0; eb < 2; ++eb) {
                st[eb] = (st[eb] + kv[eb]) * gam128;
                u32x2 w; w.x = pk_bf16(st[eb][0], st[eb][1]); w.y = pk_bf16(st[eb][2], st[eb][3]);
                *(LAS u32x2*)(Snxt + (16 * eb + fr) * RS + (16 * wid + 4 * fq) * 2) = w;
            }
        }
        __syncthreads();
        {
            f32x4 oa[2]; oa[0] = (f32x4){0.f, 0.f, 0.f, 0.f}; oa[1] = oa[0];
#pragma unroll
            for (int ks = 0; ks < 4; ++ks) {
                const bf16x8 bp = *(const LAS bf16x8*)(shm + L_P + (16 * wid + fr) * RS + (ks * 32 + 8 * fq) * 2);
                const bf16x8 bq = *(const LAS bf16x8*)(shm + L_Q + (16 * wid + fr) * RS + (ks * 32 + 8 * fq) * 2);
                const int r0 = 32 * ks + 8 * fq + (fr >> 2);
#pragma unroll
                for (int eb = 0; eb < 2; ++eb) {
                    const LAS char* va = shm + L_V + r0 * 64 + (16 * eb + 4 * (fr & 3)) * 2;
                    const bf16x8 av = cat(vtr(va), vtr(va + 4 * 64));
                    oa[eb] = __builtin_amdgcn_mfma_f32_16x16x32_bf16(av, bp, oa[eb], 0, 0, 0);
                    const bf16x8 as = *(const LAS bf16x8*)(Scur + (16 * eb + fr) * RS + (ks * 32 + 8 * fq) * 2);
                    oa[eb] = __builtin_amdgcn_mfma_f32_16x16x32_bf16(as, bq, oa[eb], 0, 0, 0);
                }
            }
#pragma unroll
            for (int eb = 0; eb < 2; ++eb) {
                u32x2 w; w.x = pk_bf16(oa[eb][0], oa[eb][1]); w.y = pk_bf16(oa[eb][2], oa[eb][3]);
                *(u32x2*)(Vg + (size_t)(c * 128 + 16 * wid + fr) * PA_LD + 16 * eb + 4 * fq) = w;
            }
        }
        __syncthreads();
    }
#undef RET_LOAD
}
}


namespace side {
constexpr int RED_OFF = 98304;
template <class Fin> __device__ __forceinline__ void gemv_item(LAS unsigned char* lds, const float* W, int ldw, int K, int n0, const Fin& fin) {
    int tid_ = threadIdx.x; asm volatile("" : "+v"(tid_));
    const int tid = tid_, lane = tid & 63, wave = __builtin_amdgcn_readfirstlane(tid >> 6);
    const LAS f32x4* A = (const LAS f32x4*)lds;
    float acc[8];
#pragma unroll
    for (int r = 0; r < 8; ++r) acc[r] = 0.f;
    const int ks = K / 8, k0 = wave * ks;
    const float* wp = W + (size_t)k0 * ldw + n0 + lane;
#pragma unroll 4
    for (int k = 0; k < ks; ++k) {
        const float w = wp[(size_t)k * ldw]; const f32x4 a0 = A[(k0 + k) * 2], a1 = A[(k0 + k) * 2 + 1];
        acc[0] += a0[0] * w; acc[1] += a0[1] * w; acc[2] += a0[2] * w; acc[3] += a0[3] * w;
        acc[4] += a1[0] * w; acc[5] += a1[1] * w; acc[6] += a1[2] * w; acc[7] += a1[3] * w;
    }
    LAS float* red = (LAS float*)(lds + RED_OFF);
#pragma unroll
    for (int r = 0; r < 8; ++r) red[(wave * 8 + r) * 64 + lane] = acc[r];
    __syncthreads();
    { float s = 0.f;
#pragma unroll
      for (int w = 0; w < 8; ++w) s += red[(w * 8 + wave) * 64 + lane];
      fin(wave, n0 + lane, s, lane); }
    __syncthreads();
}
__device__ __forceinline__ void prep_norm(LAS unsigned char* lds, const float* xsrc, const float* g) {
    int tid_ = threadIdx.x; asm volatile("" : "+v"(tid_));
    const int lane = tid_ & 63, r = __builtin_amdgcn_readfirstlane(tid_ >> 6);
    const float* xr = xsrc + (size_t)r * SEQ * D;
    float v[16]; float s = 0.f;
#pragma unroll
    for (int j = 0; j < 16; ++j) { v[j] = xr[lane + 64 * j]; s += v[j] * v[j]; }
    s = wave_sum(s);
    const float rs = 1.f / sqrtf(s * (1.f / 1024.f) + EPS);
    LAS float* A = (LAS float*)lds;
#pragma unroll
    for (int j = 0; j < 16; ++j) { const int k = lane + 64 * j; A[k * 8 + r] = v[j] * g[k] * rs; }
    __syncthreads();
}
__device__ __forceinline__ float silu_(float x) { return x / (1.f + __expf(-x)); }
__device__ __forceinline__ float sigm_(float x) { return 1.f / (1.f + __expf(-x)); }
}

struct Args { const float* in[14]; float* out; unsigned char* ws; };

__device__ __forceinline__ int rope_prow(int n) { if (n >= 1536 && n < 2560) { const int j = (n - 1536) & 127, base = n - j; return base + (j < 64 ? 2 * j : 2 * (j - 64) + 1); } return n; }
__device__ __forceinline__ void transpose_item(const float* W, int K, int N, bf16_t* WT, int ldt, int koff, bool perm, LAS float* scr, int item, int lane) {
    const int nblk = N / 32, kb = item / nblk, nb = item % nblk, k0 = 64 * kb, n0 = 32 * nb;
#pragma unroll 8
    for (int i = 0; i < 32; ++i) { const int kk = 2 * i + (lane >> 5); scr[kk * 33 + (lane & 31)] = W[(size_t)(k0 + kk) * N + n0 + (lane & 31)]; }
    asm volatile("s_waitcnt lgkmcnt(0)" ::: "memory");
    const int c = lane & 7;
#pragma unroll
    for (int j = 0; j < 4; ++j) { const int n = (lane >> 3) + 8 * j; const LAS float* s = scr + (8 * c) * 33 + n;
        u32x4 o; o.x = pk_bf16(s[0 * 33], s[1 * 33]); o.y = pk_bf16(s[2 * 33], s[3 * 33]); o.z = pk_bf16(s[4 * 33], s[5 * 33]); o.w = pk_bf16(s[6 * 33], s[7 * 33]);
        const int dr = perm ? rope_prow(n0 + n) : (n0 + n);
        *(u32x4*)(WT + (size_t)dr * ldt + koff + k0 + 8 * c) = o; }
    asm volatile("s_waitcnt lgkmcnt(0)" ::: "memory");
}
__device__ __forceinline__ void convert_mixer(const Args& a, int l, LAS unsigned char* lds, int gw, int NGW, int wave, int lane) {
    LAS float* scr = (LAS float*)(lds + wave * 16384);
    bf16_t* win = (bf16_t*)(a.ws + WS_WIN); bf16_t* wcat = (bf16_t*)(a.ws + WS_WCAT); bf16_t* wo = (bf16_t*)(a.ws + WS_WO);
    const float* w_in = a.in[2] + (size_t)l * D * IN_COLS; const float* sbw = a.in[4] + (size_t)l * 512 * D;
    const float* rw = a.in[6] + (size_t)l * D * D; const float* w_o = a.in[7] + (size_t)l * D * D;
    constexpr int I0 = (D / 64) * (IN_COLS / 32), I1 = (512 / 64) * (D / 32), I2 = (D / 64) * (D / 32), I3 = I2;
    for (int it = gw; it < I0 + I1 + I2 + I3; it += NGW) {
        int r = it;
        if (r < I0) { transpose_item(w_in, D, IN_COLS, win, D, 0, true, scr, r, lane); continue; } r -= I0;
        if (r < I1) { transpose_item(sbw, 512, D, wcat, 1536, 0, false, scr, r, lane); continue; } r -= I1;
        if (r < I2) { transpose_item(rw, D, D, wcat, 1536, 512, false, scr, r, lane); continue; } r -= I2;
        transpose_item(w_o, D, D, wo, D, 0, false, scr, r, lane);
    }
}
__device__ __forceinline__ void convert_ffn(const Args& a, int l, LAS unsigned char* lds, int gw, int NGW, int wave, int lane) {
    LAS float* scr = (LAS float*)(lds + wave * 16384);
    bf16_t* wup = (bf16_t*)(a.ws + WS_WUP); bf16_t* wdn = (bf16_t*)(a.ws + WS_WDN);
    const float* w_up = a.in[9] + (size_t)l * D * U_LD; const float* w_dn = a.in[12] + (size_t)l * FF * D;
    constexpr int I0 = (D / 64) * (U_LD / 32), I1 = (FF / 64) * (D / 32);
    for (int it = gw; it < I0 + I1; it += NGW) {
        int r = it;
        if (r < I0) { transpose_item(w_up, D, U_LD, wup, D, 0, false, scr, r, lane); continue; } r -= I0;
        transpose_item(w_dn, FF, D, wdn, FF, 0, false, scr, r, lane);
    }
}

__global__ void __launch_bounds__(512, 2) fwd_kernel(Args a) {
    extern __shared__ __attribute__((aligned(16))) unsigned char lds_raw[];
    LAS unsigned char* lds = (LAS unsigned char*)lds_raw;
    cg::grid_group grid = cg::this_grid();
    const int G = gridDim.x, bx = blockIdx.x;
    const int vcu = (G % 8 == 0) ? (bx % 8) * (G / 8) + bx / 8 : bx;
    const int NGW = G * 8, NGT = G * 512;
#define PHASE_IDS() int tid_ = threadIdx.x; asm volatile("" : "+v"(tid_)); const int tid = tid_, lane = tid & 63, wave = __builtin_amdgcn_readfirstlane(tid >> 6); \
    const int gw = vcu * 8 + wave, gtid = bx * 512 + tid; (void)gw; (void)gtid; (void)lane;
    unsigned char* ws = a.ws;
    float* ssq = (float*)(ws + WS_SSQ);
    f32x4* rope = (f32x4*)(ws + WS_ROPE);
    bf16_t* win = (bf16_t*)(ws + WS_WIN); bf16_t* wcat = (bf16_t*)(ws + WS_WCAT); bf16_t* wo = (bf16_t*)(ws + WS_WO);
    bf16_t* XN = (bf16_t*)(ws + WS_XN); bf16_t* PA = (bf16_t*)(ws + WS_PROJ); bf16_t* PB = (bf16_t*)(ws + WS_PB); bf16_t* U = (bf16_t*)(ws + WS_PROJ);
    bf16_t* wup = (bf16_t*)(ws + WS_WUP); bf16_t* wdn = (bf16_t*)(ws + WS_WDN);
    const float* x = a.in[0]; float* out = a.out;
    float* SP = (float*)(ws + WS_SP); float* YB = (float*)(ws + WS_YB); float* UU = (float*)(ws + WS_UU);

    {
    PHASE_IDS();
    convert_mixer(a, 0, lds, gw, NGW, wave, lane);
    for (int i = gtid; i < 4096 * 64; i += NGT) {
        const int pos = i >> 6, k = i & 63;
        const float inv = __builtin_exp2f(-(float)k * (13.287712379549449f / 64.f));
        const double ang = (double)((float)pos * inv);
        double rev = ang * 0.15915494309189535; rev -= __builtin_rint(rev);
        f32x2 cs; cs.x = __builtin_amdgcn_cosf((float)rev); cs.y = __builtin_amdgcn_sinf((float)rev);
        ((f32x2*)rope)[i] = cs;
    }
    for (int i = gtid; i < 4 * M; i += NGT) ssq[M + i] = 0.f;
    {
        const float* g0 = a.in[1];
        for (int m = gw; m < M; m += NGW) {
            const f32x4* xr = (const f32x4*)(x + (size_t)m * D) + lane; const f32x4* gr = (const f32x4*)g0 + lane;
            f32x4 v[4]; float s = 0.f;
#pragma unroll
            for (int j = 0; j < 4; ++j) { v[j] = xr[64 * j]; s += (v[j][0] * v[j][0] + v[j][1] * v[j][1]) + (v[j][2] * v[j][2] + v[j][3] * v[j][3]); }
            s = wave_sum(s);
            if (lane == 0) ssq[m] = s;
            u32x2* o8 = (u32x2*)(XN + (size_t)m * D) + lane;
#pragma unroll
            for (int j = 0; j < 4; ++j) { const f32x4 w = v[j] * gr[64 * j]; u32x2 o; o.x = pk_bf16(w[0], w[1]); o.y = pk_bf16(w[2], w[3]); o8[64 * j] = o; }
        }
    }
    }
    grid.sync();

#pragma unroll 1
    for (int l = 0; l < 2; ++l) {
        const float* bgate = a.in[3] + (size_t)l * 2048;
        if (bx < 80) {
            side::prep_norm(lds, (l == 0) ? x : out, a.in[1] + (size_t)l * D);
            const float* w_in = a.in[2] + (size_t)l * D * IN_COLS;
            for (int it = bx; it < 80; it += G)
                side::gemv_item(lds, w_in, IN_COLS, D, 1536 + it * 64, [&](int r, int col, float s, int) { SP[r * IN_COLS + col] = s; });
        }
        {
            pg8::Gemm g{XN, win, D, D, M, IN_COLS, D}; pg8::StaticOrder S; S.init(M, IN_COLS, G, bx);
            Epi<1> E; E.p = EpiP{}; E.p.ssq = ssq + (size_t)(2 * l) * M; E.p.PA = PA; E.p.PB = PB; E.p.rope = rope;
            pg8::gemm_phase(lds, g, S, E);
        }
        grid.sync();
        if (bx < 16) {
            {
                PHASE_IDS();
                const int r = wave, hh = lane >> 4, sub = lane & 15;
                const float* sp = SP + (size_t)r * IN_COLS;
                float dq = 0.f;
#pragma unroll
                for (int j = 0; j < 8; ++j) dq += sp[1536 + hh * 128 + sub * 8 + j] * sp[2048 + hh * 128 + sub * 8 + j];
#pragma unroll
                for (int o = 1; o < 16; o <<= 1) dq += __shfl_xor(dq, o);
                const float w0 = dq * 0.08838834764831845f;
                float ov[16]; float s = 0.f;
#pragma unroll
                for (int j = 0; j < 16; ++j) { ov[j] = w0 * sp[2560 + hh * 256 + sub * 16 + j]; s += ov[j]; }
#pragma unroll
                for (int o = 1; o < 16; o <<= 1) s += __shfl_xor(s, o);
                const float mu = s * (1.f / 256.f); float q = 0.f;
#pragma unroll
                for (int j = 0; j < 16; ++j) { ov[j] -= mu; q += ov[j] * ov[j]; }
#pragma unroll
                for (int o = 1; o < 16; o <<= 1) q += __shfl_xor(q, o);
                const float rstd = 1.f / sqrtf(q * (1.f / 256.f) + EPS);
                const float* rn = a.in[5] + (size_t)l * D;
                LAS float* A = (LAS float*)lds;
#pragma unroll
                for (int j = 0; j < 16; ++j) { const int e = hh * 256 + sub * 16 + j; A[e * 8 + r] = ov[j] * rstd * rn[e] * side::silu_(sp[3584 + e]); }
                __syncthreads();
            }
            const float* rw = a.in[6] + (size_t)l * D * D;
            for (int it = bx; it < 16; it += G)
                side::gemv_item(lds, rw, D, D, it * 64, [&](int r, int col, float s, int) { YB[r * D + col] = s; });
        }
        for (int j = vcu; j < 256; j += G) ret::item(j >> 5, (j >> 3) & 3, j & 7, PA, (LAS char*)lds);
        for (int j = vcu; j < 256; j += G) {
            const int bh = j >> 2, s = j & 3;
            sb::unit(bh >> 3, bh & 7, 15 - s, PA, (LAS char*)lds);
            sb::unit(bh >> 3, bh & 7, 8 + s, PA, (LAS char*)lds);
            sb::unit(bh >> 3, bh & 7, 7 - s, PA, (LAS char*)lds);
            sb::unit(bh >> 3, bh & 7, s, PA, (LAS char*)lds);
        }
        grid.sync();
        if (bx < 16) {
            {
                PHASE_IDS();
                LAS float* A = (LAS float*)lds;
                for (int i = tid; i < 8 * D; i += 512) { const int r = i >> 10, k = i & 1023; A[k * 8 + r] = side::sigm_(SP[(size_t)r * IN_COLS + 5632 + k] + bgate[1024 + k]) * YB[r * D + k]; }
                __syncthreads();
            }
            const float* w_o = a.in[7] + (size_t)l * D * D; const float* xsrc = (l == 0) ? x : out; const float* gf = a.in[8] + (size_t)l * D;
            float* sq = ssq + (size_t)(2 * l + 1) * M;
            for (int it = bx; it < 16; it += G)
                side::gemv_item(lds, w_o, D, D, it * 64, [&](int r, int col, float s, int ln) {
                    const size_t off = (size_t)r * SEQ * D + col; const float x1 = xsrc[off] + s; out[off] = x1;
                    XN[off] = (bf16_t)(pk_bf16(x1 * gf[col], 0.f) & 0xffffu);
                    const float t = wave_sum(x1 * x1); if (ln == 0) unsafeAtomicAdd(sq + (size_t)r * SEQ, t); });
        }
        {
            PHASE_IDS();
            const float* rg = a.in[5] + (size_t)l * D;
            for (int m = gw; m < M; m += NGW) {
                bf16_t* op = PA + (size_t)m * PA_LD + 2560 + 16 * lane; const bf16_t* gp = PB + (size_t)m * PB_LD + 16 * lane;
                const u32x4 o0 = *(const u32x4*)op, o1 = *(const u32x4*)(op + 8), g0 = *(const u32x4*)gp, g1 = *(const u32x4*)(gp + 8);
                float v[16], gv[16];
                v[0] = bf_lo(o0.x); v[1] = bf_hi(o0.x); v[2] = bf_lo(o0.y); v[3] = bf_hi(o0.y); v[4] = bf_lo(o0.z); v[5] = bf_hi(o0.z); v[6] = bf_lo(o0.w); v[7] = bf_hi(o0.w);
                v[8] = bf_lo(o1.x); v[9] = bf_hi(o1.x); v[10] = bf_lo(o1.y); v[11] = bf_hi(o1.y); v[12] = bf_lo(o1.z); v[13] = bf_hi(o1.z); v[14] = bf_lo(o1.w); v[15] = bf_hi(o1.w);
                gv[0] = bf_lo(g0.x); gv[1] = bf_hi(g0.x); gv[2] = bf_lo(g0.y); gv[3] = bf_hi(g0.y); gv[4] = bf_lo(g0.z); gv[5] = bf_hi(g0.z); gv[6] = bf_lo(g0.w); gv[7] = bf_hi(g0.w);
                gv[8] = bf_lo(g1.x); gv[9] = bf_hi(g1.x); gv[10] = bf_lo(g1.y); gv[11] = bf_hi(g1.y); gv[12] = bf_lo(g1.z); gv[13] = bf_hi(g1.z); gv[14] = bf_lo(g1.w); gv[15] = bf_hi(g1.w);
                float s = 0.f;
#pragma unroll
                for (int k = 0; k < 16; ++k) s += v[k];
#pragma unroll
                for (int o = 1; o < 16; o <<= 1) s += __shfl_xor(s, o);
                const float mu = s * (1.f / 256.f); float q = 0.f;
#pragma unroll
                for (int k = 0; k < 16; ++k) { v[k] -= mu; q += v[k] * v[k]; }
#pragma unroll
                for (int o = 1; o < 16; o <<= 1) q += __shfl_xor(q, o);
                const float rstd = __builtin_amdgcn_rsqf(q * (1.f / 256.f) + EPS);
                const f32x4* rgp = (const f32x4*)(rg + 16 * lane);
                unsigned w[8];
#pragma unroll
                for (int k4 = 0; k4 < 4; ++k4) { const f32x4 gg = rgp[k4];
                    float y[4];
#pragma unroll
                    for (int k = 0; k < 4; ++k) { const float gx = gv[4 * k4 + k]; y[k] = v[4 * k4 + k] * rstd * gg[k] * gx * sigmoidf_(gx); }
                    w[2 * k4] = pk_bf16(y[0], y[1]); w[2 * k4 + 1] = pk_bf16(y[2], y[3]); }
                *(u32x4*)op = (u32x4){w[0], w[1], w[2], w[3]}; *(u32x4*)(op + 8) = (u32x4){w[4], w[5], w[6], w[7]};
            }
            __syncthreads();
            pg8::Gemm g{PA, wcat, PA_LD, 1536, M, D, 512}; pg8::StaticOrder S; S.init(M, D, G, bx);
            Epi<2> E; E.p = EpiP{}; E.p.PA = PA; E.p.PB = PB; E.p.bgate = bgate;
            pg8::gemm_phase(lds, g, S, E);
        }
        grid.sync();
        {
            pg8::Gemm g{PA + 2560, wcat + 512, PA_LD, 1536, M, D, D}; pg8::StaticOrder S; S.init(M, D, G, bx);
            Epi<3> E; E.p = EpiP{}; E.p.PA = PA; E.p.PB = PB; E.p.bgate = bgate;
            pg8::gemm_phase(lds, g, S, E);
        }
        grid.sync();
        if (bx < 88) {
            side::prep_norm(lds, out, a.in[8] + (size_t)l * D);
            const float* w_up = a.in[9] + (size_t)l * D * U_LD;
            for (int it = bx; it < 88; it += G)
                side::gemv_item(lds, w_up, U_LD, D, it * 64, [&](int r, int col, float s, int) { UU[r * U_LD + col] = s; });
        }
        {
            PHASE_IDS();
            convert_ffn(a, l, lds, gw, NGW, wave, lane);
            __syncthreads();
            pg8::Gemm g{PA + 1536, wo, PA_LD, D, M, D, D}; pg8::StaticOrder S; S.init(M, D, G, bx);
            Epi<4> E; E.p = EpiP{}; E.p.xin = (l == 0) ? x : out; E.p.xout = out; E.p.XN = XN; E.p.gnext = a.in[8] + (size_t)l * D; E.p.ssq_out = ssq + (size_t)(2 * l + 1) * M;
            pg8::gemm_phase(lds, g, S, E);
        }
        grid.sync();
        {
            PHASE_IDS();
            if (l == 0) { convert_mixer(a, 1, lds, gw, NGW, wave, lane); __syncthreads(); }
            pg8::Gemm g{XN, wup, D, D, M, U_LD, D}; pg8::StaticOrder S; S.init(M, U_LD, G, bx);
            Epi<5> E; E.p = EpiP{}; E.p.ssq = ssq + (size_t)(2 * l + 1) * M; E.p.U = U;
            pg8::gemm_phase(lds, g, S, E);
        }
        grid.sync();
        if (bx < 16) {
            {
                PHASE_IDS();
                const float* cw2 = a.in[10] + (size_t)l * 3 * FF + 2 * FF; const float* cbb = a.in[11] + (size_t)l * FF;
                LAS float* A = (LAS float*)lds;
                for (int i = tid; i < 8 * FF; i += 512) { const int r = i / FF, k = i - r * FF; A[k * 8 + r] = side::silu_(cw2[k] * UU[r * U_LD + k] + cbb[k]) * UU[r * U_LD + FF + k]; }
                __syncthreads();
            }
            const float* w_dn = a.in[12] + (size_t)l * FF * D; const float* gn = (l == 0) ? a.in[1] + D : a.in[13];
            float* sq = ssq + (size_t)(2 * l + 2) * M;
            for (int it = bx; it < 16; it += G)
                side::gemv_item(lds, w_dn, D, FF, it * 64, [&](int r, int col, float s, int ln) {
                    const size_t off = (size_t)r * SEQ * D + col; const float x2 = out[off] + s; out[off] = x2;
                    XN[off] = (bf16_t)(pk_bf16(x2 * gn[col], 0.f) & 0xffffu);
                    const float t = wave_sum(x2 * x2); if (ln == 0) unsafeAtomicAdd(sq + (size_t)r * SEQ, t); });
        }
        {
            PHASE_IDS();
            const float* cw = a.in[10] + (size_t)l * 3 * FF; const float* cb = a.in[11] + (size_t)l * FF;
            constexpr int NCH = FF / 8, NIT = (M / 8) * NCH;
            for (int it = gtid; it < NIT; it += NGT) {
                const int sbd = it / NCH, ch = it - sbd * NCH, r0 = sbd * 8, c0 = ch * 8;
                float w0[8], w1[8], w2[8], bsv[8];
#pragma unroll
                for (int k = 0; k < 8; ++k) { w0[k] = cw[c0 + k]; w1[k] = cw[FF + c0 + k]; w2[k] = cw[2 * FF + c0 + k]; bsv[k] = cb[c0 + k]; }
                float a2[8], a1[8];
                if ((r0 & 4095) == 0) {
#pragma unroll
                    for (int k = 0; k < 8; ++k) { a2[k] = 0.f; a1[k] = 0.f; }
                } else {
                    const u32x4 p2 = *(const u32x4*)(U + (size_t)(r0 - 2) * U_LD + c0), p1 = *(const u32x4*)(U + (size_t)(r0 - 1) * U_LD + c0);
                    a2[0] = bf_lo(p2.x); a2[1] = bf_hi(p2.x); a2[2] = bf_lo(p2.y); a2[3] = bf_hi(p2.y); a2[4] = bf_lo(p2.z); a2[5] = bf_hi(p2.z); a2[6] = bf_lo(p2.w); a2[7] = bf_hi(p2.w);
                    a1[0] = bf_lo(p1.x); a1[1] = bf_hi(p1.x); a1[2] = bf_lo(p1.y); a1[3] = bf_hi(p1.y); a1[4] = bf_lo(p1.z); a1[5] = bf_hi(p1.z); a1[6] = bf_lo(p1.w); a1[7] = bf_hi(p1.w);
                }
#pragma unroll
                for (int r = 0; r < 8; ++r) {
                    bf16_t* up = U + (size_t)(r0 + r) * U_LD + c0;
                    const u32x4 pa = *(const u32x4*)up, pb = *(const u32x4*)(up + FF);
                    float a0[8], bv[8], y[8];
                    a0[0] = bf_lo(pa.x); a0[1] = bf_hi(pa.x); a0[2] = bf_lo(pa.y); a0[3] = bf_hi(pa.y); a0[4] = bf_lo(pa.z); a0[5] = bf_hi(pa.z); a0[6] = bf_lo(pa.w); a0[7] = bf_hi(pa.w);
                    bv[0] = bf_lo(pb.x); bv[1] = bf_hi(pb.x); bv[2] = bf_lo(pb.y); bv[3] = bf_hi(pb.y); bv[4] = bf_lo(pb.z); bv[5] = bf_hi(pb.z); bv[6] = bf_lo(pb.w); bv[7] = bf_hi(pb.w);
#pragma unroll
                    for (int k = 0; k < 8; ++k) { const float cv = w0[k] * a2[k] + w1[k] * a1[k] + w2[k] * a0[k] + bsv[k]; y[k] = cv * sigmoidf_(cv) * bv[k]; a2[k] = a1[k]; a1[k] = a0[k]; }
                    *(u32x4*)(up + FF) = (u32x4){pk_bf16(y[0], y[1]), pk_bf16(y[2], y[3]), pk_bf16(y[4], y[5]), pk_bf16(y[6], y[7])};
                }
            }
        }
        grid.sync();
        {
            pg8::Gemm g{U + FF, wdn, U_LD, FF, M, D, FF}; pg8::StaticOrder S; S.init(M, D, G, bx);
            Epi<4> E; E.p = EpiP{}; E.p.xin = out; E.p.xout = out; E.p.XN = XN; E.p.gnext = (l == 0) ? a.in[1] + D : a.in[13]; E.p.ssq_out = ssq + (size_t)(2 * l + 2) * M;
            pg8::gemm_phase(lds, g, S, E);
        }
        grid.sync();
    }
    {
        PHASE_IDS();
        const float* gf = a.in[13]; const float* sq = ssq + (size_t)4 * M;
        for (int m = gw; m < M; m += NGW) {
            f32x4* xr = (f32x4*)(out + (size_t)m * D) + lane; const f32x4* gr = (const f32x4*)gf + lane;
            const float rs = __builtin_amdgcn_rsqf(sq[m] * (1.f / 1024.f) + EPS);
#pragma unroll
            for (int j = 0; j < 4; ++j) { const f32x4 v = xr[64 * j]; xr[64 * j] = v * rs * gr[64 * j]; }
        }
    }
}

constexpr int LDS_BYTES = 131072 + 1024;
static_assert(ret::LDS_BYTES <= 131072 && sb::LDS_BYTES <= 131072 && pg8::STAGE_BYTES <= 131072, "LDS map");

extern "C" void kernel_launch(void* const* d_in, const int* in_sizes, int n_in, void* d_out, int out_size, void* d_ws, size_t ws_size, hipStream_t stream) {
    static int grid = 0;
    if (grid == 0) {
        int dev = 0, cus = 0, per_cu = 0;
        hipGetDevice(&dev);
        hipDeviceGetAttribute(&cus, hipDeviceAttributeMultiprocessorCount, dev);
        hipFuncSetAttribute((const void*)fwd_kernel, hipFuncAttributeMaxDynamicSharedMemorySize, LDS_BYTES);
        hipOccupancyMaxActiveBlocksPerMultiprocessor(&per_cu, (const void*)fwd_kernel, 512, LDS_BYTES);
        (void)hipGetLastError();
        if (per_cu < 1) per_cu = 1;
        if (cus < 1) cus = 256;
        grid = cus;
        if (ws_size < WS_END) fprintf(stderr, "kernel_launch: workspace too small: %zu < %zu\n", ws_size, (size_t)WS_END);
    }
    Args a{};
    for (int i = 0; i < 14; ++i) a.in[i] = (const float*)d_in[i];
    a.out = (float*)d_out; a.ws = (unsigned char*)d_ws;
    void* args[] = {&a};
    hipError_t e = hipLaunchCooperativeKernel((const void*)fwd_kernel, dim3(grid), dim3(512), args, LDS_BYTES, stream);
    if (e != hipSuccess) fprintf(stderr, "cooperative launch failed: %s (grid %d)\n", hipGetErrorString(e), grid);
}
```

```cpp
#include <hip/hip_runtime.h>
#include <hip/hip_cooperative_groups.h>
#include <cstdio>
#include <cstdint>
namespace cg = cooperative_groups;

#define LAS __attribute__((address_space(3)))
typedef unsigned short bf16_t;
typedef short bf16x8 __attribute__((ext_vector_type(8)));
typedef short s16x4 __attribute__((ext_vector_type(4)));
typedef float f32x2 __attribute__((ext_vector_type(2)));
typedef float f32x4 __attribute__((ext_vector_type(4)));
typedef float f32x16 __attribute__((ext_vector_type(16)));
typedef unsigned u32x4 __attribute__((ext_vector_type(4)));
typedef unsigned u32x2 __attribute__((ext_vector_type(2)));

constexpr int M = 32768, D = 1024, SEQ = 4096, FF = 2816;
constexpr int IN_COLS = 6656, PA_LD = 3584, PB_LD = 3072, U_LD = 5632;
constexpr float EPS = 1e-6f;
constexpr float LOG2E = 1.4426950408889634f;

constexpr size_t MiB = 1u << 20;
constexpr size_t WS_SSQ = 0;
constexpr size_t WS_ROPE = 1 * MiB;
constexpr size_t WS_WIN = 3 * MiB;
constexpr size_t WS_WCAT = 16 * MiB;
constexpr size_t WS_WO = 19 * MiB;
constexpr size_t WS_XN = 21 * MiB;
constexpr size_t WS_PROJ = 85 * MiB;
constexpr size_t WS_PB = WS_PROJ + 224 * MiB;
constexpr size_t WS_WUP = WS_PROJ + 352 * MiB;
constexpr size_t WS_WDN = WS_WUP + 11 * MiB;
constexpr size_t WS_END0 = WS_PROJ + 416 * MiB;
constexpr size_t WS_SIDE = WS_END0;
constexpr int SD_SP = 0, SD_YB = 8 * 6656, SD_MO = SD_YB + 8 * 1024, SD_UU = SD_MO + 8 * 1024, SD_DD = SD_UU + 8 * 5632, SD_LAYER = SD_DD + 8 * 1024;
constexpr size_t WS_XS = WS_SIDE + (size_t)2 * SD_LAYER * 4;
constexpr size_t WS_END = WS_XS + 8 * 1024 * 4;

__device__ __forceinline__ unsigned pk_bf16(float lo, float hi) {
    typedef __bf16 b2 __attribute__((ext_vector_type(2))); f32x2 v = {lo, hi}; b2 b = __builtin_convertvector(v, b2); return __builtin_bit_cast(unsigned, b);
}
__device__ __forceinline__ float bf_lo(unsigned w) { return __uint_as_float(w << 16); }
__device__ __forceinline__ float bf_hi(unsigned w) { return __uint_as_float(w & 0xffff0000u); }
__device__ __forceinline__ float sigmoidf_(float x) { return __builtin_amdgcn_rcpf(1.f + __builtin_amdgcn_exp2f(-x * LOG2E)); }
__device__ __forceinline__ float wave_sum(float v) {
#pragma unroll
    for (int o = 1; o < 64; o <<= 1) v += __shfl_xor(v, o);
    return v;
}

namespace pg8 {
constexpr int BM = 256, BK = 64, HALF = 128, HTB = HALF * BK * 2, STAGE_BYTES = 8 * HTB, NXCD = 8, WGM = 8;
__host__ __device__ __forceinline__ int lds_byte(int r, int c) { const int st = (r >> 4) * 2 + (c >> 5), rr = r & 15, cc = c & 31, ob = rr * 64 + cc * 2; return st * 1024 + (ob ^ (((ob >> 9) & 1) << 5)); }
__host__ __device__ __forceinline__ void stage_rc(int b, int& R, int& C) { const int st = b / 1024, sb = b % 1024, swz = sb ^ (((sb >> 9) & 1) << 5); R = (st >> 1) * 16 + swz / 64; C = (st & 1) * 32 + (swz % 64) / 2; }
__host__ __device__ __forceinline__ int perm32(int rho) { const int n = rho >> 4, i = rho & 15; return 8 * (i >> 2) + 4 * n + (i & 3); }

struct Unit { int pm, pn; };
struct Gemm { const bf16_t* A; const bf16_t* Bt; int lda, ldb, M, N, K; };

struct StaticOrder {
    int nM, nN, nwg, G, c;
    __device__ void init(int M_, int N_, int G_, int c_) { nM = M_ / BM; nN = N_ / BM; nwg = nM * nN; G = G_; c = c_; }
    __device__ bool next(int i, Unit& u) const {
        const long L = (long)i * G + c; if (L >= nwg) return false;
        int wgid = (int)L; { const int q = nwg / NXCD, r = nwg % NXCD, xcd = wgid % NXCD, off = wgid / NXCD; wgid = (xcd < r ? xcd * (q + 1) : r * (q + 1) + (xcd - r) * q) + off; }
        const int nig = WGM * nN, gid = wgid / nig, fm = gid * WGM, gsz = (nM - fm) < WGM ? (nM - fm) : WGM;
        u.pm = fm + ((wgid % nig) % gsz); u.pn = (wgid % nig) / gsz; return true;
    }
};

template <class Epi>
__device__ __forceinline__ void gemm_phase(LAS unsigned char* lds, const Gemm g, const StaticOrder& S, const Epi& E) {
    int tid_ = threadIdx.x; asm volatile("" : "+v"(tid_));
    const int tid = tid_, wid = __builtin_amdgcn_readfirstlane(tid >> 6), lane = tid & 63, wr = wid >> 2, wc = wid & 3, fr = lane & 15, fq = lane >> 4;
    const int K = g.K, nt = K / BK;
    unsigned voffA[2], voffB[2];
#pragma unroll
    for (int i = 0; i < 2; ++i) { int R, C; stage_rc(tid * 16 + i * 8192, R, C); const int Rb = (R & ~31) + perm32(R & 31);
        voffA[i] = (unsigned)(R * g.lda + C) * 2u; voffB[i] = (unsigned)(Rb * g.ldb + C) * 2u; }
    const size_t kstep = (size_t)(BK * 2);
    const size_t hstepA = (size_t)HALF * g.lda * 2, hstepB = (size_t)HALF * g.ldb * 2;
    const size_t tstepA = 2 * hstepA, tstepB = 2 * hstepB;
    const unsigned ldsw = (unsigned)wid * 1024u;
    const int aoff = lds_byte(wr * 64 + fr, fq * 8), boff = lds_byte(wc * 32 + fr, fq * 8);
#define PG8_SA(b, h) (((b) * 2 + (h)) * HTB)
#define PG8_SB(b, h) ((4 + (b) * 2 + (h)) * HTB)
#define PG8_STAGE(bufoff, gbase, voff) do { _Pragma("unroll") for (int _i = 0; _i < 2; ++_i) \
        __builtin_amdgcn_global_load_lds((const unsigned*)((const char*)(gbase) + (voff)[_i]), (LAS unsigned*)(lds + (bufoff) + ldsw + _i * 8192), 16, 0, 0); } while (0)
#define PG8_LDA(dst, b, h) do { _Pragma("unroll") for (int m = 0; m < 4; ++m) _Pragma("unroll") for (int k = 0; k < 2; ++k) dst[m][k] = *(const LAS bf16x8*)(lds + PG8_SA(b, h) + aoff + m * 2048 + k * 1024); } while (0)
#define PG8_LDB(dst, b, h) do { _Pragma("unroll") for (int n = 0; n < 2; ++n) _Pragma("unroll") for (int k = 0; k < 2; ++k) dst[n][k] = *(const LAS bf16x8*)(lds + PG8_SB(b, h) + boff + n * 2048 + k * 1024); } while (0)
#define PG8_MMA(ai, bj, At, Bt) do { __builtin_amdgcn_s_setprio(1); _Pragma("unroll") for (int m = 0; m < 4; ++m) _Pragma("unroll") for (int n = 0; n < 2; ++n) _Pragma("unroll") for (int k = 0; k < 2; ++k) \
        acc[ai][bj][m][n] = __builtin_amdgcn_mfma_f32_16x16x32_bf16(Bt[n][k], At[m][k], acc[ai][bj][m][n], 0, 0, 0); __builtin_amdgcn_s_setprio(0); } while (0)
#define PG8_WAIT_V(n) asm volatile("s_waitcnt vmcnt(" #n ")" ::: "memory")
#define PG8_WAIT_L(n) asm volatile("s_waitcnt lgkmcnt(" #n ")" ::: "memory")
#define PG8_BAR __builtin_amdgcn_s_barrier()
#define PG8_SCHED __builtin_amdgcn_sched_barrier(0)
    Unit cur, nxt; int ui = 0;
    if (!S.next(0, cur)) return;
    f32x4 acc[2][2][4][2];
#pragma unroll
    for (int a = 0; a < 2; ++a)
#pragma unroll
        for (int b = 0; b < 2; ++b)
#pragma unroll
            for (int m = 0; m < 4; ++m)
#pragma unroll
                for (int n = 0; n < 2; ++n) acc[a][b][m][n] = (f32x4){0.f, 0.f, 0.f, 0.f};
    bf16x8 At[4][2], B0[2][2], B1[2][2];
    const char* cA = (const char*)g.A + (size_t)cur.pm * tstepA; const char* cB = (const char*)g.Bt + (size_t)cur.pn * tstepB;
    PG8_STAGE(PG8_SB(0, 0), cB, voffB); PG8_STAGE(PG8_SB(0, 1), cB + hstepB, voffB); PG8_STAGE(PG8_SA(0, 0), cA, voffA); PG8_STAGE(PG8_SA(0, 1), cA + hstepA, voffA);
    if (wr == 1) PG8_BAR;
    PG8_WAIT_V(2); PG8_BAR;
    PG8_STAGE(PG8_SB(1, 0), cB + kstep, voffB); PG8_STAGE(PG8_SA(1, 0), cA + kstep, voffA); PG8_STAGE(PG8_SB(1, 1), cB + hstepB + kstep, voffB);
    PG8_WAIT_V(6); PG8_BAR;
    for (;;) {
        const bool has_next = S.next(ui + 1, nxt);
        const char* nA = has_next ? (const char*)g.A + (size_t)nxt.pm * tstepA : cA; const char* nB = has_next ? (const char*)g.Bt + (size_t)nxt.pn * tstepB : cB;
        for (int t = 0; t < nt; t += 2) {
            const bool last = (t == nt - 2);
            const char* a1 = cA + (size_t)(t + 1) * kstep;
            const char* a2 = last ? nA : cA + (size_t)(t + 2) * kstep; const char* b2 = last ? nB : cB + (size_t)(t + 2) * kstep;
            const char* a3 = a2 + kstep; const char* b3 = b2 + kstep;
            PG8_LDB(B0, 0, 0); PG8_LDB(B1, 0, 1); PG8_SCHED; PG8_LDA(At, 0, 0); PG8_STAGE(PG8_SA(1, 1), a1 + hstepA, voffA);
            PG8_WAIT_V(8); PG8_WAIT_L(0); PG8_BAR; PG8_MMA(0, 0, At, B0); PG8_MMA(0, 1, At, B1); PG8_BAR; PG8_SCHED;
            PG8_LDA(At, 0, 1); PG8_STAGE(PG8_SB(0, 0), b2, voffB); PG8_STAGE(PG8_SB(0, 1), b2 + hstepB, voffB); PG8_STAGE(PG8_SA(0, 0), a2, voffA);
            PG8_WAIT_V(8); PG8_WAIT_L(0); PG8_BAR; PG8_MMA(1, 0, At, B0); PG8_MMA(1, 1, At, B1); PG8_BAR; PG8_SCHED;
            PG8_LDB(B0, 1, 0); PG8_LDB(B1, 1, 1); PG8_SCHED; PG8_LDA(At, 1, 0); PG8_STAGE(PG8_SA(0, 1), a2 + hstepA, voffA);
            PG8_WAIT_V(8); PG8_WAIT_L(0); PG8_BAR; PG8_MMA(0, 0, At, B0); PG8_MMA(0, 1, At, B1); PG8_BAR; PG8_SCHED;
            PG8_LDA(At, 1, 1); PG8_STAGE(PG8_SB(1, 0), b3, voffB); PG8_STAGE(PG8_SB(1, 1), b3 + hstepB, voffB); PG8_STAGE(PG8_SA(1, 0), a3, voffA);
            PG8_WAIT_V(8); PG8_WAIT_L(0); PG8_BAR; PG8_MMA(1, 0, At, B0); PG8_MMA(1, 1, At, B1); PG8_BAR; PG8_SCHED;
        }
        if (wr == 0) PG8_BAR;
        E(acc, cur, wr, wc, fr, fq);
        if (!has_next) break;
#pragma unroll
        for (int a = 0; a < 2; ++a)
#pragma unroll
            for (int b = 0; b < 2; ++b)
#pragma unroll
                for (int m = 0; m < 4; ++m)
#pragma unroll
                    for (int n = 0; n < 2; ++n) acc[a][b][m][n] = (f32x4){0.f, 0.f, 0.f, 0.f};
        cur = nxt; cA = nA; cB = nB; ++ui;
        if (wr == 1) PG8_BAR;
    }
    PG8_WAIT_V(0);
    PG8_BAR;
#undef PG8_SA
#undef PG8_SB
#undef PG8_STAGE
#undef PG8_LDA
#undef PG8_LDB
#undef PG8_MMA
#undef PG8_WAIT_V
#undef PG8_WAIT_L
#undef PG8_BAR
#undef PG8_SCHED
}
}

struct EpiP {
    const float* ssq;
    bf16_t* PA; bf16_t* PB;
    const f32x4* rope;
    const float* bgate;
    const float* xin; float* xout; bf16_t* XN; const float* gnext; float* ssq_out;
    bf16_t* U;
};
template <int MODE> struct Epi {
    EpiP p;
    __device__ __forceinline__ void operator()(const f32x4 (&acc)[2][2][4][2], const pg8::Unit& u, int wr, int wc, int fr, int fq) const {
        const int pn = u.pn;
        const int rowb = u.pm * 256 + wr * 64 + fr;
        const int colw = wc * 32 + 8 * fq;
        if constexpr (MODE == 1) {
            bf16_t* O; int ldc, cb;
            if (pn < 14) { O = p.PA; ldc = PA_LD; cb = pn * 256; } else { O = p.PB; ldc = PB_LD; cb = (pn - 14) * 256; }
            const int kind = (pn < 2) ? 1 : (pn >= 6 && pn < 8) ? 2 : (pn >= 8 && pn < 10) ? 3 : 0;
#pragma unroll
            for (int ai = 0; ai < 2; ++ai)
#pragma unroll
                for (int m = 0; m < 4; ++m) {
                    const int row = rowb + ai * 128 + m * 16;
                    float sc = __builtin_amdgcn_rsqf(p.ssq[row] * (1.f / 1024.f) + EPS);
                    if (kind == 1) sc *= 0.125f * LOG2E;
#pragma unroll
                    for (int bj = 0; bj < 2; ++bj) {
                        f32x4 v0 = acc[ai][bj][m][0] * sc, v1 = acc[ai][bj][m][1] * sc;
                        if (kind >= 2) {
                            const int head = (pn - (kind == 2 ? 6 : 8)) * 2 + bj;
                            const float lg = __builtin_log2f(1.f - __builtin_exp2f(-5.f - (float)head));
                            const float e = (float)((row & 127) + 1) * lg;
                            const float dsc = (kind == 2) ? __builtin_amdgcn_exp2f(e) * 0.08838834764831845f : __builtin_amdgcn_exp2f(-e);
                            const f32x4* rp = p.rope + ((size_t)(row & 4095) * 64 + wc * 16 + 4 * fq) / 2;
                            const f32x4 c01 = rp[0], c23 = rp[1];
                            f32x4 w0, w1;
                            w0[0] = (v0[0] * c01[0] - v0[1] * c01[1]) * dsc; w0[1] = (v0[0] * c01[1] + v0[1] * c01[0]) * dsc;
                            w0[2] = (v0[2] * c01[2] - v0[3] * c01[3]) * dsc; w0[3] = (v0[2] * c01[3] + v0[3] * c01[2]) * dsc;
                            w1[0] = (v1[0] * c23[0] - v1[1] * c23[1]) * dsc; w1[1] = (v1[0] * c23[1] + v1[1] * c23[0]) * dsc;
                            w1[2] = (v1[2] * c23[2] - v1[3] * c23[3]) * dsc; w1[3] = (v1[2] * c23[3] + v1[3] * c23[2]) * dsc;
                            v0 = w0; v1 = w1;
                        }
                        u32x4 w; w.x = pk_bf16(v0[0], v0[1]); w.y = pk_bf16(v0[2], v0[3]); w.z = pk_bf16(v1[0], v1[1]); w.w = pk_bf16(v1[2], v1[3]);
                        *(u32x4*)(O + (size_t)row * ldc + cb + bj * 128 + colw) = w;
                    }
                }
        } else if constexpr (MODE == 2 || MODE == 3) {
            const int goff = (MODE == 2) ? 1024 : 2048, boff = (MODE == 2) ? 0 : 1024;
            f32x4 bb[2][2];
#pragma unroll
            for (int bj = 0; bj < 2; ++bj) { const int col = pn * 256 + bj * 128 + colw; bb[bj][0] = *(const f32x4*)(p.bgate + boff + col); bb[bj][1] = *(const f32x4*)(p.bgate + boff + col + 4); }
#pragma unroll
            for (int ai = 0; ai < 2; ++ai)
#pragma unroll
                for (int m = 0; m < 4; ++m) {
                    const int row = rowb + ai * 128 + m * 16;
#pragma unroll
                    for (int bj = 0; bj < 2; ++bj) {
                        const int col = pn * 256 + bj * 128 + colw;
                        const u32x4 gw = *(const u32x4*)(p.PB + (size_t)row * PB_LD + goff + col);
                        f32x4 g0, g1;
                        g0[0] = bf_lo(gw.x); g0[1] = bf_hi(gw.x); g0[2] = bf_lo(gw.y); g0[3] = bf_hi(gw.y);
                        g1[0] = bf_lo(gw.z); g1[1] = bf_hi(gw.z); g1[2] = bf_lo(gw.w); g1[3] = bf_hi(gw.w);
                        g0 += bb[bj][0]; g1 += bb[bj][1];
                        f32x4 v0 = acc[ai][bj][m][0], v1 = acc[ai][bj][m][1];
#pragma unroll
                        for (int k = 0; k < 4; ++k) { v0[k] *= sigmoidf_(g0[k]); v1[k] *= sigmoidf_(g1[k]); }
                        if constexpr (MODE == 3) {
                            const u32x4 tw = *(const u32x4*)(p.PA + (size_t)row * PA_LD + 512 + col);
                            v0[0] += bf_lo(tw.x); v0[1] += bf_hi(tw.x); v0[2] += bf_lo(tw.y); v0[3] += bf_hi(tw.y);
                            v1[0] += bf_lo(tw.z); v1[1] += bf_hi(tw.z); v1[2] += bf_lo(tw.w); v1[3] += bf_hi(tw.w);
                        }
                        u32x4 w; w.x = pk_bf16(v0[0], v0[1]); w.y = pk_bf16(v0[2], v0[3]); w.z = pk_bf16(v1[0], v1[1]); w.w = pk_bf16(v1[2], v1[3]);
                        *(u32x4*)(p.PA + (size_t)row * PA_LD + (MODE == 2 ? 512 : 1536) + col) = w;
                    }
                }
        } else if constexpr (MODE == 4) {
            f32x4 gg[2][2];
#pragma unroll
            for (int bj = 0; bj < 2; ++bj) { const int col = pn * 256 + bj * 128 + colw; gg[bj][0] = *(const f32x4*)(p.gnext + col); gg[bj][1] = *(const f32x4*)(p.gnext + col + 4); }
#pragma unroll
            for (int ai = 0; ai < 2; ++ai)
#pragma unroll
                for (int m = 0; m < 4; ++m) {
                    const int row = rowb + ai * 128 + m * 16;
                    const bool keep = (row & 4095) != 0;
                    float ss = 0.f;
#pragma unroll
                    for (int bj = 0; bj < 2; ++bj) {
                        const int col = pn * 256 + bj * 128 + colw;
                        const size_t off = (size_t)row * D + col;
                        f32x4 x0 = *(const f32x4*)(p.xin + off), x1 = *(const f32x4*)(p.xin + off + 4);
                        x0 += acc[ai][bj][m][0]; x1 += acc[ai][bj][m][1];
                        if (keep) { *(f32x4*)(p.xout + off) = x0; *(f32x4*)(p.xout + off + 4) = x1; }
                        ss += (x0[0] * x0[0] + x0[1] * x0[1]) + (x0[2] * x0[2] + x0[3] * x0[3]) + (x1[0] * x1[0] + x1[1] * x1[1]) + (x1[2] * x1[2] + x1[3] * x1[3]);
                        x0 *= gg[bj][0]; x1 *= gg[bj][1];
                        u32x4 w; w.x = pk_bf16(x0[0], x0[1]); w.y = pk_bf16(x0[2], x0[3]); w.z = pk_bf16(x1[0], x1[1]); w.w = pk_bf16(x1[2], x1[3]);
                        if (keep) *(u32x4*)(p.XN + off) = w;
                    }
                    ss += __shfl_xor(ss, 16); ss += __shfl_xor(ss, 32);
                    if (fq == 0 && keep) unsafeAtomicAdd(p.ssq_out + row, ss);
                }
        } else {
#pragma unroll
            for (int ai = 0; ai < 2; ++ai)
#pragma unroll
                for (int m = 0; m < 4; ++m) {
                    const int row = rowb + ai * 128 + m * 16;
                    const float sc = __builtin_amdgcn_rsqf(p.ssq[row] * (1.f / 1024.f) + EPS);
#pragma unroll
                    for (int bj = 0; bj < 2; ++bj) {
                        const f32x4 v0 = acc[ai][bj][m][0] * sc, v1 = acc[ai][bj][m][1] * sc;
                        u32x4 w; w.x = pk_bf16(v0[0], v0[1]); w.y = pk_bf16(v0[2], v0[3]); w.z = pk_bf16(v1[0], v1[1]); w.w = pk_bf16(v1[2], v1[3]);
                        *(u32x4*)(p.U + (size_t)row * U_LD + pn * 256 + bj * 128 + colw) = w;
                    }
                }
        }
    }
};

namespace sb {
constexpr int PITCH = PA_LD, NW = 8, QB = 256, KVBLK = 64;
constexpr int NSLOT = 3, SLOTB = 8192;
constexpr int LDS_K = 0, LDS_V = NSLOT * SLOTB, LDS_OST = 2 * NSLOT * SLOTB, LDS_BYTES = LDS_OST + NW * 4096;
__device__ __forceinline__ void glds16(const void* gsrc, unsigned lds_dst) { unsigned keep;
    asm volatile("s_mov_b32 %0, m0\n\ts_mov_b32 m0, %2\n\ts_nop 0\n\tglobal_load_lds_dwordx4 %1, off\n\ts_mov_b32 m0, %0" : "=&s"(keep) : "v"(gsrc), "s"(lds_dst) : "memory"); }
__device__ __forceinline__ int crow(int r, int hi) { return (r & 3) + 8 * (r >> 2) + 4 * hi; }
typedef short v4i16_t __attribute__((ext_vector_type(4)));
__device__ __forceinline__ s16x4 vtr(const LAS char* p) { return __builtin_bit_cast(s16x4, __builtin_amdgcn_ds_read_tr16_b64_v4i16((LAS v4i16_t*)p)); }

__device__ __forceinline__ void unit(int b, int h, int qb, bf16_t* PA, LAS char* shm) {
    int tid_ = threadIdx.x; asm volatile("" : "+v"(tid_));
    const int tid = tid_, lane = tid & 63, r32 = lane & 31, hi = lane >> 5; const int wid = __builtin_amdgcn_readfirstlane(tid >> 6);
    const long rowbase = (long)b * SEQ; const int q0 = qb * QB;
    const bf16_t* Qw = PA + (rowbase + q0 + wid * 32) * PITCH + h * 64;
    const bf16_t* Kh = PA + rowbase * PITCH + 512 + h * 64;
    const bf16_t* Vh = PA + rowbase * PITCH + 1024 + h * 64;
    const unsigned lds0 = (unsigned)(uintptr_t)shm;
    const int kperm = ((lane >> 2) & 1) * 32 + (lane >> 5) * 16 + ((lane & 31) >> 3) * 4 + (lane & 3);
    const bf16_t* ksrc = Kh + (long)kperm * PITCH + wid * 8;
    const bf16_t* vsrc = Vh + (long)(16 * (wid & 3) + (lane >> 2)) * PITCH + (wid >> 2) * 32 + (lane & 3) * 8;
    const unsigned kdst = lds0 + LDS_K + wid * 1024, vdst = lds0 + LDS_V + wid * 1024;
#define DMA_KV(t, slot) do { glds16(ksrc + (long)(t) * KVBLK * PITCH, (unsigned)__builtin_amdgcn_readfirstlane(kdst + (slot))); \
                             glds16(vsrc + (long)(t) * KVBLK * PITCH, (unsigned)__builtin_amdgcn_readfirstlane(vdst + (slot))); } while (0)
    const int NT = (q0 + QB) / KVBLK;
    bf16x8 qr[4];
#pragma unroll
    for (int d0 = 0; d0 < 4; ++d0) qr[d0] = *reinterpret_cast<const bf16x8*>(&Qw[(long)r32 * PITCH + d0 * 16 + hi * 8]);
    DMA_KV(NT - 1, 0); DMA_KV(NT - 2, SLOTB);
    f32x16 o[2]; o[0] = f32x16{}; o[1] = f32x16{};
    float carry = 1.f;
    const int qrel = wid * 32 + r32;
    const LAS char* kp0 = shm + LDS_K + hi * 1024 + r32 * 16;
    const LAS char* vp0 = shm + LDS_V + (32 * hi + ((lane & 15) >> 2)) * 64 + ((lane >> 4) & 1) * 32 + (lane & 3) * 8;
    int slot = 0, slot2 = 2 * SLOTB;
    for (int t = NT - 1; t >= 0; --t) {
        if (t >= 1) asm volatile("s_waitcnt vmcnt(2) lgkmcnt(0)\n\ts_barrier" ::: "memory");
        else        asm volatile("s_waitcnt vmcnt(0) lgkmcnt(0)\n\ts_barrier" ::: "memory");
        if (t >= 2) DMA_KV(t - 2, slot2);
        const int jb = t - (NT - 4);
        if (jb <= (wid >> 1)) {
            f32x16 p0 = f32x16{}, p1 = f32x16{};
            const LAS char* kb = kp0 + slot;
#pragma unroll
            for (int d0 = 0; d0 < 4; ++d0) {
                const bf16x8 b0 = *(const LAS bf16x8*)(kb + d0 * 2048);
                const bf16x8 b1 = *(const LAS bf16x8*)(kb + d0 * 2048 + 512);
                p0 = __builtin_amdgcn_mfma_f32_32x32x16_bf16(b0, qr[d0], p0, 0, 0, 0);
                p1 = __builtin_amdgcn_mfma_f32_32x32x16_bf16(b1, qr[d0], p1, 0, 0, 0);
            }
#pragma unroll
            for (int r = 0; r < 16; ++r) { p0[r] = __builtin_amdgcn_rcpf(1.f + __builtin_amdgcn_exp2f(p0[r])); p1[r] = __builtin_amdgcn_rcpf(1.f + __builtin_amdgcn_exp2f(p1[r])); }
            if (jb == (wid >> 1)) {
                const int kb0 = 64 * jb + 32 * hi;
#pragma unroll
                for (int r = 0; r < 16; ++r) { if (kb0 + r >= qrel) p0[r] = 1.f; if (kb0 + 16 + r >= qrel) p1[r] = 1.f; }
            }
            float T = 1.f;
#pragma unroll
            for (int r = 15; r >= 0; --r) { const float Tn = T * p1[r]; p1[r] = T - Tn; T = Tn; }
#pragma unroll
            for (int r = 15; r >= 0; --r) { const float Tn = T * p0[r]; p0[r] = T - Tn; T = Tn; }
            const float Tp = __shfl_xor(T, 32);
            const float base = carry * (hi == 0 ? Tp : 1.f);
            carry = carry * T * Tp;
#pragma unroll
            for (int r = 0; r < 16; ++r) { p0[r] *= base; p1[r] *= base; }
            u32x4 pw0, pw1, pw2, pw3;
            pw0 = (u32x4){pk_bf16(p0[0], p0[1]), pk_bf16(p0[2], p0[3]), pk_bf16(p0[4], p0[5]), pk_bf16(p0[6], p0[7])};
            pw1 = (u32x4){pk_bf16(p0[8], p0[9]), pk_bf16(p0[10], p0[11]), pk_bf16(p0[12], p0[13]), pk_bf16(p0[14], p0[15])};
            pw2 = (u32x4){pk_bf16(p1[0], p1[1]), pk_bf16(p1[2], p1[3]), pk_bf16(p1[4], p1[5]), pk_bf16(p1[6], p1[7])};
            pw3 = (u32x4){pk_bf16(p1[8], p1[9]), pk_bf16(p1[10], p1[11]), pk_bf16(p1[12], p1[13]), pk_bf16(p1[14], p1[15])};
            const LAS char* vb = vp0 + slot;
#pragma unroll
            for (int d0 = 0; d0 < 2; ++d0) {
                s16x4 lo[4], hh[4];
#pragma unroll
                for (int ks = 0; ks < 4; ++ks) { lo[ks] = vtr(vb + d0 * 4096 + ks * 512); hh[ks] = vtr(vb + d0 * 4096 + ks * 512 + 256); }
#define PKV(k) (bf16x8){lo[k][0], lo[k][1], lo[k][2], lo[k][3], hh[k][0], hh[k][1], hh[k][2], hh[k][3]}
                o[d0] = __builtin_amdgcn_mfma_f32_32x32x16_bf16(__builtin_bit_cast(bf16x8, pw0), PKV(0), o[d0], 0, 0, 0);
                o[d0] = __builtin_amdgcn_mfma_f32_32x32x16_bf16(__builtin_bit_cast(bf16x8, pw1), PKV(1), o[d0], 0, 0, 0);
                o[d0] = __builtin_amdgcn_mfma_f32_32x32x16_bf16(__builtin_bit_cast(bf16x8, pw2), PKV(2), o[d0], 0, 0, 0);
                o[d0] = __builtin_amdgcn_mfma_f32_32x32x16_bf16(__builtin_bit_cast(bf16x8, pw3), PKV(3), o[d0], 0, 0, 0);
#undef PKV
            }
        }
        slot2 = slot; slot = (slot == (NSLOT - 1) * SLOTB) ? 0 : slot + SLOTB;
    }
    bf16_t* Ow = PA + (rowbase + q0 + wid * 32) * PITCH + h * 64;
    {
        LAS bf16_t* stg = (LAS bf16_t*)(shm + LDS_OST) + wid * 2048;
#pragma unroll
        for (int r = 0; r < 16; ++r) { const int orow = crow(r, hi);
#pragma unroll
            for (int d0 = 0; d0 < 2; ++d0) stg[orow * 64 + d0 * 32 + r32] = (bf16_t)(pk_bf16(o[d0][r], 0.f) & 0xffffu); }
        asm volatile("s_waitcnt lgkmcnt(0)" ::: "memory");
#pragma unroll
        for (int i = 0; i < 4; ++i) { const int row = i * 8 + (lane >> 3), ch = lane & 7; const u32x4 v = *(const LAS u32x4*)(stg + row * 64 + ch * 8); *(u32x4*)(Ow + (long)row * PITCH + ch * 8) = v; }
    }
    asm volatile("s_waitcnt vmcnt(0) lgkmcnt(0)\n\ts_barrier" ::: "memory");
#undef DMA_KV
}
}

namespace ret {
constexpr int RS = 272;
constexpr int L_Q = 0, L_K = 128 * RS, L_P = 2 * 128 * RS, L_V = 3 * 128 * RS, L_S = L_V + 128 * 64, LDS_BYTES = L_S + 2 * 32 * RS;
typedef short v4i16_t __attribute__((ext_vector_type(4)));
__device__ __forceinline__ s16x4 vtr(const LAS char* p) { return __builtin_bit_cast(s16x4, __builtin_amdgcn_ds_read_tr16_b64_v4i16((LAS v4i16_t*)p)); }
__device__ __forceinline__ bf16x8 cat(s16x4 a, s16x4 b) { return (bf16x8){a[0], a[1], a[2], a[3], b[0], b[1], b[2], b[3]}; }

__device__ __forceinline__ void item(int b, int h, int sl, bf16_t* PA, LAS char* shm) {
    int tid_ = threadIdx.x; asm volatile("" : "+v"(tid_));
    const int tid = tid_, lane = tid & 63, fr = lane & 15, fq = lane >> 4; const int wid = __builtin_amdgcn_readfirstlane(tid >> 6);
    const size_t rowbase = (size_t)b * SEQ;
    const bf16_t* Qg = PA + rowbase * PA_LD + 1536 + h * 128;
    const bf16_t* Kg = PA + rowbase * PA_LD + 2048 + h * 128;
    bf16_t* Vg = PA + rowbase * PA_LD + 2560 + h * 256 + sl * 32;
    const float lg = __builtin_log2f(1.f - __builtin_exp2f(-5.f - (float)h));
    const float gam128 = __builtin_exp2f(128.f * lg);
    for (int i = tid; i < 32 * RS / 4; i += 512) ((LAS unsigned*)(shm + L_S))[i] = 0u;
    u32x4 qreg[4], kreg[4], vreg;
#define RET_LOAD(c) do { _Pragma("unroll") for (int i = 0; i < 4; ++i) { const int id = tid + 512 * i, row = id >> 4, ch = id & 15; \
            qreg[i] = *(const u32x4*)(Qg + (size_t)((c) * 128 + row) * PA_LD + ch * 8); kreg[i] = *(const u32x4*)(Kg + (size_t)((c) * 128 + row) * PA_LD + ch * 8); } \
        vreg = *(const u32x4*)(Vg + (size_t)((c) * 128 + (tid >> 2)) * PA_LD + (tid & 3) * 8); } while (0)
    RET_LOAD(0);
    f32x4 st[2]; st[0] = (f32x4){0.f, 0.f, 0.f, 0.f}; st[1] = st[0];
    for (int c = 0; c < 32; ++c) {
#pragma unroll
        for (int i = 0; i < 4; ++i) { const int id = tid + 512 * i, row = id >> 4, ch = id & 15;
            *(LAS u32x4*)(shm + L_Q + row * RS + ch * 16) = qreg[i]; *(LAS u32x4*)(shm + L_K + row * RS + ch * 16) = kreg[i]; }
        *(LAS u32x4*)(shm + L_V + (tid >> 2) * 64 + (tid & 3) * 16) = vreg;
        __syncthreads();
        if (c + 1 < 32) RET_LOAD(c + 1);
        const LAS char* Scur = shm + L_S + (c & 1) * 32 * RS; LAS char* Snxt = shm + L_S + ((c + 1) & 1) * 32 * RS;
        {
            bf16x8 bq[4];
#pragma unroll
            for (int ks = 0; ks < 4; ++ks) bq[ks] = *(const LAS bf16x8*)(shm + L_Q + (16 * wid + fr) * RS + (ks * 32 + 8 * fq) * 2);
            const int n = 16 * wid + fr;
#pragma unroll
            for (int mb = 0; mb < 8; ++mb) {
                f32x4 a4 = (f32x4){0.f, 0.f, 0.f, 0.f};
#pragma unroll
                for (int ks = 0; ks < 4; ++ks) { const bf16x8 ak = *(const LAS bf16x8*)(shm + L_K + (16 * mb + fr) * RS + (ks * 32 + 8 * fq) * 2);
                    a4 = __builtin_amdgcn_mfma_f32_16x16x32_bf16(ak, bq[ks], a4, 0, 0, 0); }
                const int m0 = 16 * mb + 4 * fq;
#pragma unroll
                for (int k = 0; k < 4; ++k) if (m0 + k > n) a4[k] = 0.f;
                u32x2 w; w.x = pk_bf16(a4[0], a4[1]); w.y = pk_bf16(a4[2], a4[3]);
                *(LAS u32x2*)(shm + L_P + n * RS + m0 * 2) = w;
            }
        }
        {
            f32x4 kv[2]; kv[0] = (f32x4){0.f, 0.f, 0.f, 0.f}; kv[1] = kv[0];
#pragma unroll
            for (int ks = 0; ks < 4; ++ks) {
                const int r0 = 32 * ks + 8 * fq + (fr >> 2);
                const LAS char* ka = shm + L_K + r0 * RS + (16 * wid + 4 * (fr & 3)) * 2;
                const bf16x8 af = cat(vtr(ka), vtr(ka + 4 * RS));
#pragma unroll
                for (int eb = 0; eb < 2; ++eb) {
                    const LAS char* va = shm + L_V + r0 * 64 + (16 * eb + 4 * (fr & 3)) * 2;
                    const bf16x8 bfv = cat(vtr(va), vtr(va + 4 * 64));
                    kv[eb] = __builtin_amdgcn_mfma_f32_16x16x32_bf16(af, bfv, kv[eb], 0, 0, 0);
                }
            }
#pragma unroll
            for (int eb = 0; eb < 2; ++eb) {
                st[eb] = (st[eb] + kv[eb]) * gam128;
                u32x2 w; w.x = pk_bf16(st[eb][0], st[eb][1]); w.y = pk_bf16(st[eb][2], st[eb][3]);
                *(LAS u32x2*)(Snxt + (16 * eb + fr) * RS + (16 * wid + 4 * fq) * 2) = w;
            }
        }
        __syncthreads();
        {
            f32x4 oa[2]; oa[0] = (f32x4){0.f, 0.f, 0.f, 0.f}; oa[1] = oa[0];
#pragma unroll
            for (int ks = 0; ks < 4; ++ks) {
                const bf16x8 bp = *(const LAS bf16x8*)(shm + L_P + (16 * wid + fr) * RS + (ks * 32 + 8 * fq) * 2);
                const bf16x8 bq = *(const LAS bf16x8*)(shm + L_Q + (16 * wid + fr) * RS + (ks * 32 + 8 * fq) * 2);
                const int r0 = 32 * ks + 8 * fq + (fr >> 2);
#pragma unroll
                for (int eb = 0; eb < 2; ++eb) {
                    const LAS char* va = shm + L_V + r0 * 64 + (16 * eb + 4 * (fr & 3)) * 2;
                    const bf16x8 av = cat(vtr(va), vtr(va + 4 * 64));
                    oa[eb] = __builtin_amdgcn_mfma_f32_16x16x32_bf16(av, bp, oa[eb], 0, 0, 0);
                    const bf16x8 as = *(const LAS bf16x8*)(Scur + (16 * eb + fr) * RS + (ks * 32 + 8 * fq) * 2);
                    oa[eb] = __builtin_amdgcn_mfma_f32_16x16x32_bf16(as, bq, oa[eb], 0, 0, 0);
                }
            }
#pragma unroll
            for (int eb = 0; eb < 2; ++eb) {
                u32x2 w; w.x = pk_bf16(oa[eb][0], oa[eb][1]); w.y = pk_bf16(oa[eb][2], oa[eb][3]);
                *(u32x2*)(Vg + (size_t)(c * 128 + 16 * wid + fr) * PA_LD + 16 * eb + 4 * fq) = w;
            }
        }
        __syncthreads();
    }
#undef RET_LOAD
}
}


namespace side {
constexpr int RED_OFF = 98304;
__device__ __forceinline__ void gemv_item(LAS unsigned char* lds, const float* W, int ldw, int kb, int n0, float* outp, int ldo) {
    int tid_ = threadIdx.x; asm volatile("" : "+v"(tid_));
    const int tid = tid_, lane = tid & 63, wave = __builtin_amdgcn_readfirstlane(tid >> 6);
    const LAS f32x4* A = (const LAS f32x4*)lds;
    float acc[8];
#pragma unroll
    for (int r = 0; r < 8; ++r) acc[r] = 0.f;
    const int k0 = kb + wave * 32;
    const float* wp = W + (size_t)k0 * ldw + n0 + lane;
    float w[32];
#pragma unroll
    for (int k = 0; k < 32; ++k) w[k] = wp[(size_t)k * ldw];
#pragma unroll
    for (int k = 0; k < 32; ++k) {
        const f32x4 a0 = A[(k0 + k) * 2], a1 = A[(k0 + k) * 2 + 1];
        acc[0] += a0[0] * w[k]; acc[1] += a0[1] * w[k]; acc[2] += a0[2] * w[k]; acc[3] += a0[3] * w[k];
        acc[4] += a1[0] * w[k]; acc[5] += a1[1] * w[k]; acc[6] += a1[2] * w[k]; acc[7] += a1[3] * w[k];
    }
    LAS float* red = (LAS float*)(lds + RED_OFF);
#pragma unroll
    for (int r = 0; r < 8; ++r) red[(wave * 8 + r) * 64 + lane] = acc[r];
    __syncthreads();
    { float s = 0.f;
#pragma unroll
      for (int ww = 0; ww < 8; ++ww) s += red[(ww * 8 + wave) * 64 + lane];
      unsafeAtomicAdd(outp + (size_t)wave * ldo + n0 + lane, s); }
    __syncthreads();
}
__device__ __forceinline__ void prep_norm(LAS unsigned char* lds, const float* xa, size_t xa_stride, const float* add, const float* g, bool wr, float* outw, bf16_t* XNw, float* ssqw, float* xsw) {
    int tid_ = threadIdx.x; asm volatile("" : "+v"(tid_));
    const int lane = tid_ & 63, r = __builtin_amdgcn_readfirstlane(tid_ >> 6);
    const size_t rowoff = (size_t)r * SEQ * D;
    float v[16]; float s = 0.f;
#pragma unroll
    for (int j = 0; j < 16; ++j) { const int k = lane + 64 * j; v[j] = xa[(size_t)r * xa_stride + k] + (add ? add[r * D + k] : 0.f); s += v[j] * v[j]; }
    s = wave_sum(s);
    const float rs = 1.f / sqrtf(s * (1.f / 1024.f) + EPS);
    LAS float* A = (LAS float*)lds;
#pragma unroll
    for (int j = 0; j < 16; ++j) { const int k = lane + 64 * j; const float gk = g[k]; A[k * 8 + r] = v[j] * gk * rs;
        if (wr) { outw[rowoff + k] = v[j]; XNw[rowoff + k] = (bf16_t)(pk_bf16(v[j] * gk, 0.f) & 0xffffu); if (xsw) xsw[r * D + k] = v[j]; } }
    if (wr && lane == 0) ssqw[(size_t)r * SEQ] = s;
    __syncthreads();
}
__device__ __forceinline__ float silu_(float x) { return x / (1.f + __expf(-x)); }
__device__ __forceinline__ float sigm_(float x) { return 1.f / (1.f + __expf(-x)); }
}

struct Args { const float* in[14]; float* out; unsigned char* ws; };

__device__ __forceinline__ int rope_prow(int n) { if (n >= 1536 && n < 2560) { const int j = (n - 1536) & 127, base = n - j; return base + (j < 64 ? 2 * j : 2 * (j - 64) + 1); } return n; }
__device__ __forceinline__ void transpose_item(const float* W, int K, int N, bf16_t* WT, int ldt, int koff, bool perm, LAS float* scr, int item, int lane) {
    const int nblk = N / 32, kb = item / nblk, nb = item % nblk, k0 = 64 * kb, n0 = 32 * nb;
#pragma unroll 8
    for (int i = 0; i < 32; ++i) { const int kk = 2 * i + (lane >> 5); scr[kk * 33 + (lane & 31)] = W[(size_t)(k0 + kk) * N + n0 + (lane & 31)]; }
    asm volatile("s_waitcnt lgkmcnt(0)" ::: "memory");
    const int c = lane & 7;
#pragma unroll
    for (int j = 0; j < 4; ++j) { const int n = (lane >> 3) + 8 * j; const LAS float* s = scr + (8 * c) * 33 + n;
        u32x4 o; o.x = pk_bf16(s[0 * 33], s[1 * 33]); o.y = pk_bf16(s[2 * 33], s[3 * 33]); o.z = pk_bf16(s[4 * 33], s[5 * 33]); o.w = pk_bf16(s[6 * 33], s[7 * 33]);
        const int dr = perm ? rope_prow(n0 + n) : (n0 + n);
        *(u32x4*)(WT + (size_t)dr * ldt + koff + k0 + 8 * c) = o; }
    asm volatile("s_waitcnt lgkmcnt(0)" ::: "memory");
}
__device__ __forceinline__ void convert_mixer(const Args& a, int l, LAS unsigned char* lds, int gw, int NGW, int wave, int lane) {
    LAS float* scr = (LAS float*)(lds + wave * 16384);
    bf16_t* win = (bf16_t*)(a.ws + WS_WIN); bf16_t* wcat = (bf16_t*)(a.ws + WS_WCAT); bf16_t* wo = (bf16_t*)(a.ws + WS_WO);
    const float* w_in = a.in[2] + (size_t)l * D * IN_COLS; const float* sbw = a.in[4] + (size_t)l * 512 * D;
    const float* rw = a.in[6] + (size_t)l * D * D; const float* w_o = a.in[7] + (size_t)l * D * D;
    constexpr int I0 = (D / 64) * (IN_COLS / 32), I1 = (512 / 64) * (D / 32), I2 = (D / 64) * (D / 32), I3 = I2;
    for (int it = gw; it < I0 + I1 + I2 + I3; it += NGW) {
        int r = it;
        if (r < I0) { transpose_item(w_in, D, IN_COLS, win, D, 0, true, scr, r, lane); continue; } r -= I0;
        if (r < I1) { transpose_item(sbw, 512, D, wcat, 1536, 0, false, scr, r, lane); continue; } r -= I1;
        if (r < I2) { transpose_item(rw, D, D, wcat, 1536, 512, false, scr, r, lane); continue; } r -= I2;
        transpose_item(w_o, D, D, wo, D, 0, false, scr, r, lane);
    }
}
__device__ __forceinline__ void convert_ffn(const Args& a, int l, LAS unsigned char* lds, int gw, int NGW, int wave, int lane) {
    LAS float* scr = (LAS float*)(lds + wave * 16384);
    bf16_t* wup = (bf16_t*)(a.ws + WS_WUP); bf16_t* wdn = (bf16_t*)(a.ws + WS_WDN);
    const float* w_up = a.in[9] + (size_t)l * D * U_LD; const float* w_dn = a.in[12] + (size_t)l * FF * D;
    constexpr int I0 = (D / 64) * (U_LD / 32), I1 = (FF / 64) * (D / 32);
    for (int it = gw; it < I0 + I1; it += NGW) {
        int r = it;
        if (r < I0) { transpose_item(w_up, D, U_LD, wup, D, 0, false, scr, r, lane); continue; } r -= I0;
        transpose_item(w_dn, FF, D, wdn, FF, 0, false, scr, r, lane);
    }
}

__global__ void __launch_bounds__(512, 2) fwd_kernel(Args a) {
    extern __shared__ __attribute__((aligned(16))) unsigned char lds_raw[];
    LAS unsigned char* lds = (LAS unsigned char*)lds_raw;
    cg::grid_group grid = cg::this_grid();
    const int G = gridDim.x, bx = blockIdx.x;
    const int vcu = (G % 8 == 0) ? (bx % 8) * (G / 8) + bx / 8 : bx;
    const int NGW = G * 8, NGT = G * 512;
#define PHASE_IDS() int tid_ = threadIdx.x; asm volatile("" : "+v"(tid_)); const int tid = tid_, lane = tid & 63, wave = __builtin_amdgcn_readfirstlane(tid >> 6); \
    const int gw = vcu * 8 + wave, gtid = bx * 512 + tid; (void)gw; (void)gtid; (void)lane;
    unsigned char* ws = a.ws;
    float* ssq = (float*)(ws + WS_SSQ);
    f32x4* rope = (f32x4*)(ws + WS_ROPE);
    bf16_t* win = (bf16_t*)(ws + WS_WIN); bf16_t* wcat = (bf16_t*)(ws + WS_WCAT); bf16_t* wo = (bf16_t*)(ws + WS_WO);
    bf16_t* XN = (bf16_t*)(ws + WS_XN); bf16_t* PA = (bf16_t*)(ws + WS_PROJ); bf16_t* PB = (bf16_t*)(ws + WS_PB); bf16_t* U = (bf16_t*)(ws + WS_PROJ);
    bf16_t* wup = (bf16_t*)(ws + WS_WUP); bf16_t* wdn = (bf16_t*)(ws + WS_WDN);
    const float* x = a.in[0]; float* out = a.out;
    float* SIDE = (float*)(ws + WS_SIDE); float* XS = (float*)(ws + WS_XS);

    {
    PHASE_IDS();
    convert_mixer(a, 0, lds, gw, NGW, wave, lane);
    for (int i = gtid; i < 4096 * 64; i += NGT) {
        const int pos = i >> 6, k = i & 63;
        const float inv = __builtin_exp2f(-(float)k * (13.287712379549449f / 64.f));
        const double ang = (double)((float)pos * inv);
        double rev = ang * 0.15915494309189535; rev -= __builtin_rint(rev);
        f32x2 cs; cs.x = __builtin_amdgcn_cosf((float)rev); cs.y = __builtin_amdgcn_sinf((float)rev);
        ((f32x2*)rope)[i] = cs;
    }
    for (int i = gtid; i < 4 * M; i += NGT) ssq[M + i] = 0.f;
    for (int i = gtid; i < 2 * SD_LAYER; i += NGT) SIDE[i] = 0.f;
    {
        const float* g0 = a.in[1];
        for (int m = gw; m < M; m += NGW) {
            const f32x4* xr = (const f32x4*)(x + (size_t)m * D) + lane; const f32x4* gr = (const f32x4*)g0 + lane;
            f32x4 v[4]; float s = 0.f;
#pragma unroll
            for (int j = 0; j < 4; ++j) { v[j] = xr[64 * j]; s += (v[j][0] * v[j][0] + v[j][1] * v[j][1]) + (v[j][2] * v[j][2] + v[j][3] * v[j][3]); }
            s = wave_sum(s);
            if (lane == 0) ssq[m] = s;
            u32x2* o8 = (u32x2*)(XN + (size_t)m * D) + lane;
#pragma unroll
            for (int j = 0; j < 4; ++j) { const f32x4 w = v[j] * gr[64 * j]; u32x2 o; o.x = pk_bf16(w[0], w[1]); o.y = pk_bf16(w[2], w[3]); o8[64 * j] = o; }
        }
    }
    }
    grid.sync();

#pragma unroll 1
    for (int l = 0; l < 2; ++l) {
        const float* bgate = a.in[3] + (size_t)l * 2048;
        float* SP = SIDE + (size_t)l * SD_LAYER + SD_SP; float* YB = SIDE + (size_t)l * SD_LAYER + SD_YB; float* MO = SIDE + (size_t)l * SD_LAYER + SD_MO;
        float* UU = SIDE + (size_t)l * SD_LAYER + SD_UU; float* DD = SIDE + (size_t)l * SD_LAYER + SD_DD;
        {
            side::prep_norm(lds, (l == 0) ? x : XS, (l == 0) ? (size_t)SEQ * D : (size_t)D, nullptr, a.in[1] + (size_t)l * D, false, nullptr, nullptr, nullptr, nullptr);
            const float* w_in = a.in[2] + (size_t)l * D * IN_COLS;
            for (int it = bx; it < 320; it += G) side::gemv_item(lds, w_in, IN_COLS, (it & 3) * 256, 1536 + (it >> 2) * 64, SP, IN_COLS);
        }
        {
            pg8::Gemm g{XN, win, D, D, M, IN_COLS, D}; pg8::StaticOrder S; S.init(M, IN_COLS, G, bx);
            Epi<1> E; E.p = EpiP{}; E.p.ssq = ssq + (size_t)(2 * l) * M; E.p.PA = PA; E.p.PB = PB; E.p.rope = rope;
            pg8::gemm_phase(lds, g, S, E);
        }
        grid.sync();
        if (bx < 64) {
            {
                PHASE_IDS();
                const int r = wave, hh = lane >> 4, sub = lane & 15;
                const float* sp = SP + (size_t)r * IN_COLS;
                float dq = 0.f;
#pragma unroll
                for (int j = 0; j < 8; ++j) dq += sp[1536 + hh * 128 + sub * 8 + j] * sp[2048 + hh * 128 + sub * 8 + j];
#pragma unroll
                for (int o = 1; o < 16; o <<= 1) dq += __shfl_xor(dq, o);
                const float w0 = dq * 0.08838834764831845f;
                float ov[16]; float s = 0.f;
#pragma unroll
                for (int j = 0; j < 16; ++j) { ov[j] = w0 * sp[2560 + hh * 256 + sub * 16 + j]; s += ov[j]; }
#pragma unroll
                for (int o = 1; o < 16; o <<= 1) s += __shfl_xor(s, o);
                const float mu = s * (1.f / 256.f); float q = 0.f;
#pragma unroll
                for (int j = 0; j < 16; ++j) { ov[j] -= mu; q += ov[j] * ov[j]; }
#pragma unroll
                for (int o = 1; o < 16; o <<= 1) q += __shfl_xor(q, o);
                const float rstd = 1.f / sqrtf(q * (1.f / 256.f) + EPS);
                const float* rn = a.in[5] + (size_t)l * D;
                LAS float* A = (LAS float*)lds;
#pragma unroll
                for (int j = 0; j < 16; ++j) { const int e = hh * 256 + sub * 16 + j; A[e * 8 + r] = ov[j] * rstd * rn[e] * side::silu_(sp[3584 + e]); }
                __syncthreads();
            }
            const float* rw = a.in[6] + (size_t)l * D * D;
            for (int it = bx; it < 64; it += G) side::gemv_item(lds, rw, D, (it & 3) * 256, (it >> 2) * 64, YB, D);
        }
        for (int j = vcu; j < 256; j += G) ret::item(j >> 5, (j >> 3) & 3, j & 7, PA, (LAS char*)lds);
        for (int j = vcu; j < 256; j += G) {
            const int bh = j >> 2, s = j & 3;
            sb::unit(bh >> 3, bh & 7, 15 - s, PA, (LAS char*)lds);
            sb::unit(bh >> 3, bh & 7, 8 + s, PA, (LAS char*)lds);
            sb::unit(bh >> 3, bh & 7, 7 - s, PA, (LAS char*)lds);
            sb::unit(bh >> 3, bh & 7, s, PA, (LAS char*)lds);
        }
        grid.sync();
        if (bx < 64) {
            {
                PHASE_IDS();
                LAS float* A = (LAS float*)lds;
                for (int i = tid; i < 8 * D; i += 512) { const int r = i >> 10, k = i & 1023; A[k * 8 + r] = side::sigm_(SP[(size_t)r * IN_COLS + 5632 + k] + bgate[1024 + k]) * YB[r * D + k]; }
                __syncthreads();
            }
            const float* w_o = a.in[7] + (size_t)l * D * D;
            for (int it = bx; it < 64; it += G) side::gemv_item(lds, w_o, D, (it & 3) * 256, (it >> 2) * 64, MO, D);
        }
        {
            PHASE_IDS();
            const float* rg = a.in[5] + (size_t)l * D;
            for (int m = gw; m < M; m += NGW) {
                bf16_t* op = PA + (size_t)m * PA_LD + 2560 + 16 * lane; const bf16_t* gp = PB + (size_t)m * PB_LD + 16 * lane;
                const u32x4 o0 = *(const u32x4*)op, o1 = *(const u32x4*)(op + 8), g0 = *(const u32x4*)gp, g1 = *(const u32x4*)(gp + 8);
                float v[16], gv[16];
                v[0] = bf_lo(o0.x); v[1] = bf_hi(o0.x); v[2] = bf_lo(o0.y); v[3] = bf_hi(o0.y); v[4] = bf_lo(o0.z); v[5] = bf_hi(o0.z); v[6] = bf_lo(o0.w); v[7] = bf_hi(o0.w);
                v[8] = bf_lo(o1.x); v[9] = bf_hi(o1.x); v[10] = bf_lo(o1.y); v[11] = bf_hi(o1.y); v[12] = bf_lo(o1.z); v[13] = bf_hi(o1.z); v[14] = bf_lo(o1.w); v[15] = bf_hi(o1.w);
                gv[0] = bf_lo(g0.x); gv[1] = bf_hi(g0.x); gv[2] = bf_lo(g0.y); gv[3] = bf_hi(g0.y); gv[4] = bf_lo(g0.z); gv[5] = bf_hi(g0.z); gv[6] = bf_lo(g0.w); gv[7] = bf_hi(g0.w);
                gv[8] = bf_lo(g1.x); gv[9] = bf_hi(g1.x); gv[10] = bf_lo(g1.y); gv[11] = bf_hi(g1.y); gv[12] = bf_lo(g1.z); gv[13] = bf_hi(g1.z); gv[14] = bf_lo(g1.w); gv[15] = bf_hi(g1.w);
                float s = 0.f;
#pragma unroll
                for (int k = 0; k < 16; ++k) s += v[k];
#pragma unroll
                for (int o = 1; o < 16; o <<= 1) s += __shfl_xor(s, o);
                const float mu = s * (1.f / 256.f); float q = 0.f;
#pragma unroll
                for (int k = 0; k < 16; ++k) { v[k] -= mu; q += v[k] * v[k]; }
#pragma unroll
                for (int o = 1; o < 16; o <<= 1) q += __shfl_xor(q, o);
                const float rstd = __builtin_amdgcn_rsqf(q * (1.f / 256.f) + EPS);
                const f32x4* rgp = (const f32x4*)(rg + 16 * lane);
                unsigned w[8];
#pragma unroll
                for (int k4 = 0; k4 < 4; ++k4) { const f32x4 gg = rgp[k4];
                    float y[4];
#pragma unroll
                    for (int k = 0; k < 4; ++k) { const float gx = gv[4 * k4 + k]; y[k] = v[4 * k4 + k] * rstd * gg[k] * gx * sigmoidf_(gx); }
                    w[2 * k4] = pk_bf16(y[0], y[1]); w[2 * k4 + 1] = pk_bf16(y[2], y[3]); }
                *(u32x4*)op = (u32x4){w[0], w[1], w[2], w[3]}; *(u32x4*)(op + 8) = (u32x4){w[4], w[5], w[6], w[7]};
            }
            __syncthreads();
            pg8::Gemm g{PA, wcat, PA_LD, 1536, M, D, 512}; pg8::StaticOrder S; S.init(M, D, G, bx);
            Epi<2> E; E.p = EpiP{}; E.p.PA = PA; E.p.PB = PB; E.p.bgate = bgate;
            pg8::gemm_phase(lds, g, S, E);
        }
        grid.sync();
        {
            pg8::Gemm g{PA + 2560, wcat + 512, PA_LD, 1536, M, D, D}; pg8::StaticOrder S; S.init(M, D, G, bx);
            Epi<3> E; E.p = EpiP{}; E.p.PA = PA; E.p.PB = PB; E.p.bgate = bgate;
            pg8::gemm_phase(lds, g, S, E);
        }
        grid.sync();
        {
            side::prep_norm(lds, (l == 0) ? x : XS, (l == 0) ? (size_t)SEQ * D : (size_t)D, MO, a.in[8] + (size_t)l * D, bx == 0, out, XN, ssq + (size_t)(2 * l + 1) * M, nullptr);
            const float* w_up = a.in[9] + (size_t)l * D * U_LD;
            for (int it = bx; it < 352; it += G) side::gemv_item(lds, w_up, U_LD, (it & 3) * 256, (it >> 2) * 64, UU, U_LD);
        }
        {
            PHASE_IDS();
            convert_ffn(a, l, lds, gw, NGW, wave, lane);
            __syncthreads();
            pg8::Gemm g{PA + 1536, wo, PA_LD, D, M, D, D}; pg8::StaticOrder S; S.init(M, D, G, bx);
            Epi<4> E; E.p = EpiP{}; E.p.xin = (l == 0) ? x : out; E.p.xout = out; E.p.XN = XN; E.p.gnext = a.in[8] + (size_t)l * D; E.p.ssq_out = ssq + (size_t)(2 * l + 1) * M;
            pg8::gemm_phase(lds, g, S, E);
        }
        grid.sync();
        {
            PHASE_IDS();
            if (l == 0) { convert_mixer(a, 1, lds, gw, NGW, wave, lane); __syncthreads(); }
            pg8::Gemm g{XN, wup, D, D, M, U_LD, D}; pg8::StaticOrder S; S.init(M, U_LD, G, bx);
            Epi<5> E; E.p = EpiP{}; E.p.ssq = ssq + (size_t)(2 * l + 1) * M; E.p.U = U;
            pg8::gemm_phase(lds, g, S, E);
        }
        grid.sync();
        if (bx < 176) {
            {
                PHASE_IDS();
                const float* cw2 = a.in[10] + (size_t)l * 3 * FF + 2 * FF; const float* cbb = a.in[11] + (size_t)l * FF;
                LAS float* A = (LAS float*)lds;
                for (int i = tid; i < 8 * FF; i += 512) { const int r = i / FF, k = i - r * FF; A[k * 8 + r] = side::silu_(cw2[k] * UU[r * U_LD + k] + cbb[k]) * UU[r * U_LD + FF + k]; }
                __syncthreads();
            }
            const float* w_dn = a.in[12] + (size_t)l * FF * D;
            for (int it = bx; it < 176; it += G) side::gemv_item(lds, w_dn, D, (it / 16) * 256, (it & 15) * 64, DD, D);
        }
        {
            PHASE_IDS();
            const float* cw = a.in[10] + (size_t)l * 3 * FF; const float* cb = a.in[11] + (size_t)l * FF;
            constexpr int NCH = FF / 8, NIT = (M / 8) * NCH;
            for (int it = gtid; it < NIT; it += NGT) {
                const int sbd = it / NCH, ch = it - sbd * NCH, r0 = sbd * 8, c0 = ch * 8;
                float w0[8], w1[8], w2[8], bsv[8];
#pragma unroll
                for (int k = 0; k < 8; ++k) { w0[k] = cw[c0 + k]; w1[k] = cw[FF + c0 + k]; w2[k] = cw[2 * FF + c0 + k]; bsv[k] = cb[c0 + k]; }
                float a2[8], a1[8];
                if ((r0 & 4095) == 0) {
#pragma unroll
                    for (int k = 0; k < 8; ++k) { a2[k] = 0.f; a1[k] = 0.f; }
                } else {
                    const u32x4 p2 = *(const u32x4*)(U + (size_t)(r0 - 2) * U_LD + c0), p1 = *(const u32x4*)(U + (size_t)(r0 - 1) * U_LD + c0);
                    a2[0] = bf_lo(p2.x); a2[1] = bf_hi(p2.x); a2[2] = bf_lo(p2.y); a2[3] = bf_hi(p2.y); a2[4] = bf_lo(p2.z); a2[5] = bf_hi(p2.z); a2[6] = bf_lo(p2.w); a2[7] = bf_hi(p2.w);
                    a1[0] = bf_lo(p1.x); a1[1] = bf_hi(p1.x); a1[2] = bf_lo(p1.y); a1[3] = bf_hi(p1.y); a1[4] = bf_lo(p1.z); a1[5] = bf_hi(p1.z); a1[6] = bf_lo(p1.w); a1[7] = bf_hi(p1.w);
                }
#pragma unroll
                for (int r = 0; r < 8; ++r) {
                    bf16_t* up = U + (size_t)(r0 + r) * U_LD + c0;
                    const u32x4 pa = *(const u32x4*)up, pb = *(const u32x4*)(up + FF);
                    float a0[8], bv[8], y[8];
                    a0[0] = bf_lo(pa.x); a0[1] = bf_hi(pa.x); a0[2] = bf_lo(pa.y); a0[3] = bf_hi(pa.y); a0[4] = bf_lo(pa.z); a0[5] = bf_hi(pa.z); a0[6] = bf_lo(pa.w); a0[7] = bf_hi(pa.w);
                    bv[0] = bf_lo(pb.x); bv[1] = bf_hi(pb.x); bv[2] = bf_lo(pb.y); bv[3] = bf_hi(pb.y); bv[4] = bf_lo(pb.z); bv[5] = bf_hi(pb.z); bv[6] = bf_lo(pb.w); bv[7] = bf_hi(pb.w);
#pragma unroll
                    for (int k = 0; k < 8; ++k) { const float cv = w0[k] * a2[k] + w1[k] * a1[k] + w2[k] * a0[k] + bsv[k]; y[k] = cv * sigmoidf_(cv) * bv[k]; a2[k] = a1[k]; a1[k] = a0[k]; }
                    *(u32x4*)(up + FF) = (u32x4){pk_bf16(y[0], y[1]), pk_bf16(y[2], y[3]), pk_bf16(y[4], y[5]), pk_bf16(y[6], y[7])};
                }
            }
        }
        grid.sync();
        if (bx == 0)
            side::prep_norm(lds, out, (size_t)SEQ * D, DD, (l == 0) ? a.in[1] + D : a.in[13], true, out, XN, ssq + (size_t)(2 * l + 2) * M, XS);
        {
            pg8::Gemm g{U + FF, wdn, U_LD, FF, M, D, FF}; pg8::StaticOrder S; S.init(M, D, G, bx);
            Epi<4> E; E.p = EpiP{}; E.p.xin = out; E.p.xout = out; E.p.XN = XN; E.p.gnext = (l == 0) ? a.in[1] + D : a.in[13]; E.p.ssq_out = ssq + (size_t)(2 * l + 2) * M;
            pg8::gemm_phase(lds, g, S, E);
        }
        grid.sync();
    }
    {
        PHASE_IDS();
        const float* gf = a.in[13]; const float* sq = ssq + (size_t)4 * M;
        for (int m = gw; m < M; m += NGW) {
            f32x4* xr = (f32x4*)(out + (size_t)m * D) + lane; const f32x4* gr = (const f32x4*)gf + lane;
            const float rs = __builtin_amdgcn_rsqf(sq[m] * (1.f / 1024.f) + EPS);
#pragma unroll
            for (int j = 0; j < 4; ++j) { const f32x4 v = xr[64 * j]; xr[64 * j] = v * rs * gr[64 * j]; }
        }
    }
}

constexpr int LDS_BYTES = 131072 + 1024;
static_assert(ret::LDS_BYTES <= 131072 && sb::LDS_BYTES <= 131072 && pg8::STAGE_BYTES <= 131072, "LDS map");

extern "C" void kernel_launch(void* const* d_in, const int* in_sizes, int n_in, void* d_out, int out_size, void* d_ws, size_t ws_size, hipStream_t stream) {
    static int grid = 0;
    if (grid == 0) {
        int dev = 0, cus = 0, per_cu = 0;
        hipGetDevice(&dev);
        hipDeviceGetAttribute(&cus, hipDeviceAttributeMultiprocessorCount, dev);
        hipFuncSetAttribute((const void*)fwd_kernel, hipFuncAttributeMaxDynamicSharedMemorySize, LDS_BYTES);
        hipOccupancyMaxActiveBlocksPerMultiprocessor(&per_cu, (const void*)fwd_kernel, 512, LDS_BYTES);
        (void)hipGetLastError();
        if (per_cu < 1) per_cu = 1;
        if (cus < 1) cus = 256;
        grid = cus;
        if (ws_size < WS_END) fprintf(stderr, "kernel_launch: workspace too small: %zu < %zu\n", ws_size, (size_t)WS_END);
    }
    Args a{};
    for (int i = 0; i < 14; ++i) a.in[i] = (const float*)d_in[i];
    a.out = (float*)d_out; a.ws = (unsigned char*)d_ws;
    void* args[] = {&a};
    hipError_t e = hipLaunchCooperativeKernel((const void*)fwd_kernel, dim3(grid), dim3(512), args, LDS_BYTES, stream);
    if (e != hipSuccess) fprintf(stderr, "cooperative launch failed: %s (grid %d)\n", hipGetErrorString(e), grid);
}
```

```cpp
#include <hip/hip_runtime.h>
#include <hip/hip_cooperative_groups.h>
#include <cstdio>
#include <cstdint>
namespace cg = cooperative_groups;

#define LAS __attribute__((address_space(3)))
typedef unsigned short bf16_t;
typedef short bf16x8 __attribute__((ext_vector_type(8)));
typedef short s16x4 __attribute__((ext_vector_type(4)));
typedef float f32x2 __attribute__((ext_vector_type(2)));
typedef float f32x4 __attribute__((ext_vector_type(4)));
typedef float f32x16 __attribute__((ext_vector_type(16)));
typedef unsigned u32x4 __attribute__((ext_vector_type(4)));
typedef unsigned u32x2 __attribute__((ext_vector_type(2)));

constexpr int M = 32768, D = 1024, SEQ = 4096, FF = 2816;
constexpr int IN_COLS = 6656, PA_LD = 3584, PB_LD = 3072, U_LD = 5632;
constexpr float EPS = 1e-6f;
constexpr float LOG2E = 1.4426950408889634f;

constexpr size_t MiB = 1u << 20;
constexpr size_t WS_SSQ = 0;
constexpr size_t WS_ROPE = 1 * MiB;
constexpr size_t WS_WIN = 3 * MiB;
constexpr size_t WS_WCAT = 16 * MiB;
constexpr size_t WS_WO = 19 * MiB;
constexpr size_t WS_XN = 21 * MiB;
constexpr size_t WS_PROJ = 85 * MiB;
constexpr size_t WS_PB = WS_PROJ + 224 * MiB;
constexpr size_t WS_WUP = WS_PROJ + 352 * MiB;
constexpr size_t WS_WDN = WS_WUP + 11 * MiB;
constexpr size_t WS_END0 = WS_PROJ + 416 * MiB;
constexpr size_t WS_SIDE = WS_END0;
constexpr int SD_SP = 0, SD_YB = 8 * 6656, SD_MO = SD_YB + 8 * 1024, SD_UU = SD_MO + 8 * 1024, SD_DD = SD_UU + 8 * 5632, SD_LAYER = SD_DD + 8 * 1024;
constexpr size_t WS_XS = WS_SIDE + (size_t)2 * SD_LAYER * 4;
constexpr size_t WS_BAR = WS_XS + 262144;
constexpr size_t WS_CNT = WS_BAR + 16384;
constexpr size_t WS_END = WS_CNT + 32768;

__device__ __forceinline__ unsigned pk_bf16(float lo, float hi) {
    typedef __bf16 b2 __attribute__((ext_vector_type(2))); f32x2 v = {lo, hi}; b2 b = __builtin_convertvector(v, b2); return __builtin_bit_cast(unsigned, b);
}
__device__ __forceinline__ float bf_lo(unsigned w) { return __uint_as_float(w << 16); }
__device__ __forceinline__ float bf_hi(unsigned w) { return __uint_as_float(w & 0xffff0000u); }
__device__ __forceinline__ float sigmoidf_(float x) { return __builtin_amdgcn_rcpf(1.f + __builtin_amdgcn_exp2f(-x * LOG2E)); }
__device__ __forceinline__ float shx(float v, int o) {
    int l = (int)__builtin_amdgcn_mbcnt_hi(~0u, __builtin_amdgcn_mbcnt_lo(~0u, 0u)); asm volatile("" : "+v"(l));
    return __int_as_float(__builtin_amdgcn_ds_bpermute((l ^ o) << 2, __float_as_int(v)));
}
__device__ __forceinline__ float wave_sum(float v) {
#pragma unroll
    for (int o = 1; o < 64; o <<= 1) v += shx(v, o);
    return v;
}

namespace pg8 {
constexpr int BM = 256, BK = 64, HALF = 128, HTB = HALF * BK * 2, STAGE_BYTES = 8 * HTB, NXCD = 8, WGM = 8;
__host__ __device__ __forceinline__ int lds_byte(int r, int c) { const int st = (r >> 4) * 2 + (c >> 5), rr = r & 15, cc = c & 31, ob = rr * 64 + cc * 2; return st * 1024 + (ob ^ (((ob >> 9) & 1) << 5)); }
__host__ __device__ __forceinline__ void stage_rc(int b, int& R, int& C) { const int st = b / 1024, sb = b % 1024, swz = sb ^ (((sb >> 9) & 1) << 5); R = (st >> 1) * 16 + swz / 64; C = (st & 1) * 32 + (swz % 64) / 2; }
__host__ __device__ __forceinline__ int perm32(int rho) { const int n = rho >> 4, i = rho & 15; return 8 * (i >> 2) + 4 * n + (i & 3); }

struct Unit { int pm, pn, arow; };
struct Gemm { const bf16_t* A; const bf16_t* Bt; int lda, ldb, M, N, K; };

struct StaticOrder {
    int nM, nN, nwg, G, c; bool ovl;
    __device__ void init(int M_, int N_, int G_, int c_, bool ovl_ = false) { ovl = ovl_; nM = ovl ? (M_ / 4096) * 17 : M_ / BM; nN = N_ / BM; nwg = nM * nN; G = G_; c = c_; }
    __device__ bool next(int i, Unit& u) const {
        const long L = (long)i * G + c; if (L >= nwg) return false;
        int wgid = (int)L; { const int q = nwg / NXCD, r = nwg % NXCD, xcd = wgid % NXCD, off = wgid / NXCD; wgid = (xcd < r ? xcd * (q + 1) : r * (q + 1) + (xcd - r) * q) + off; }
        const int nig = WGM * nN, gid = wgid / nig, fm = gid * WGM, gsz = (nM - fm) < WGM ? (nM - fm) : WGM;
        u.pm = fm + ((wgid % nig) % gsz); u.pn = (wgid % nig) / gsz;
        u.arow = ovl ? (u.pm / 17) * 4096 + 254 * (u.pm % 17) - 2 : u.pm * BM; return true;
    }
};

template <class Epi>
__device__ __forceinline__ void gemm_phase(LAS unsigned char* lds, const Gemm g, const StaticOrder& S, const Epi& E) {
    int tid_ = threadIdx.x; asm volatile("" : "+v"(tid_));
    const int tid = tid_, wid = __builtin_amdgcn_readfirstlane(tid >> 6), lane = tid & 63, wr = wid >> 2, wc = wid & 3, fr = lane & 15, fq = lane >> 4;
    const int K = g.K, nt = K / BK;
    unsigned voffA[2], voffB[2];
#pragma unroll
    for (int i = 0; i < 2; ++i) { int R, C; stage_rc(tid * 16 + i * 8192, R, C); const int Rb = (R & ~31) + perm32(R & 31);
        voffA[i] = (unsigned)(R * g.lda + C) * 2u; voffB[i] = (unsigned)(Rb * g.ldb + C) * 2u; }
    const size_t kstep = (size_t)(BK * 2);
    const size_t hstepA = (size_t)HALF * g.lda * 2, hstepB = (size_t)HALF * g.ldb * 2;
    const size_t tstepB = 2 * hstepB;
    const unsigned ldsw = (unsigned)wid * 1024u;
    const int aoff = lds_byte(wr * 64 + fr, fq * 8), boff = lds_byte(wc * 32 + fr, fq * 8);
#define PG8_SA(b, h) (((b) * 2 + (h)) * HTB)
#define PG8_SB(b, h) ((4 + (b) * 2 + (h)) * HTB)
#define PG8_STAGE(bufoff, gbase, voff) do { _Pragma("unroll") for (int _i = 0; _i < 2; ++_i) \
        __builtin_amdgcn_global_load_lds((const unsigned*)((const char*)(gbase) + (voff)[_i]), (LAS unsigned*)(lds + (bufoff) + ldsw + _i * 8192), 16, 0, 0); } while (0)
#define PG8_LDA(dst, b, h) do { _Pragma("unroll") for (int m = 0; m < 4; ++m) _Pragma("unroll") for (int k = 0; k < 2; ++k) dst[m][k] = *(const LAS bf16x8*)(lds + PG8_SA(b, h) + aoff + m * 2048 + k * 1024); } while (0)
#define PG8_LDB(dst, b, h) do { _Pragma("unroll") for (int n = 0; n < 2; ++n) _Pragma("unroll") for (int k = 0; k < 2; ++k) dst[n][k] = *(const LAS bf16x8*)(lds + PG8_SB(b, h) + boff + n * 2048 + k * 1024); } while (0)
#define PG8_MMA(ai, bj, At, Bt) do { __builtin_amdgcn_s_setprio(1); _Pragma("unroll") for (int m = 0; m < 4; ++m) _Pragma("unroll") for (int n = 0; n < 2; ++n) _Pragma("unroll") for (int k = 0; k < 2; ++k) \
        acc[ai][bj][m][n] = __builtin_amdgcn_mfma_f32_16x16x32_bf16(Bt[n][k], At[m][k], acc[ai][bj][m][n], 0, 0, 0); __builtin_amdgcn_s_setprio(0); } while (0)
#define PG8_WAIT_V(n) asm volatile("s_waitcnt vmcnt(" #n ")" ::: "memory")
#define PG8_WAIT_L(n) asm volatile("s_waitcnt lgkmcnt(" #n ")" ::: "memory")
#define PG8_BAR __builtin_amdgcn_s_barrier()
#define PG8_SCHED __builtin_amdgcn_sched_barrier(0)
    Unit cur, nxt; int ui = 0;
    if (!S.next(0, cur)) return;
    f32x4 acc[2][2][4][2];
#pragma unroll
    for (int a = 0; a < 2; ++a)
#pragma unroll
        for (int b = 0; b < 2; ++b)
#pragma unroll
            for (int m = 0; m < 4; ++m)
#pragma unroll
                for (int n = 0; n < 2; ++n) acc[a][b][m][n] = (f32x4){0.f, 0.f, 0.f, 0.f};
    bf16x8 At[4][2], B0[2][2], B1[2][2];
    const char* cA = (const char*)g.A + (ptrdiff_t)cur.arow * (ptrdiff_t)(g.lda * 2); const char* cB = (const char*)g.Bt + (size_t)cur.pn * tstepB;
    PG8_STAGE(PG8_SB(0, 0), cB, voffB); PG8_STAGE(PG8_SB(0, 1), cB + hstepB, voffB); PG8_STAGE(PG8_SA(0, 0), cA, voffA); PG8_STAGE(PG8_SA(0, 1), cA + hstepA, voffA);
    if (wr == 1) PG8_BAR;
    PG8_WAIT_V(2); PG8_BAR;
    PG8_STAGE(PG8_SB(1, 0), cB + kstep, voffB); PG8_STAGE(PG8_SA(1, 0), cA + kstep, voffA); PG8_STAGE(PG8_SB(1, 1), cB + hstepB + kstep, voffB);
    PG8_WAIT_V(6); PG8_BAR;
    for (;;) {
        const bool has_next = S.next(ui + 1, nxt);
        const char* nA = has_next ? (const char*)g.A + (ptrdiff_t)nxt.arow * (ptrdiff_t)(g.lda * 2) : cA; const char* nB = has_next ? (const char*)g.Bt + (size_t)nxt.pn * tstepB : cB;
        for (int t = 0; t < nt; t += 2) {
            const bool last = (t == nt - 2);
            const char* a1 = cA + (size_t)(t + 1) * kstep;
            const char* a2 = last ? nA : cA + (size_t)(t + 2) * kstep; const char* b2 = last ? nB : cB + (size_t)(t + 2) * kstep;
            const char* a3 = a2 + kstep; const char* b3 = b2 + kstep;
            PG8_LDB(B0, 0, 0); PG8_LDB(B1, 0, 1); PG8_SCHED; PG8_LDA(At, 0, 0); PG8_STAGE(PG8_SA(1, 1), a1 + hstepA, voffA);
            PG8_WAIT_V(8); PG8_WAIT_L(0); PG8_BAR; PG8_MMA(0, 0, At, B0); PG8_MMA(0, 1, At, B1); PG8_BAR; PG8_SCHED;
            PG8_LDA(At, 0, 1); PG8_STAGE(PG8_SB(0, 0), b2, voffB); PG8_STAGE(PG8_SB(0, 1), b2 + hstepB, voffB); PG8_STAGE(PG8_SA(0, 0), a2, voffA);
            PG8_WAIT_V(8); PG8_WAIT_L(0); PG8_BAR; PG8_MMA(1, 0, At, B0); PG8_MMA(1, 1, At, B1); PG8_BAR; PG8_SCHED;
            PG8_LDB(B0, 1, 0); PG8_LDB(B1, 1, 1); PG8_SCHED; PG8_LDA(At, 1, 0); PG8_STAGE(PG8_SA(0, 1), a2 + hstepA, voffA);
            PG8_WAIT_V(8); PG8_WAIT_L(0); PG8_BAR; PG8_MMA(0, 0, At, B0); PG8_MMA(0, 1, At, B1); PG8_BAR; PG8_SCHED;
            PG8_LDA(At, 1, 1); PG8_STAGE(PG8_SB(1, 0), b3, voffB); PG8_STAGE(PG8_SB(1, 1), b3 + hstepB, voffB); PG8_STAGE(PG8_SA(1, 0), a3, voffA);
            PG8_WAIT_V(8); PG8_WAIT_L(0); PG8_BAR; PG8_MMA(1, 0, At, B0); PG8_MMA(1, 1, At, B1); PG8_BAR; PG8_SCHED;
        }
        if (wr == 0) PG8_BAR;
        E(acc, cur, wr, wc, fr, fq);
        if (!has_next) break;
#pragma unroll
        for (int a = 0; a < 2; ++a)
#pragma unroll
            for (int b = 0; b < 2; ++b)
#pragma unroll
                for (int m = 0; m < 4; ++m)
#pragma unroll
                    for (int n = 0; n < 2; ++n) acc[a][b][m][n] = (f32x4){0.f, 0.f, 0.f, 0.f};
        cur = nxt; cA = nA; cB = nB; ++ui;
        if (wr == 1) PG8_BAR;
    }
    PG8_WAIT_V(0);
    PG8_BAR;
#undef PG8_SA
#undef PG8_SB
#undef PG8_STAGE
#undef PG8_LDA
#undef PG8_LDB
#undef PG8_MMA
#undef PG8_WAIT_V
#undef PG8_WAIT_L
#undef PG8_BAR
#undef PG8_SCHED
}
}

struct EpiP {
    const float* ssq;
    bf16_t* PA; bf16_t* PB;
    const f32x4* rope;
    const float* bgate;
    const float* xin; float* xout; bf16_t* XN; const float* gnext; float* ssq_out; int wxn;
    bf16_t* U;
    unsigned* cnt;
    bf16_t* H; const float* cw; const float* cb; LAS float* xch;
};
template <int MODE> struct Epi {
    EpiP p;
    __device__ __forceinline__ void operator()(const f32x4 (&acc)[2][2][4][2], const pg8::Unit& u, int wr, int wc, int fr, int fq) const {
        asm volatile("" : "+v"(fr), "+v"(fq));
        const int pn = u.pn;
        const int rowb = u.pm * 256 + wr * 64 + fr;
        const int colw = wc * 32 + 8 * fq;
        if constexpr (MODE == 1) {
            bf16_t* O; int ldc, cb;
            if (pn < 14) { O = p.PA; ldc = PA_LD; cb = pn * 256; } else { O = p.PB; ldc = PB_LD; cb = (pn - 14) * 256; }
            const int kind = (pn < 2) ? 1 : (pn >= 6 && pn < 8) ? 2 : (pn >= 8 && pn < 10) ? 3 : 0;
            float ssv[2][4]; f32x4 rc[2][4][2];
#pragma unroll
            for (int ai = 0; ai < 2; ++ai)
#pragma unroll
                for (int m = 0; m < 4; ++m) { const int row = rowb + ai * 128 + m * 16; ssv[ai][m] = p.ssq[row];
                    if (kind >= 2) { const f32x4* rp = p.rope + ((size_t)(row & 4095) * 64 + wc * 16 + 4 * fq) / 2; rc[ai][m][0] = rp[0]; rc[ai][m][1] = rp[1]; } }
            __builtin_amdgcn_sched_barrier(0);
#pragma unroll
            for (int ai = 0; ai < 2; ++ai)
#pragma unroll
                for (int m = 0; m < 4; ++m) {
                    const int row = rowb + ai * 128 + m * 16;
                    float sc = __builtin_amdgcn_rsqf(ssv[ai][m] * (1.f / 1024.f) + EPS);
                    if (kind == 1) sc *= 0.125f * LOG2E;
#pragma unroll
                    for (int bj = 0; bj < 2; ++bj) {
                        f32x4 v0 = acc[ai][bj][m][0] * sc, v1 = acc[ai][bj][m][1] * sc;
                        if (kind >= 2) {
                            const int head = (pn - (kind == 2 ? 6 : 8)) * 2 + bj;
                            const float lg = __builtin_log2f(1.f - __builtin_exp2f(-5.f - (float)head));
                            const float e = (float)((row & 127) + 1) * lg;
                            const float dsc = (kind == 2) ? __builtin_amdgcn_exp2f(e) * 0.08838834764831845f : __builtin_amdgcn_exp2f(-e);
                            const f32x4 c01 = rc[ai][m][0], c23 = rc[ai][m][1];
                            f32x4 w0, w1;
                            w0[0] = (v0[0] * c01[0] - v0[1] * c01[1]) * dsc; w0[1] = (v0[0] * c01[1] + v0[1] * c01[0]) * dsc;
                            w0[2] = (v0[2] * c01[2] - v0[3] * c01[3]) * dsc; w0[3] = (v0[2] * c01[3] + v0[3] * c01[2]) * dsc;
                            w1[0] = (v1[0] * c23[0] - v1[1] * c23[1]) * dsc; w1[1] = (v1[0] * c23[1] + v1[1] * c23[0]) * dsc;
                            w1[2] = (v1[2] * c23[2] - v1[3] * c23[3]) * dsc; w1[3] = (v1[2] * c23[3] + v1[3] * c23[2]) * dsc;
                            v0 = w0; v1 = w1;
                        }
                        u32x4 w; w.x = pk_bf16(v0[0], v0[1]); w.y = pk_bf16(v0[2], v0[3]); w.z = pk_bf16(v1[0], v1[1]); w.w = pk_bf16(v1[2], v1[3]);
                        *(u32x4*)(O + (size_t)row * ldc + cb + bj * 128 + colw) = w;
                    }
                }
        } else if constexpr (MODE == 2 || MODE == 3) {
            const int goff = (MODE == 2) ? 1024 : 2048, boff = (MODE == 2) ? 0 : 1024;
            f32x4 bb[2][2];
#pragma unroll
            for (int bj = 0; bj < 2; ++bj) { const int col = pn * 256 + bj * 128 + colw; bb[bj][0] = *(const f32x4*)(p.bgate + boff + col); bb[bj][1] = *(const f32x4*)(p.bgate + boff + col + 4); }
#pragma unroll
            for (int aih = 0; aih < 4; ++aih) {
              const int ai = aih >> 1, mb = (aih & 1) * 2;
              u32x4 gwv[4][2], twv[4][2];
#pragma unroll
              for (int m = mb; m < mb + 2; ++m)
#pragma unroll
                for (int bj = 0; bj < 2; ++bj) { const int row = rowb + ai * 128 + m * 16, col = pn * 256 + bj * 128 + colw;
                    gwv[m][bj] = *(const u32x4*)(p.PB + (size_t)row * PB_LD + goff + col);
                    if constexpr (MODE == 3) twv[m][bj] = *(const u32x4*)(p.PA + (size_t)row * PA_LD + 512 + col); }
              __builtin_amdgcn_sched_barrier(0);
#pragma unroll
                for (int m = mb; m < mb + 2; ++m) {
                    const int row = rowb + ai * 128 + m * 16;
#pragma unroll
                    for (int bj = 0; bj < 2; ++bj) {
                        const int col = pn * 256 + bj * 128 + colw;
                        const u32x4 gw = gwv[m][bj];
                        f32x4 g0, g1;
                        g0[0] = bf_lo(gw.x); g0[1] = bf_hi(gw.x); g0[2] = bf_lo(gw.y); g0[3] = bf_hi(gw.y);
                        g1[0] = bf_lo(gw.z); g1[1] = bf_hi(gw.z); g1[2] = bf_lo(gw.w); g1[3] = bf_hi(gw.w);
                        g0 += bb[bj][0]; g1 += bb[bj][1];
                        f32x4 v0 = acc[ai][bj][m][0], v1 = acc[ai][bj][m][1];
#pragma unroll
                        for (int k = 0; k < 4; ++k) { v0[k] *= sigmoidf_(g0[k]); v1[k] *= sigmoidf_(g1[k]); }
                        if constexpr (MODE == 3) {
                            const u32x4 tw = twv[m][bj];
                            v0[0] += bf_lo(tw.x); v0[1] += bf_hi(tw.x); v0[2] += bf_lo(tw.y); v0[3] += bf_hi(tw.y);
                            v1[0] += bf_lo(tw.z); v1[1] += bf_hi(tw.z); v1[2] += bf_lo(tw.w); v1[3] += bf_hi(tw.w);
                        }
                        u32x4 w; w.x = pk_bf16(v0[0], v0[1]); w.y = pk_bf16(v0[2], v0[3]); w.z = pk_bf16(v1[0], v1[1]); w.w = pk_bf16(v1[2], v1[3]);
                        *(u32x4*)(p.PA + (size_t)row * PA_LD + (MODE == 2 ? 512 : 1536) + col) = w;
                    }
                }
            }
        } else if constexpr (MODE == 4) {
            f32x4 gg[2][2];
#pragma unroll
            for (int bj = 0; bj < 2; ++bj) { const int col = pn * 256 + bj * 128 + colw; gg[bj][0] = *(const f32x4*)(p.gnext + col); gg[bj][1] = *(const f32x4*)(p.gnext + col + 4); }
#pragma unroll
            for (int ai = 0; ai < 2; ++ai) {
              f32x4 xv[4][2][2];
#pragma unroll
              for (int m = 0; m < 4; ++m)
#pragma unroll
                for (int bj = 0; bj < 2; ++bj) { const size_t off = (size_t)(rowb + ai * 128 + m * 16) * D + pn * 256 + bj * 128 + colw;
                    xv[m][bj][0] = *(const f32x4*)(p.xin + off); xv[m][bj][1] = *(const f32x4*)(p.xin + off + 4); }
              __builtin_amdgcn_sched_barrier(0);
#pragma unroll
                for (int m = 0; m < 4; ++m) {
                    const int row = rowb + ai * 128 + m * 16;
                    const bool keep = (row & 4095) != 0;
                    float ss = 0.f;
#pragma unroll
                    for (int bj = 0; bj < 2; ++bj) {
                        const int col = pn * 256 + bj * 128 + colw;
                        const size_t off = (size_t)row * D + col;
                        f32x4 x0 = xv[m][bj][0], x1 = xv[m][bj][1];
                        x0 += acc[ai][bj][m][0]; x1 += acc[ai][bj][m][1];
                        if (keep) { *(f32x4*)(p.xout + off) = x0; *(f32x4*)(p.xout + off + 4) = x1; }
                        ss += (x0[0] * x0[0] + x0[1] * x0[1]) + (x0[2] * x0[2] + x0[3] * x0[3]) + (x1[0] * x1[0] + x1[1] * x1[1]) + (x1[2] * x1[2] + x1[3] * x1[3]);
                        x0 *= gg[bj][0]; x1 *= gg[bj][1];
                        u32x4 w; w.x = pk_bf16(x0[0], x0[1]); w.y = pk_bf16(x0[2], x0[3]); w.z = pk_bf16(x1[0], x1[1]); w.w = pk_bf16(x1[2], x1[3]);
                        if (keep && p.wxn) *(u32x4*)(p.XN + off) = w;
                    }
                    ss += shx(ss, 16); ss += shx(ss, 32);
                    if (fq == 0 && keep) unsafeAtomicAdd(p.ssq_out + row, ss);
                }
            }
        } else if constexpr (MODE == 7) {
            f32x4 xn[2][4][2][2];
#pragma unroll
            for (int ai = 0; ai < 2; ++ai) {
#pragma unroll
              for (int m = 0; m < 4; ++m)
#pragma unroll
                for (int bj = 0; bj < 2; ++bj) { const size_t off = (size_t)(rowb + ai * 128 + m * 16) * D + pn * 256 + bj * 128 + colw;
                    xn[ai][m][bj][0] = *(const f32x4*)(p.xin + off); xn[ai][m][bj][1] = *(const f32x4*)(p.xin + off + 4); }
              __builtin_amdgcn_sched_barrier(0);
#pragma unroll
                for (int m = 0; m < 4; ++m) {
                    const int row = rowb + ai * 128 + m * 16;
                    float ss = 0.f;
#pragma unroll
                    for (int bj = 0; bj < 2; ++bj) {
                        f32x4 x0 = xn[ai][m][bj][0] + acc[ai][bj][m][0], x1 = xn[ai][m][bj][1] + acc[ai][bj][m][1];
                        xn[ai][m][bj][0] = x0; xn[ai][m][bj][1] = x1;
                        ss += (x0[0] * x0[0] + x0[1] * x0[1]) + (x0[2] * x0[2] + x0[3] * x0[3]) + (x1[0] * x1[0] + x1[1] * x1[1]) + (x1[2] * x1[2] + x1[3] * x1[3]);
                    }
                    ss += shx(ss, 16); ss += shx(ss, 32);
                    if (fq == 0 && (row & 4095) != 0) unsafeAtomicAdd(p.ssq_out + row, ss);
                }
            }
            asm volatile("s_waitcnt vmcnt(0) lgkmcnt(0)\n\ts_barrier" ::: "memory");
            if (wr == 0 && wc == 0 && fr == 0 && fq == 0) {
                unsigned* c = p.cnt + 64 * u.pm;
                __hip_atomic_fetch_add(c, 1u, __ATOMIC_RELAXED, __HIP_MEMORY_SCOPE_AGENT);
                unsigned spins = 0;
                while (__hip_atomic_load(c, __ATOMIC_RELAXED, __HIP_MEMORY_SCOPE_AGENT) < 4u && ++spins < (1u << 22)) __builtin_amdgcn_s_sleep(1);
            }
            asm volatile("s_waitcnt vmcnt(0) lgkmcnt(0)\n\ts_barrier" ::: "memory");
            f32x4 gg[2][2];
#pragma unroll
            for (int bj = 0; bj < 2; ++bj) { const int col = pn * 256 + bj * 128 + colw; gg[bj][0] = *(const f32x4*)(p.gnext + col); gg[bj][1] = *(const f32x4*)(p.gnext + col + 4); }
            float sq[2][4];
#pragma unroll
            for (int ai = 0; ai < 2; ++ai)
#pragma unroll
                for (int m = 0; m < 4; ++m) sq[ai][m] = __hip_atomic_load(p.ssq_out + rowb + ai * 128 + m * 16, __ATOMIC_RELAXED, __HIP_MEMORY_SCOPE_AGENT);
#pragma unroll
            for (int ai = 0; ai < 2; ++ai)
#pragma unroll
                for (int m = 0; m < 4; ++m) {
                    const int row = rowb + ai * 128 + m * 16;
                    const float rs = __builtin_amdgcn_rsqf(sq[ai][m] * (1.f / 1024.f) + EPS);
                    if ((row & 4095) != 0) {
#pragma unroll
                        for (int bj = 0; bj < 2; ++bj) { const size_t off = (size_t)row * D + pn * 256 + bj * 128 + colw;
                            *(f32x4*)(p.xout + off) = xn[ai][m][bj][0] * rs * gg[bj][0]; *(f32x4*)(p.xout + off + 4) = xn[ai][m][bj][1] * rs * gg[bj][1]; }
                    }
                }
        } else if constexpr (MODE == 6) {
            const int sq_ = u.pm / 17, jt = u.pm - sq_ * 17, p0 = 254 * jt - 2;
            const int colh = pn * 128 + colw;
            float rsv[2][4];
#pragma unroll
            for (int ai = 0; ai < 2; ++ai)
#pragma unroll
                for (int m = 0; m < 4; ++m) { int grow = sq_ * 4096 + p0 + ai * 128 + wr * 64 + m * 16 + fr; grow = grow < 0 ? 0 : (grow > M - 1 ? M - 1 : grow); rsv[ai][m] = p.ssq[grow]; }
            __builtin_amdgcn_sched_barrier(0);
#pragma unroll
            for (int ai = 0; ai < 2; ++ai)
#pragma unroll
                for (int m = 0; m < 4; ++m) rsv[ai][m] = __builtin_amdgcn_rsqf(rsv[ai][m] * (1.f / 1024.f) + EPS);
            if (fr >= 14) {
#pragma unroll
                for (int ai = 0; ai < 2; ++ai) {
                    const float rs = rsv[ai][3];
                    LAS float* d = p.xch + ((((ai * 2 + wr) * 4 + wc) * 4 + fq) * 2 + (fr - 14)) * 8;
                    *(LAS f32x4*)d = acc[ai][0][3][0] * rs; *(LAS f32x4*)(d + 4) = acc[ai][0][3][1] * rs; }
            }
            asm volatile("s_waitcnt lgkmcnt(0)\n\ts_barrier" ::: "memory");
            float w0[8], w1[8], w2[8], cbv[8];
#pragma unroll
            for (int k = 0; k < 8; ++k) { w0[k] = p.cw[colh + k]; w1[k] = p.cw[FF + colh + k]; w2[k] = p.cw[2 * FF + colh + k]; cbv[k] = p.cb[colh + k]; }
#pragma unroll
            for (int ai = 0; ai < 2; ++ai) {
                float r1p[8], r2p[8];
                {
                    const bool has = (wr == 1) || (ai == 1);
                    const int ais = (wr == 1) ? ai : ai - 1, wrs = (wr == 1) ? 0 : 1;
                    f32x4 h62a = (f32x4){0.f, 0.f, 0.f, 0.f}, h62b = h62a, h63a = h62a, h63b = h62a;
                    if (has) { const LAS float* s = p.xch + ((((ais * 2 + wrs) * 4 + wc) * 4 + fq) * 2) * 8;
                        h62a = *(const LAS f32x4*)s; h62b = *(const LAS f32x4*)(s + 4); h63a = *(const LAS f32x4*)(s + 8); h63b = *(const LAS f32x4*)(s + 12); }
#pragma unroll
                    for (int k = 0; k < 4; ++k) { r1p[k] = h63a[k]; r1p[4 + k] = h63b[k]; r2p[k] = (fr == 0) ? h62a[k] : h63a[k]; r2p[4 + k] = (fr == 0) ? h62b[k] : h63b[k]; }
                }
#pragma unroll
                for (int m = 0; m < 4; ++m) {
                    const int lr = ai * 128 + wr * 64 + m * 16 + fr, pos = p0 + lr;
                    const float rs = rsv[ai][m];
                    float y[8];
#pragma unroll
                    for (int k = 0; k < 8; ++k) {
                        const float a0 = (k < 4 ? acc[ai][0][m][0][k & 3] : acc[ai][0][m][1][k & 3]) * rs;
                        const float r1 = __int_as_float(__builtin_amdgcn_update_dpp(0, __float_as_int(a0), 0x121, 0xf, 0xf, false));
                        const float r2 = __int_as_float(__builtin_amdgcn_update_dpp(0, __float_as_int(a0), 0x122, 0xf, 0xf, false));
                        float t1 = (fr == 0) ? r1p[k] : r1, t2 = (fr < 2) ? r2p[k] : r2;
                        r1p[k] = r1; r2p[k] = r2;
                        t1 = (pos >= 1) ? t1 : 0.f; t2 = (pos >= 2) ? t2 : 0.f;
                        const float cv = w0[k] * t2 + w1[k] * t1 + w2[k] * a0 + cbv[k];
                        const float bvv = (k < 4 ? acc[ai][1][m][0][k & 3] : acc[ai][1][m][1][k & 3]) * rs;
                        y[k] = cv * sigmoidf_(cv) * bvv;
                    }
                    if (lr >= 2 && pos < 4096)
                        *(u32x4*)(p.H + (size_t)(sq_ * 4096 + pos) * FF + colh) = (u32x4){pk_bf16(y[0], y[1]), pk_bf16(y[2], y[3]), pk_bf16(y[4], y[5]), pk_bf16(y[6], y[7])};
                }
            }
        } else {
#pragma unroll
            for (int ai = 0; ai < 2; ++ai)
#pragma unroll
                for (int m = 0; m < 4; ++m) {
                    const int row = rowb + ai * 128 + m * 16;
                    const float sc = __builtin_amdgcn_rsqf(p.ssq[row] * (1.f / 1024.f) + EPS);
#pragma unroll
                    for (int bj = 0; bj < 2; ++bj) {
                        const f32x4 v0 = acc[ai][bj][m][0] * sc, v1 = acc[ai][bj][m][1] * sc;
                        u32x4 w; w.x = pk_bf16(v0[0], v0[1]); w.y = pk_bf16(v0[2], v0[3]); w.z = pk_bf16(v1[0], v1[1]); w.w = pk_bf16(v1[2], v1[3]);
                        *(u32x4*)(p.U + (size_t)row * U_LD + pn * 256 + bj * 128 + colw) = w;
                    }
                }
        }
    }
};

namespace sb {
constexpr int PITCH = PA_LD, NW = 8, QB = 256, KVBLK = 64;
constexpr int NSLOT = 6, SLOTB = 8192;
constexpr int LDS_K = 0, LDS_V = NSLOT * SLOTB, LDS_OST = 2 * NSLOT * SLOTB, LDS_BYTES = LDS_OST + NW * 4096;
__device__ __forceinline__ void glds16(const void* gsrc, unsigned lds_dst) { unsigned keep;
    asm volatile("s_mov_b32 %0, m0\n\ts_mov_b32 m0, %2\n\ts_nop 0\n\tglobal_load_lds_dwordx4 %1, off\n\ts_mov_b32 m0, %0" : "=&s"(keep) : "v"(gsrc), "s"(lds_dst) : "memory"); }
__device__ __forceinline__ int crow(int r, int hi) { return (r & 3) + 8 * (r >> 2) + 4 * hi; }
typedef short v4i16_t __attribute__((ext_vector_type(4)));
__device__ __forceinline__ s16x4 vtr(const LAS char* p) { return __builtin_bit_cast(s16x4, __builtin_amdgcn_ds_read_tr16_b64_v4i16((LAS v4i16_t*)p)); }

__device__ __forceinline__ void unit(int b, int h, int qb, bf16_t* PA, LAS char* shm) {
    int tid_ = threadIdx.x; asm volatile("" : "+v"(tid_));
    const int tid = tid_, lane = tid & 63, r32 = lane & 31, hi = lane >> 5; const int wid = __builtin_amdgcn_readfirstlane(tid >> 6);
    const long rowbase = (long)b * SEQ; const int q0 = qb * QB;
    const bf16_t* Qw = PA + (rowbase + q0 + wid * 32) * PITCH + h * 64;
    const bf16_t* Kh = PA + rowbase * PITCH + 512 + h * 64;
    const bf16_t* Vh = PA + rowbase * PITCH + 1024 + h * 64;
    const unsigned lds0 = (unsigned)(uintptr_t)shm;
    const int kperm = ((lane >> 2) & 1) * 32 + (lane >> 5) * 16 + ((lane & 31) >> 3) * 4 + (lane & 3);
    const bf16_t* ksrc = Kh + (long)kperm * PITCH + wid * 8;
    const bf16_t* vsrc = Vh + (long)(16 * (wid & 3) + (lane >> 2)) * PITCH + (wid >> 2) * 32 + (lane & 3) * 8;
    const unsigned kdst = lds0 + LDS_K + wid * 1024, vdst = lds0 + LDS_V + wid * 1024;
#define DMA_KV(t, slot) do { glds16(ksrc + (long)(t) * KVBLK * PITCH, (unsigned)__builtin_amdgcn_readfirstlane(kdst + (slot))); \
                             glds16(vsrc + (long)(t) * KVBLK * PITCH, (unsigned)__builtin_amdgcn_readfirstlane(vdst + (slot))); } while (0)
    const int NT = (q0 + QB) / KVBLK;
    bf16x8 qr[4];
#pragma unroll
    for (int d0 = 0; d0 < 4; ++d0) qr[d0] = *reinterpret_cast<const bf16x8*>(&Qw[(long)r32 * PITCH + d0 * 16 + hi * 8]);
    DMA_KV(NT - 1, 0); DMA_KV(NT - 2, SLOTB); DMA_KV(NT - 3, 2 * SLOTB); DMA_KV(NT - 4, 3 * SLOTB);
    asm volatile("" : "+v"(qr[0]), "+v"(qr[1]), "+v"(qr[2]), "+v"(qr[3]));
    f32x16 o[2]; o[0] = f32x16{}; o[1] = f32x16{};
    float carry = 1.f;
    const int qrel = wid * 32 + r32;
    const LAS char* kp0 = shm + LDS_K + hi * 1024 + r32 * 16;
    const LAS char* vp0 = shm + LDS_V + (32 * hi + ((lane & 15) >> 2)) * 64 + ((lane >> 4) & 1) * 32 + (lane & 3) * 8;
    auto tile = [&](const int t, const int slot) __attribute__((always_inline)) {
        const int jb = t - (NT - 4);
        if (jb <= (wid >> 1)) {
            const LAS char* kb = kp0 + slot; const LAS char* vb = vp0 + slot;
            bf16x8 kf[8];
#pragma unroll
            for (int d0 = 0; d0 < 4; ++d0) { kf[2 * d0] = *(const LAS bf16x8*)(kb + d0 * 2048); kf[2 * d0 + 1] = *(const LAS bf16x8*)(kb + d0 * 2048 + 512); }
            s16x4 vl[8], vh[8];
#pragma unroll
            for (int i = 0; i < 8; ++i) { vl[i] = vtr(vb + (i >> 2) * 4096 + (i & 3) * 512); vh[i] = vtr(vb + (i >> 2) * 4096 + (i & 3) * 512 + 256); }
            __builtin_amdgcn_sched_barrier(0);
            f32x16 p0 = f32x16{}, p1 = f32x16{};
#pragma unroll
            for (int d0 = 0; d0 < 4; ++d0) {
                p0 = __builtin_amdgcn_mfma_f32_32x32x16_bf16(kf[2 * d0], qr[d0], p0, 0, 0, 0);
                p1 = __builtin_amdgcn_mfma_f32_32x32x16_bf16(kf[2 * d0 + 1], qr[d0], p1, 0, 0, 0);
            }
#pragma unroll
            for (int r = 0; r < 16; ++r) { p0[r] = __builtin_amdgcn_exp2f(__builtin_amdgcn_fmed3f(p0[r], 15.f, -3.0e38f)); p1[r] = __builtin_amdgcn_exp2f(__builtin_amdgcn_fmed3f(p1[r], 15.f, -3.0e38f)); }
            if (jb == (wid >> 1)) {
                const int kb0 = 64 * jb + 32 * hi;
#pragma unroll
                for (int r = 0; r < 16; ++r) { if (kb0 + r >= qrel) p0[r] = 0.f; if (kb0 + 16 + r >= qrel) p1[r] = 0.f; }
            }
            float R0, R1, R2, R3;
            { float Q = 1.f;
#pragma unroll
              for (int i = 0; i < 8; ++i) { const float d = Q * p0[i]; p0[i] = d; Q += d; }
              R0 = __builtin_amdgcn_rcpf(Q); }
            { float Q = 1.f;
#pragma unroll
              for (int i = 8; i < 16; ++i) { const float d = Q * p0[i]; p0[i] = d; Q += d; }
              R1 = __builtin_amdgcn_rcpf(Q); }
            { float Q = 1.f;
#pragma unroll
              for (int i = 0; i < 8; ++i) { const float d = Q * p1[i]; p1[i] = d; Q += d; }
              R2 = __builtin_amdgcn_rcpf(Q); }
            { float Q = 1.f;
#pragma unroll
              for (int i = 8; i < 16; ++i) { const float d = Q * p1[i]; p1[i] = d; Q += d; }
              R3 = __builtin_amdgcn_rcpf(Q); }
            const float Tl = (R0 * R1) * (R2 * R3);
            float Tp;
            { const auto rr = __builtin_amdgcn_permlane32_swap(__float_as_uint(Tl), __float_as_uint(Tl), false, false); Tp = __uint_as_float(hi == 0 ? rr[1] : rr[0]); }
            const float base = carry * (hi == 0 ? Tp : 1.f);
            carry = carry * Tl * Tp;
            const float sc3 = base * R3, sc2 = sc3 * R2, sc1 = sc2 * R1, sc0 = sc1 * R0;
#pragma unroll
            for (int i = 0; i < 8; ++i) { p0[i] *= sc0; p0[8 + i] *= sc1; p1[i] *= sc2; p1[8 + i] *= sc3; }
            u32x4 pw0, pw1, pw2, pw3;
            pw0 = (u32x4){pk_bf16(p0[0], p0[1]), pk_bf16(p0[2], p0[3]), pk_bf16(p0[4], p0[5]), pk_bf16(p0[6], p0[7])};
            pw1 = (u32x4){pk_bf16(p0[8], p0[9]), pk_bf16(p0[10], p0[11]), pk_bf16(p0[12], p0[13]), pk_bf16(p0[14], p0[15])};
            pw2 = (u32x4){pk_bf16(p1[0], p1[1]), pk_bf16(p1[2], p1[3]), pk_bf16(p1[4], p1[5]), pk_bf16(p1[6], p1[7])};
            pw3 = (u32x4){pk_bf16(p1[8], p1[9]), pk_bf16(p1[10], p1[11]), pk_bf16(p1[12], p1[13]), pk_bf16(p1[14], p1[15])};
#pragma unroll
            for (int d0 = 0; d0 < 2; ++d0) {
#define PKV(k) (bf16x8){vl[d0 * 4 + k][0], vl[d0 * 4 + k][1], vl[d0 * 4 + k][2], vl[d0 * 4 + k][3], vh[d0 * 4 + k][0], vh[d0 * 4 + k][1], vh[d0 * 4 + k][2], vh[d0 * 4 + k][3]}
                o[d0] = __builtin_amdgcn_mfma_f32_32x32x16_bf16(__builtin_bit_cast(bf16x8, pw0), PKV(0), o[d0], 0, 0, 0);
                o[d0] = __builtin_amdgcn_mfma_f32_32x32x16_bf16(__builtin_bit_cast(bf16x8, pw1), PKV(1), o[d0], 0, 0, 0);
                o[d0] = __builtin_amdgcn_mfma_f32_32x32x16_bf16(__builtin_bit_cast(bf16x8, pw2), PKV(2), o[d0], 0, 0, 0);
                o[d0] = __builtin_amdgcn_mfma_f32_32x32x16_bf16(__builtin_bit_cast(bf16x8, pw3), PKV(3), o[d0], 0, 0, 0);
#undef PKV
            }
        }
    };
    int si = 0;
    for (int t = NT - 1; t >= 1; t -= 2) {
        if (t >= 3) asm volatile("s_waitcnt vmcnt(4) lgkmcnt(0)\n\ts_barrier" ::: "memory");
        else        asm volatile("s_waitcnt vmcnt(0) lgkmcnt(0)\n\ts_barrier" ::: "memory");
        const int s1 = (si + 1 >= NSLOT) ? si + 1 - NSLOT : si + 1;
        if (t >= 5) { const int s4 = (si + 4 >= NSLOT) ? si + 4 - NSLOT : si + 4, s5 = (si + 5 >= NSLOT) ? si + 5 - NSLOT : si + 5;
            DMA_KV(t - 4, s4 * SLOTB); DMA_KV(t - 5, s5 * SLOTB); }
        tile(t, si * SLOTB); tile(t - 1, s1 * SLOTB);
        si = (si + 2 >= NSLOT) ? si + 2 - NSLOT : si + 2;
    }
    bf16_t* Ow = PA + (rowbase + q0 + wid * 32) * PITCH + h * 64;
    {
        LAS bf16_t* stg = (LAS bf16_t*)(shm + LDS_OST) + wid * 2048;
#pragma unroll
        for (int r = 0; r < 16; ++r) { const int orow = crow(r, hi);
#pragma unroll
            for (int d0 = 0; d0 < 2; ++d0) stg[orow * 64 + d0 * 32 + r32] = (bf16_t)(pk_bf16(o[d0][r], 0.f) & 0xffffu); }
        asm volatile("s_waitcnt lgkmcnt(0)" ::: "memory");
#pragma unroll
        for (int i = 0; i < 4; ++i) { const int row = i * 8 + (lane >> 3), ch = lane & 7; const u32x4 v = *(const LAS u32x4*)(stg + row * 64 + ch * 8); *(u32x4*)(Ow + (long)row * PITCH + ch * 8) = v; }
    }
    asm volatile("s_waitcnt vmcnt(0) lgkmcnt(0)\n\ts_barrier" ::: "memory");
#undef DMA_KV
}
}

namespace ret {
constexpr int RS = 272;
constexpr int L_Q = 0, L_K = 128 * RS, L_P = 2 * 128 * RS, L_V = 3 * 128 * RS, L_S = L_V + 128 * 64, LDS_BYTES = L_S + 2 * 32 * RS;
typedef short v4i16_t __attribute__((ext_vector_type(4)));
__device__ __forceinline__ s16x4 vtr(const LAS char* p) { return __builtin_bit_cast(s16x4, __builtin_amdgcn_ds_read_tr16_b64_v4i16((LAS v4i16_t*)p)); }
__device__ __forceinline__ bf16x8 cat(s16x4 a, s16x4 b) { return (bf16x8){a[0], a[1], a[2], a[3], b[0], b[1], b[2], b[3]}; }

__device__ __forceinline__ void item(int b, int h, int sl, bf16_t* PA, LAS char* shm) {
    int tid_ = threadIdx.x; asm volatile("" : "+v"(tid_));
    const int tid = tid_, lane = tid & 63, fr = lane & 15, fq = lane >> 4; const int wid = __builtin_amdgcn_readfirstlane(tid >> 6);
    const size_t rowbase = (size_t)b * SEQ;
    const bf16_t* Qg = PA + rowbase * PA_LD + 1536 + h * 128;
    const bf16_t* Kg = PA + rowbase * PA_LD + 2048 + h * 128;
    bf16_t* Vg = PA + rowbase * PA_LD + 2560 + h * 256 + sl * 32;
    const float lg = __builtin_log2f(1.f - __builtin_exp2f(-5.f - (float)h));
    const float gam128 = __builtin_exp2f(128.f * lg);
    for (int i = tid; i < 32 * RS / 4; i += 512) ((LAS unsigned*)(shm + L_S))[i] = 0u;
    u32x4 qA[4], kA[4], vA, qB[4], kB[4], vB;
#define RET_LOAD(c, Q_, K_, V_) do { _Pragma("unroll") for (int i = 0; i < 4; ++i) { const int id = tid + 512 * i, row = id >> 4, ch = id & 15; \
            Q_[i] = *(const u32x4*)(Qg + (size_t)((c) * 128 + row) * PA_LD + ch * 8); K_[i] = *(const u32x4*)(Kg + (size_t)((c) * 128 + row) * PA_LD + ch * 8); } \
        V_ = *(const u32x4*)(Vg + (size_t)((c) * 128 + (tid >> 2)) * PA_LD + (tid & 3) * 8); } while (0)
#define RET_STORE(Q_, K_, V_) do { _Pragma("unroll") for (int i = 0; i < 4; ++i) { const int id = tid + 512 * i, row = id >> 4, ch = id & 15; \
            *(LAS u32x4*)(shm + L_Q + row * RS + ch * 16) = Q_[i]; *(LAS u32x4*)(shm + L_K + row * RS + ch * 16) = K_[i]; } \
        *(LAS u32x4*)(shm + L_V + (tid >> 2) * 64 + (tid & 3) * 16) = V_; } while (0)
    RET_LOAD(0, qA, kA, vA); RET_LOAD(1, qB, kB, vB);
    f32x4 st[2]; st[0] = (f32x4){0.f, 0.f, 0.f, 0.f}; st[1] = st[0];
    auto step = [&](const int c, u32x4 (&Qs)[4], u32x4 (&Ks)[4], u32x4& Vs) __attribute__((always_inline)) {
        RET_STORE(Qs, Ks, Vs);
        asm volatile("s_waitcnt lgkmcnt(0)\n\ts_barrier" ::: "memory");
        if (c + 2 < 32) RET_LOAD(c + 2, Qs, Ks, Vs);
        const LAS char* Scur = shm + L_S + (c & 1) * 32 * RS; LAS char* Snxt = shm + L_S + ((c + 1) & 1) * 32 * RS;
        bf16x8 bq[4];
        {
#pragma unroll
            for (int ks = 0; ks < 4; ++ks) bq[ks] = *(const LAS bf16x8*)(shm + L_Q + (16 * wid + fr) * RS + (ks * 32 + 8 * fq) * 2);
            const int n = 16 * wid + fr;
#pragma unroll
            for (int hb = 0; hb < 2; ++hb) {
                bf16x8 ak[4][4];
#pragma unroll
                for (int mi = 0; mi < 4; ++mi)
#pragma unroll
                    for (int ks = 0; ks < 4; ++ks) ak[mi][ks] = *(const LAS bf16x8*)(shm + L_K + (16 * (4 * hb + mi) + fr) * RS + (ks * 32 + 8 * fq) * 2);
                __builtin_amdgcn_sched_barrier(0);
#pragma unroll
                for (int mi = 0; mi < 4; ++mi) {
                    f32x4 a4 = (f32x4){0.f, 0.f, 0.f, 0.f};
#pragma unroll
                    for (int ks = 0; ks < 4; ++ks) a4 = __builtin_amdgcn_mfma_f32_16x16x32_bf16(ak[mi][ks], bq[ks], a4, 0, 0, 0);
                    const int m0 = 16 * (4 * hb + mi) + 4 * fq;
#pragma unroll
                    for (int k = 0; k < 4; ++k) if (m0 + k > n) a4[k] = 0.f;
                    u32x2 w; w.x = pk_bf16(a4[0], a4[1]); w.y = pk_bf16(a4[2], a4[3]);
                    *(LAS u32x2*)(shm + L_P + n * RS + m0 * 2) = w;
                }
                __builtin_amdgcn_sched_barrier(0);
            }
        }
        bf16x8 vf[4][2];
        {
            bf16x8 kfr[4];
#pragma unroll
            for (int ks = 0; ks < 4; ++ks) {
                const int r0 = 32 * ks + 8 * fq + (fr >> 2);
                const LAS char* ka = shm + L_K + r0 * RS + (16 * wid + 4 * (fr & 3)) * 2;
                kfr[ks] = cat(vtr(ka), vtr(ka + 4 * RS));
#pragma unroll
                for (int eb = 0; eb < 2; ++eb) { const LAS char* va = shm + L_V + r0 * 64 + (16 * eb + 4 * (fr & 3)) * 2; vf[ks][eb] = cat(vtr(va), vtr(va + 4 * 64)); }
            }
            __builtin_amdgcn_sched_barrier(0);
            f32x4 kv[2]; kv[0] = (f32x4){0.f, 0.f, 0.f, 0.f}; kv[1] = kv[0];
#pragma unroll
            for (int ks = 0; ks < 4; ++ks)
#pragma unroll
                for (int eb = 0; eb < 2; ++eb) kv[eb] = __builtin_amdgcn_mfma_f32_16x16x32_bf16(kfr[ks], vf[ks][eb], kv[eb], 0, 0, 0);
#pragma unroll
            for (int eb = 0; eb < 2; ++eb) {
                st[eb] = (st[eb] + kv[eb]) * gam128;
                u32x2 w; w.x = pk_bf16(st[eb][0], st[eb][1]); w.y = pk_bf16(st[eb][2], st[eb][3]);
                *(LAS u32x2*)(Snxt + (16 * eb + fr) * RS + (16 * wid + 4 * fq) * 2) = w;
            }
        }
        asm volatile("s_waitcnt lgkmcnt(0)\n\ts_barrier" ::: "memory");
        {
            bf16x8 bp[4], as_[4][2];
#pragma unroll
            for (int ks = 0; ks < 4; ++ks) {
                bp[ks] = *(const LAS bf16x8*)(shm + L_P + (16 * wid + fr) * RS + (ks * 32 + 8 * fq) * 2);
#pragma unroll
                for (int eb = 0; eb < 2; ++eb) as_[ks][eb] = *(const LAS bf16x8*)(Scur + (16 * eb + fr) * RS + (ks * 32 + 8 * fq) * 2);
            }
            __builtin_amdgcn_sched_barrier(0);
            f32x4 oa[2]; oa[0] = (f32x4){0.f, 0.f, 0.f, 0.f}; oa[1] = oa[0];
#pragma unroll
            for (int ks = 0; ks < 4; ++ks)
#pragma unroll
                for (int eb = 0; eb < 2; ++eb) {
                    oa[eb] = __builtin_amdgcn_mfma_f32_16x16x32_bf16(vf[ks][eb], bp[ks], oa[eb], 0, 0, 0);
                    oa[eb] = __builtin_amdgcn_mfma_f32_16x16x32_bf16(as_[ks][eb], bq[ks], oa[eb], 0, 0, 0);
                }
#pragma unroll
            for (int eb = 0; eb < 2; ++eb) {
                u32x2 w; w.x = pk_bf16(oa[eb][0], oa[eb][1]); w.y = pk_bf16(oa[eb][2], oa[eb][3]);
                *(u32x2*)(Vg + (size_t)(c * 128 + 16 * wid + fr) * PA_LD + 16 * eb + 4 * fq) = w;
            }
        }
    };
    for (int c = 0; c < 32; c += 2) { step(c, qA, kA, vA); step(c + 1, qB, kB, vB); }
    asm volatile("s_waitcnt lgkmcnt(0)\n\ts_barrier" ::: "memory");
#undef RET_LOAD
#undef RET_STORE
}
}


namespace side {
constexpr int RED_OFF = 98304;
__device__ __forceinline__ void gemv_item(LAS unsigned char* lds, const float* W, int ldw, int kb, int n0, float* outp, int ldo) {
    int tid_ = threadIdx.x; asm volatile("" : "+v"(tid_));
    const int tid = tid_, lane = tid & 63, wave = __builtin_amdgcn_readfirstlane(tid >> 6);
    const LAS f32x4* A = (const LAS f32x4*)lds;
    float acc[8];
#pragma unroll
    for (int r = 0; r < 8; ++r) acc[r] = 0.f;
    const int k0 = kb + wave * 32;
    const float* wp = W + (size_t)k0 * ldw + n0 + lane;
    float w[32];
#pragma unroll
    for (int k = 0; k < 32; ++k) w[k] = wp[(size_t)k * ldw];
#pragma unroll
    for (int k = 0; k < 32; ++k) {
        const f32x4 a0 = A[(k0 + k) * 2], a1 = A[(k0 + k) * 2 + 1];
        acc[0] += a0[0] * w[k]; acc[1] += a0[1] * w[k]; acc[2] += a0[2] * w[k]; acc[3] += a0[3] * w[k];
        acc[4] += a1[0] * w[k]; acc[5] += a1[1] * w[k]; acc[6] += a1[2] * w[k]; acc[7] += a1[3] * w[k];
    }
    LAS float* red = (LAS float*)(lds + RED_OFF);
#pragma unroll
    for (int r = 0; r < 8; ++r) red[(wave * 8 + r) * 64 + lane] = acc[r];
    __syncthreads();
    { float s = 0.f;
#pragma unroll
      for (int ww = 0; ww < 8; ++ww) s += red[(ww * 8 + wave) * 64 + lane];
      unsafeAtomicAdd(outp + (size_t)wave * ldo + n0 + lane, s); }
    __syncthreads();
}
__device__ __forceinline__ void prep_norm(LAS unsigned char* lds, const float* xa, size_t xa_stride, const float* add, const float* g, bool wr, float* outw, bf16_t* XNw, float* ssqw, float* xsw, bool normw = false) {
    int tid_ = threadIdx.x; asm volatile("" : "+v"(tid_));
    const int lane = tid_ & 63, r = __builtin_amdgcn_readfirstlane(tid_ >> 6);
    const size_t rowoff = (size_t)r * SEQ * D;
    float v[16]; float s = 0.f;
#pragma unroll
    for (int j = 0; j < 16; ++j) { const int k = lane + 64 * j; v[j] = xa[(size_t)r * xa_stride + k] + (add ? add[r * D + k] : 0.f); s += v[j] * v[j]; }
    s = wave_sum(s);
    const float rs = 1.f / sqrtf(s * (1.f / 1024.f) + EPS);
    LAS float* A = (LAS float*)lds;
#pragma unroll
    for (int j = 0; j < 16; ++j) { const int k = lane + 64 * j; const float gk = g[k]; A[k * 8 + r] = v[j] * gk * rs;
        if (wr) { outw[rowoff + k] = normw ? v[j] * gk * rs : v[j]; XNw[rowoff + k] = (bf16_t)(pk_bf16(v[j] * gk, 0.f) & 0xffffu); if (xsw) xsw[r * D + k] = v[j]; } }
    if (wr && lane == 0) ssqw[(size_t)r * SEQ] = s;
    __syncthreads();
}
__device__ __forceinline__ float silu_(float x) { return x / (1.f + __expf(-x)); }
__device__ __forceinline__ float sigm_(float x) { return 1.f / (1.f + __expf(-x)); }
}


__device__ __forceinline__ unsigned xb_ld(unsigned* p)              { return __hip_atomic_load(p, __ATOMIC_RELAXED, __HIP_MEMORY_SCOPE_AGENT); }
__device__ __forceinline__ unsigned xb_add(unsigned* p, unsigned v) { return __hip_atomic_fetch_add(p, v, __ATOMIC_RELAXED, __HIP_MEMORY_SCOPE_AGENT); }
__device__ __forceinline__ unsigned xb_xcc_id() { return (unsigned)__builtin_amdgcn_s_getreg((3 << 11) | 20) & 0xFu; }
#define XB_TMO      128
#define XB_XCNT(j)  (256  + 64 * (j))
#define XB_XSUB(j)  (1280 + 64 * (j))
#define XB_XGEN(j)  (2304 + 64 * (j))
#define XB_TOP      3328
#define XB_TOPGEN   3392
#define XCD_BAR_WORDS 3456
#define XB_SPIN_CAP (1u << 18)

#define XB_SPIN(cond, bar) do { unsigned _sp = 0; while (cond) { __builtin_amdgcn_s_sleep(1); \
    if ((++_sp & 255u) == 0u) { if (xb_ld(&(bar)[XB_TMO])) break; if (_sp > XB_SPIN_CAP) { atomicAdd(&(bar)[XB_TMO], 1u); break; } } } } while (0)

struct XcdBarrier {
    unsigned* bar; unsigned x;
    volatile LAS unsigned* st;
};

__device__ __forceinline__ XcdBarrier xcd_barrier_post(unsigned* bar, volatile LAS unsigned* st) {
    XcdBarrier b; b.bar = bar; b.x = xb_xcc_id(); b.st = st;
    if (threadIdx.x == 0) (void)xb_add(&bar[XB_XCNT(b.x)], 1u);
    return b;
}
__device__ __forceinline__ void xcd_barrier_complete(unsigned* bar, unsigned x, unsigned& nloc, unsigned& nx) {
    const unsigned G = gridDim.x * gridDim.y * gridDim.z;
    unsigned sum, cnt, mine, sp = 0u;
    for (;;) {
        sum = 0u; cnt = 0u; mine = 0u;
#pragma unroll
        for (unsigned j = 0; j < 16; ++j) { const unsigned c = xb_ld(&bar[XB_XCNT(j)]); sum += c; cnt += (c > 0u) ? 1u : 0u; mine = (j == x) ? c : mine; }
        if (sum == G) break;
        __builtin_amdgcn_s_sleep(1);
        if ((++sp & 255u) == 0u) { if (xb_ld(&bar[XB_TMO])) break; if (sp > XB_SPIN_CAP) { atomicAdd(&bar[XB_TMO], 1u); break; } }
    }
    nloc = mine > 0u ? mine : 1u; nx = cnt > 0u ? cnt : 1u;
}

__device__ __forceinline__ void xcd_barrier(const XcdBarrier& b) {
    asm volatile("s_waitcnt vmcnt(0)" ::: "memory");
    __syncthreads();
    if (threadIdx.x == 0) {
        unsigned* bar = b.bar;
        __builtin_amdgcn_s_waitcnt(0);
        unsigned nloc = b.st[0], nx = b.st[1];
        if (nloc == 0u) { xcd_barrier_complete(bar, b.x, nloc, nx); b.st[0] = nloc; b.st[1] = nx; }
        const unsigned old = xb_add(&bar[XB_XSUB(b.x)], 1u);
        const unsigned gen = old / nloc;
        if (old + 1u == (gen + 1u) * nloc) {
            __builtin_amdgcn_fence(__ATOMIC_RELEASE, "agent");
            asm volatile("s_waitcnt vmcnt(0)" ::: "memory");
            const unsigned og = xb_add(&bar[XB_TOP], 1u);
            const unsigned tg = og / nx;
            if (og + 1u == (tg + 1u) * nx) xb_add(&bar[XB_TOPGEN], 1u);
            else XB_SPIN(xb_ld(&bar[XB_TOPGEN]) == tg, bar);
            __builtin_amdgcn_fence(__ATOMIC_ACQUIRE, "agent");
            xb_add(&bar[XB_XGEN(b.x)], 1u);
            asm volatile("s_waitcnt vmcnt(0)" ::: "memory");
        } else {
            XB_SPIN(xb_ld(&bar[XB_XGEN(b.x)]) == gen, bar);
            __builtin_amdgcn_fence(__ATOMIC_ACQUIRE, "agent");
            asm volatile("s_waitcnt vmcnt(0)" ::: "memory");
        }
    }
    __syncthreads();
}


struct Args { const float* in[14]; float* out; unsigned char* ws; };

__device__ __forceinline__ int rope_prow(int n) { if (n >= 1536 && n < 2560) { const int j = (n - 1536) & 127, base = n - j; return base + (j < 64 ? 2 * j : 2 * (j - 64) + 1); } return n; }
#define TI_LOAD(wv, W, N, item) do { const int nblk_ = (N) / 32, k0_ = 64 * ((item) / nblk_), n0_ = 32 * ((item) % nblk_); \
    _Pragma("unroll") for (int i = 0; i < 32; ++i) wv[i] = (W)[(size_t)(k0_ + 2 * i + (lane >> 5)) * (N) + n0_ + (lane & 31)]; } while (0)
#define TI_STORE(wv, WT, N, ldt, koff, perm, item) do { const int nblk_ = (N) / 32, k0_ = 64 * ((item) / nblk_), n0_ = 32 * ((item) % nblk_); \
    _Pragma("unroll") for (int i = 0; i < 32; ++i) scr[(2 * i + (lane >> 5)) * 33 + (lane & 31)] = wv[i]; \
    asm volatile("s_waitcnt lgkmcnt(0)" ::: "memory"); \
    const int c_ = lane & 7; \
    _Pragma("unroll") for (int j = 0; j < 4; ++j) { const int n_ = (lane >> 3) + 8 * j; const LAS float* s_ = scr + (8 * c_) * 33 + n_; \
        u32x4 o_; o_.x = pk_bf16(s_[0 * 33], s_[1 * 33]); o_.y = pk_bf16(s_[2 * 33], s_[3 * 33]); o_.z = pk_bf16(s_[4 * 33], s_[5 * 33]); o_.w = pk_bf16(s_[6 * 33], s_[7 * 33]); \
        const int nn_ = n0_ + n_; \
        const int dr_ = ((perm) == 1) ? rope_prow(nn_) : ((perm) == 2) ? ((nn_ < FF) ? ((nn_ >> 7) * 256 + (nn_ & 127)) : (((nn_ - FF) >> 7) * 256 + 128 + ((nn_ - FF) & 127))) : nn_; \
        *(u32x4*)((WT) + (size_t)dr_ * (ldt) + (koff) + k0_ + 8 * c_) = o_; } \
    asm volatile("s_waitcnt lgkmcnt(0)" ::: "memory"); } while (0)
__device__ __forceinline__ void convert_mixer(const Args& a, int l, LAS unsigned char* lds, int gw, int NGW, int wave, int lane) {
    LAS float* scr = (LAS float*)(lds + wave * 16384);
    bf16_t* win = (bf16_t*)(a.ws + WS_WIN); bf16_t* wcat = (bf16_t*)(a.ws + WS_WCAT); bf16_t* wo = (bf16_t*)(a.ws + WS_WO);
    const float* w_in = a.in[2] + (size_t)l * D * IN_COLS; const float* sbw = a.in[4] + (size_t)l * 512 * D;
    const float* rw = a.in[6] + (size_t)l * D * D; const float* w_o = a.in[7] + (size_t)l * D * D;
    constexpr int I0 = (D / 64) * (IN_COLS / 32), I1 = (512 / 64) * (D / 32), I2 = (D / 64) * (D / 32), I3 = I2, NI = I0 + I1 + I2 + I3;
#define RES_MIX(it_, W_, WT_, N_, ldt_, koff_, perm_, item_) do { int r_ = (it_); \
        if (r_ < I0) { W_ = w_in; WT_ = win; N_ = IN_COLS; ldt_ = D; koff_ = 0; perm_ = 1; item_ = r_; } \
        else if (r_ < I0 + I1) { W_ = sbw; WT_ = wcat; N_ = D; ldt_ = 1536; koff_ = 0; perm_ = 0; item_ = r_ - I0; } \
        else if (r_ < I0 + I1 + I2) { W_ = rw; WT_ = wcat; N_ = D; ldt_ = 1536; koff_ = 512; perm_ = 0; item_ = r_ - I0 - I1; } \
        else { W_ = w_o; WT_ = wo; N_ = D; ldt_ = D; koff_ = 0; perm_ = 0; item_ = r_ - I0 - I1 - I2; } } while (0)
    for (int it = gw; it < NI; it += 2 * NGW) {
        const bool two = it + NGW < NI;
        const float *Wa, *Wb; bf16_t *Ta, *Tb; int Na, Nb, la, lb, ka, kb, pa, pb, ia, ib;
        RES_MIX(it, Wa, Ta, Na, la, ka, pa, ia); RES_MIX(two ? it + NGW : it, Wb, Tb, Nb, lb, kb, pb, ib);
        float wa[32], wb[32];
        TI_LOAD(wa, Wa, Na, ia);
        if (two) TI_LOAD(wb, Wb, Nb, ib);
        TI_STORE(wa, Ta, Na, la, ka, pa, ia);
        if (two) TI_STORE(wb, Tb, Nb, lb, kb, pb, ib);
    }
#undef RES_MIX
}
__device__ __forceinline__ void convert_ffn(const Args& a, int l, LAS unsigned char* lds, int gw, int NGW, int wave, int lane) {
    LAS float* scr = (LAS float*)(lds + wave * 16384);
    bf16_t* wup = (bf16_t*)(a.ws + WS_WUP); bf16_t* wdn = (bf16_t*)(a.ws + WS_WDN);
    const float* w_up = a.in[9] + (size_t)l * D * U_LD; const float* w_dn = a.in[12] + (size_t)l * FF * D;
    constexpr int I0 = (D / 64) * (U_LD / 32), I1 = (FF / 64) * (D / 32), NI = I0 + I1;
#define RES_FFN(it_, W_, WT_, N_, ldt_, koff_, perm_, item_) do { int r_ = (it_); \
        if (r_ < I0) { W_ = w_up; WT_ = wup; N_ = U_LD; ldt_ = D; koff_ = 0; perm_ = 2; item_ = r_; } \
        else { W_ = w_dn; WT_ = wdn; N_ = D; ldt_ = FF; koff_ = 0; perm_ = 0; item_ = r_ - I0; } } while (0)
    for (int it = gw; it < NI; it += 2 * NGW) {
        const bool two = it + NGW < NI;
        const float *Wa, *Wb; bf16_t *Ta, *Tb; int Na, Nb, la, lb, ka, kb, pa, pb, ia, ib;
        RES_FFN(it, Wa, Ta, Na, la, ka, pa, ia); RES_FFN(two ? it + NGW : it, Wb, Tb, Nb, lb, kb, pb, ib);
        float wa[32], wb[32];
        TI_LOAD(wa, Wa, Na, ia);
        if (two) TI_LOAD(wb, Wb, Nb, ib);
        TI_STORE(wa, Ta, Na, la, ka, pa, ia);
        if (two) TI_STORE(wb, Tb, Nb, lb, kb, pb, ib);
    }
#undef RES_FFN
}
#undef TI_LOAD
#undef TI_STORE

__global__ void __launch_bounds__(512, 2) fwd_kernel(Args a) {
    extern __shared__ __attribute__((aligned(16))) unsigned char lds_raw[];
    LAS unsigned char* lds = (LAS unsigned char*)lds_raw;
    cg::grid_group grid = cg::this_grid();
    const int G = gridDim.x, bx = blockIdx.x;
    if (threadIdx.x < 8) ((LAS unsigned*)(lds + 131072))[threadIdx.x] = 0u;
    __syncthreads();
    const int vcu = (G % 8 == 0) ? (bx % 8) * (G / 8) + bx / 8 : bx;
    const int NGW = G * 8, NGT = G * 512;
#define PHASE_IDS() int tid_ = threadIdx.x; asm volatile("" : "+v"(tid_)); const int tid = tid_, lane = tid & 63, wave = __builtin_amdgcn_readfirstlane(tid >> 6); \
    const int gw = vcu * 8 + wave, gtid = bx * 512 + tid; (void)gw; (void)gtid; (void)lane;
#define ws ({ __attribute__((address_space(1))) unsigned char* p_ = (__attribute__((address_space(1))) unsigned char*)a.ws; asm volatile("" : "+s"(p_)); (unsigned char*)p_; })
#define w_ssq ((float*)(ws + WS_SSQ))
#define w_rope ((f32x4*)(ws + WS_ROPE))
#define w_win ((bf16_t*)(ws + WS_WIN))
#define w_wcat ((bf16_t*)(ws + WS_WCAT))
#define w_wo ((bf16_t*)(ws + WS_WO))
#define w_XN ((bf16_t*)(ws + WS_XN))
#define w_PA ((bf16_t*)(ws + WS_PROJ))
#define w_PB ((bf16_t*)(ws + WS_PB))
#define w_U ((bf16_t*)(ws + WS_PROJ))
#define w_wup ((bf16_t*)(ws + WS_WUP))
#define w_wdn ((bf16_t*)(ws + WS_WDN))
#define w_SIDE ((float*)(ws + WS_SIDE))
#define w_XS ((float*)(ws + WS_XS))
    const float* x = a.in[0]; float* out = a.out;
#ifdef DIAG
    unsigned long long* ts_ = (unsigned long long*)(ws + WS_XS + 65536);
#define STAMP(i) do { if (bx == 0 && threadIdx.x == 0) ts_[i] = __builtin_amdgcn_s_memrealtime(); } while (0)
#else
#define STAMP(i) do {} while (0)
#endif

    {
    PHASE_IDS();
    convert_mixer(a, 0, lds, gw, NGW, wave, lane);
    for (int i = gtid; i < 4096 * 64; i += NGT) {
        const int pos = i >> 6, k = i & 63;
        const float inv = __builtin_exp2f(-(float)k * (13.287712379549449f / 64.f));
        const double ang = (double)((float)pos * inv);
        double rev = ang * 0.15915494309189535; rev -= __builtin_rint(rev);
        f32x2 cs; cs.x = __builtin_amdgcn_cosf((float)rev); cs.y = __builtin_amdgcn_sinf((float)rev);
        ((f32x2*)w_rope)[i] = cs;
    }
    for (int i = gtid; i < 4 * M; i += NGT) w_ssq[M + i] = 0.f;
    for (int i = gtid; i < 2 * SD_LAYER; i += NGT) w_SIDE[i] = 0.f;
    for (int i = gtid; i < 4096; i += NGT) ((unsigned*)(ws + WS_BAR))[i] = 0u;
    for (int i = gtid; i < 8192; i += NGT) ((unsigned*)(ws + WS_CNT))[i] = 0u;
    {
        const float* g0 = a.in[1];
        const f32x4* gr = (const f32x4*)g0 + lane;
        for (int m = gw; m < M; m += 4 * NGW) {
            f32x4 v[4][4];
#pragma unroll
            for (int u = 0; u < 4; ++u) { const f32x4* xr = (const f32x4*)(x + (size_t)(m + u * NGW) * D) + lane;
#pragma unroll
                for (int j = 0; j < 4; ++j) v[u][j] = xr[64 * j]; }
            __builtin_amdgcn_sched_barrier(0);
#pragma unroll
            for (int u = 0; u < 4; ++u) {
                float s = 0.f;
#pragma unroll
                for (int j = 0; j < 4; ++j) s += (v[u][j][0] * v[u][j][0] + v[u][j][1] * v[u][j][1]) + (v[u][j][2] * v[u][j][2] + v[u][j][3] * v[u][j][3]);
                s = wave_sum(s);
                if (lane == 0) w_ssq[m + u * NGW] = s;
                u32x2* o8 = (u32x2*)(w_XN + (size_t)(m + u * NGW) * D) + lane;
#pragma unroll
                for (int j = 0; j < 4; ++j) { const f32x4 w = v[u][j] * gr[64 * j]; u32x2 o; o.x = pk_bf16(w[0], w[1]); o.y = pk_bf16(w[2], w[3]); o8[64 * j] = o; }
            }
        }
    }
    }
    grid.sync(); STAMP(0);
    const XcdBarrier xbar = xcd_barrier_post((unsigned*)(ws + WS_BAR), (volatile LAS unsigned*)(lds + 131072));

#pragma unroll 1
    for (int l = 0; l < 2; ++l) {
        const float* bgate = a.in[3] + (size_t)l * 2048;
        float* SP = w_SIDE + (size_t)l * SD_LAYER + SD_SP; float* YB = w_SIDE + (size_t)l * SD_LAYER + SD_YB; float* MO = w_SIDE + (size_t)l * SD_LAYER + SD_MO;
        float* UU = w_SIDE + (size_t)l * SD_LAYER + SD_UU; float* DD = w_SIDE + (size_t)l * SD_LAYER + SD_DD;
        {
            side::prep_norm(lds, (l == 0) ? x : w_XS, (l == 0) ? (size_t)SEQ * D : (size_t)D, nullptr, a.in[1] + (size_t)l * D, false, nullptr, nullptr, nullptr, nullptr);
            const float* w_in = a.in[2] + (size_t)l * D * IN_COLS;
            for (int it = bx; it < 320; it += G) side::gemv_item(lds, w_in, IN_COLS, (it & 3) * 256, 1536 + (it >> 2) * 64, SP, IN_COLS);
        }
        {
            pg8::Gemm g{w_XN, w_win, D, D, M, IN_COLS, D}; pg8::StaticOrder S; S.init(M, IN_COLS, G, bx);
            Epi<1> E; E.p = EpiP{}; E.p.ssq = w_ssq + (size_t)(2 * l) * M; E.p.PA = w_PA; E.p.PB = w_PB; E.p.rope = w_rope;
            pg8::gemm_phase(lds, g, S, E);
        }
        xcd_barrier(xbar); STAMP(l * 8 + 1);
        if (bx < 64) {
            {
                PHASE_IDS();
                const int r = wave, hh = lane >> 4, sub = lane & 15;
                const float* sp = SP + (size_t)r * IN_COLS;
                float dq = 0.f;
#pragma unroll
                for (int j = 0; j < 8; ++j) dq += sp[1536 + hh * 128 + sub * 8 + j] * sp[2048 + hh * 128 + sub * 8 + j];
#pragma unroll
                for (int o = 1; o < 16; o <<= 1) dq += shx(dq, o);
                const float w0 = dq * 0.08838834764831845f;
                float ov[16]; float s = 0.f;
#pragma unroll
                for (int j = 0; j < 16; ++j) { ov[j] = w0 * sp[2560 + hh * 256 + sub * 16 + j]; s += ov[j]; }
#pragma unroll
                for (int o = 1; o < 16; o <<= 1) s += shx(s, o);
                const float mu = s * (1.f / 256.f); float q = 0.f;
#pragma unroll
                for (int j = 0; j < 16; ++j) { ov[j] -= mu; q += ov[j] * ov[j]; }
#pragma unroll
                for (int o = 1; o < 16; o <<= 1) q += shx(q, o);
                const float rstd = 1.f / sqrtf(q * (1.f / 256.f) + EPS);
                const float* rn = a.in[5] + (size_t)l * D;
                LAS float* A = (LAS float*)lds;
#pragma unroll
                for (int j = 0; j < 16; ++j) { const int e = hh * 256 + sub * 16 + j; A[e * 8 + r] = ov[j] * rstd * rn[e] * side::silu_(sp[3584 + e]); }
                __syncthreads();
            }
            const float* rw = a.in[6] + (size_t)l * D * D;
            for (int it = bx; it < 64; it += G) side::gemv_item(lds, rw, D, (it & 3) * 256, (it >> 2) * 64, YB, D);
        }
        for (int j = vcu; j < 256; j += G) ret::item(j >> 5, (j >> 3) & 3, j & 7, w_PA, (LAS char*)lds);
        STAMP(20 + l);
        for (int j = vcu; j < 256; j += G) {
            const int bh = j >> 2, s = j & 3;
            sb::unit(bh >> 3, bh & 7, 15 - s, w_PA, (LAS char*)lds);
            sb::unit(bh >> 3, bh & 7, 8 + s, w_PA, (LAS char*)lds);
            sb::unit(bh >> 3, bh & 7, 7 - s, w_PA, (LAS char*)lds);
            sb::unit(bh >> 3, bh & 7, s, w_PA, (LAS char*)lds);
        }
        xcd_barrier(xbar); STAMP(l * 8 + 2);
        if (bx < 64) {
            {
                PHASE_IDS();
                LAS float* A = (LAS float*)lds;
#pragma unroll 8
                for (int i = tid; i < 8 * D; i += 512) { const int r = i >> 10, k = i & 1023; A[k * 8 + r] = side::sigm_(SP[(size_t)r * IN_COLS + 5632 + k] + bgate[1024 + k]) * YB[r * D + k]; }
                __syncthreads();
            }
            const float* w_o = a.in[7] + (size_t)l * D * D;
            for (int it = bx; it < 64; it += G) side::gemv_item(lds, w_o, D, (it & 3) * 256, (it >> 2) * 64, MO, D);
        }
        {
            PHASE_IDS();
            const float* rg = a.in[5] + (size_t)l * D;
            auto norm_row = [&](bf16_t* op, const u32x4 o0, const u32x4 o1, const u32x4 g0, const u32x4 g1) {
                float v[16], gv[16];
                v[0] = bf_lo(o0.x); v[1] = bf_hi(o0.x); v[2] = bf_lo(o0.y); v[3] = bf_hi(o0.y); v[4] = bf_lo(o0.z); v[5] = bf_hi(o0.z); v[6] = bf_lo(o0.w); v[7] = bf_hi(o0.w);
                v[8] = bf_lo(o1.x); v[9] = bf_hi(o1.x); v[10] = bf_lo(o1.y); v[11] = bf_hi(o1.y); v[12] = bf_lo(o1.z); v[13] = bf_hi(o1.z); v[14] = bf_lo(o1.w); v[15] = bf_hi(o1.w);
                gv[0] = bf_lo(g0.x); gv[1] = bf_hi(g0.x); gv[2] = bf_lo(g0.y); gv[3] = bf_hi(g0.y); gv[4] = bf_lo(g0.z); gv[5] = bf_hi(g0.z); gv[6] = bf_lo(g0.w); gv[7] = bf_hi(g0.w);
                gv[8] = bf_lo(g1.x); gv[9] = bf_hi(g1.x); gv[10] = bf_lo(g1.y); gv[11] = bf_hi(g1.y); gv[12] = bf_lo(g1.z); gv[13] = bf_hi(g1.z); gv[14] = bf_lo(g1.w); gv[15] = bf_hi(g1.w);
                float s = 0.f;
#pragma unroll
                for (int k = 0; k < 16; ++k) s += v[k];
#pragma unroll
                for (int o = 1; o < 16; o <<= 1) s += shx(s, o);
                const float mu = s * (1.f / 256.f); float q = 0.f;
#pragma unroll
                for (int k = 0; k < 16; ++k) { v[k] -= mu; q += v[k] * v[k]; }
#pragma unroll
                for (int o = 1; o < 16; o <<= 1) q += shx(q, o);
                const float rstd = __builtin_amdgcn_rsqf(q * (1.f / 256.f) + EPS);
                const f32x4* rgp = (const f32x4*)(rg + 16 * lane);
                unsigned w[8];
#pragma unroll
                for (int k4 = 0; k4 < 4; ++k4) { const f32x4 gg = rgp[k4];
                    float y[4];
#pragma unroll
                    for (int k = 0; k < 4; ++k) { const float gx = gv[4 * k4 + k]; y[k] = v[4 * k4 + k] * rstd * gg[k] * gx * sigmoidf_(gx); }
                    w[2 * k4] = pk_bf16(y[0], y[1]); w[2 * k4 + 1] = pk_bf16(y[2], y[3]); }
                *(u32x4*)op = (u32x4){w[0], w[1], w[2], w[3]}; *(u32x4*)(op + 8) = (u32x4){w[4], w[5], w[6], w[7]};
            };
            for (int m = gw; m < M; m += 4 * NGW) {
                u32x4 o0[4], o1[4], g0[4], g1[4];
#pragma unroll
                for (int u = 0; u < 4; ++u) { const int mm = m + u * NGW; const bf16_t* op = w_PA + (size_t)mm * PA_LD + 2560 + 16 * lane; const bf16_t* gp = w_PB + (size_t)mm * PB_LD + 16 * lane;
                    o0[u] = *(const u32x4*)op; o1[u] = *(const u32x4*)(op + 8); g0[u] = *(const u32x4*)gp; g1[u] = *(const u32x4*)(gp + 8); }
                __builtin_amdgcn_sched_barrier(0);
#pragma unroll
                for (int u = 0; u < 4; ++u) norm_row(w_PA + (size_t)(m + u * NGW) * PA_LD + 2560 + 16 * lane, o0[u], o1[u], g0[u], g1[u]);
            }
            __syncthreads();
            pg8::Gemm g{w_PA, w_wcat, PA_LD, 1536, M, D, 512}; pg8::StaticOrder S; S.init(M, D, G, bx);
            Epi<2> E; E.p = EpiP{}; E.p.PA = w_PA; E.p.PB = w_PB; E.p.bgate = bgate;
            pg8::gemm_phase(lds, g, S, E);
        }
        xcd_barrier(xbar); STAMP(l * 8 + 3);
        {
            pg8::Gemm g{w_PA + 2560, w_wcat + 512, PA_LD, 1536, M, D, D}; pg8::StaticOrder S; S.init(M, D, G, bx);
            Epi<3> E; E.p = EpiP{}; E.p.PA = w_PA; E.p.PB = w_PB; E.p.bgate = bgate;
            pg8::gemm_phase(lds, g, S, E);
        }
        xcd_barrier(xbar); STAMP(l * 8 + 4);
        {
            side::prep_norm(lds, (l == 0) ? x : w_XS, (l == 0) ? (size_t)SEQ * D : (size_t)D, MO, a.in[8] + (size_t)l * D, bx == 0, out, w_XN, w_ssq + (size_t)(2 * l + 1) * M, nullptr);
            const float* w_up = a.in[9] + (size_t)l * D * U_LD;
            for (int it = bx; it < 352; it += G) side::gemv_item(lds, w_up, U_LD, (it & 3) * 256, (it >> 2) * 64, UU, U_LD);
        }
        {
            PHASE_IDS();
            convert_ffn(a, l, lds, gw, NGW, wave, lane);
            __syncthreads();
            pg8::Gemm g{w_PA + 1536, w_wo, PA_LD, D, M, D, D}; pg8::StaticOrder S; S.init(M, D, G, bx);
            Epi<4> E; E.p = EpiP{}; E.p.xin = (l == 0) ? x : out; E.p.xout = out; E.p.XN = w_XN; E.p.gnext = a.in[8] + (size_t)l * D; E.p.ssq_out = w_ssq + (size_t)(2 * l + 1) * M; E.p.wxn = 1;
            pg8::gemm_phase(lds, g, S, E);
        }
        xcd_barrier(xbar); STAMP(l * 8 + 5);
        const int b5 = (G > 176) ? bx - 176 : bx, nb5 = (G > 176) ? G - 176 : G;
        if (b5 >= 0) {
            {
                PHASE_IDS();
                const float* cw2 = a.in[10] + (size_t)l * 3 * FF + 2 * FF; const float* cbb = a.in[11] + (size_t)l * FF;
                LAS float* A = (LAS float*)lds;
#pragma unroll 11
                for (int i = tid; i < 8 * FF; i += 512) { const int r = i / FF, k = i - r * FF; A[k * 8 + r] = side::silu_(cw2[k] * UU[r * U_LD + k] + cbb[k]) * UU[r * U_LD + FF + k]; }
                __syncthreads();
            }
            const float* w_dn = a.in[12] + (size_t)l * FF * D;
            for (int it = b5; it < 176; it += nb5) side::gemv_item(lds, w_dn, D, (it / 16) * 256, (it & 15) * 64, DD, D);
        }
        {
            PHASE_IDS();
            if (l == 0) { convert_mixer(a, 1, lds, gw, NGW, wave, lane); __syncthreads(); }
            pg8::Gemm g{w_XN, w_wup, D, D, M, U_LD, D}; pg8::StaticOrder S; S.init(M, U_LD, G, bx, true);
            Epi<6> E; E.p = EpiP{}; E.p.ssq = w_ssq + (size_t)(2 * l + 1) * M; E.p.H = w_U; E.p.cw = a.in[10] + (size_t)l * 3 * FF; E.p.cb = a.in[11] + (size_t)l * FF;
            E.p.xch = (LAS float*)(lds + 131072 + 1024);
            pg8::gemm_phase(lds, g, S, E);
        }
        xcd_barrier(xbar); STAMP(l * 8 + 6); STAMP(l * 8 + 7);
        if (bx == 0)
            side::prep_norm(lds, out, (size_t)SEQ * D, DD, (l == 0) ? a.in[1] + D : a.in[13], true, out, w_XN, w_ssq + (size_t)(2 * l + 2) * M, w_XS, l == 1);
        if (l == 0) {
            pg8::Gemm g{w_U, w_wdn, FF, FF, M, D, FF}; pg8::StaticOrder S; S.init(M, D, G, bx);
            Epi<4> E; E.p = EpiP{}; E.p.xin = out; E.p.xout = out; E.p.XN = w_XN; E.p.gnext = a.in[1] + D; E.p.ssq_out = w_ssq + (size_t)2 * M; E.p.wxn = 1;
            pg8::gemm_phase(lds, g, S, E);
            xcd_barrier(xbar); STAMP(8);
        } else {
            pg8::Gemm g{w_U, w_wdn, FF, FF, M, D, FF}; pg8::StaticOrder S; S.init(M, D, G, bx);
            Epi<7> E; E.p = EpiP{}; E.p.xin = out; E.p.xout = out; E.p.gnext = a.in[13]; E.p.ssq_out = w_ssq + (size_t)4 * M; E.p.cnt = (unsigned*)(ws + WS_CNT);
            pg8::gemm_phase(lds, g, S, E);
            STAMP(16);
        }
    }
#ifdef DIAG
    xcd_barrier(xbar);
#endif
    STAMP(31);
#ifdef DIAG
    __syncthreads();
    if (bx == 0 && threadIdx.x == 0) {
        asm volatile("s_waitcnt vmcnt(0)" ::: "memory");
        const float tA = (float)(ts_[DIAG_A1] - ts_[DIAG_A0]) * 0.01f, tB = (float)(ts_[DIAG_B1] - ts_[DIAG_B0]) * 0.01f;
        out[3 * 1024 + 7] += tA * 1e-3f;
        for (int i = 0; i < 2048; ++i) out[1024 + i] += tB * 1e-4f;
    }
#endif
}

#undef ws
#undef w_ssq
#undef w_rope
#undef w_win
#undef w_wcat
#undef w_wo
#undef w_XN
#undef w_PA
#undef w_PB
#undef w_U
#undef w_wup
#undef w_wdn
#undef w_SIDE
#undef w_XS
constexpr int LDS_BYTES = 131072 + 1024 + 4096;
static_assert(ret::LDS_BYTES <= 131072 && sb::LDS_BYTES <= 131072 && pg8::STAGE_BYTES <= 131072, "LDS map");

extern "C" void kernel_launch(void* const* d_in, const int* in_sizes, int n_in, void* d_out, int out_size, void* d_ws, size_t ws_size, hipStream_t stream) {
    static int grid = 0;
    if (grid == 0) {
        int dev = 0, cus = 0, per_cu = 0;
        hipGetDevice(&dev);
        hipDeviceGetAttribute(&cus, hipDeviceAttributeMultiprocessorCount, dev);
        hipFuncSetAttribute((const void*)fwd_kernel, hipFuncAttributeMaxDynamicSharedMemorySize, LDS_BYTES);
        hipOccupancyMaxActiveBlocksPerMultiprocessor(&per_cu, (const void*)fwd_kernel, 512, LDS_BYTES);
        (void)hipGetLastError();
        if (per_cu < 1) per_cu = 1;
        if (cus < 1) cus = 256;
        grid = cus;
        if (ws_size < WS_END) fprintf(stderr, "kernel_launch: workspace too small: %zu < %zu\n", ws_size, (size_t)WS_END);
    }
    Args a{};
    for (int i = 0; i < 14; ++i) a.in[i] = (const float*)d_in[i];
    a.out = (float*)d_out; a.ws = (unsigned char*)d_ws;
    void* args[] = {&a};
    hipError_t e = hipLaunchCooperativeKernel((const void*)fwd_kernel, dim3(grid), dim3(512), args, LDS_BYTES, stream);
    if (e != hipSuccess) fprintf(stderr, "cooperative launch failed: %s (grid %d)\n", hipGetErrorString(e), grid);
}
```

```cpp
#include <hip/hip_runtime.h>
#include <hip/hip_cooperative_groups.h>
#include <cstdio>
#include <cstdint>
namespace cg = cooperative_groups;

#define LAS __attribute__((address_space(3)))
typedef unsigned short bf16_t;
typedef short bf16x8 __attribute__((ext_vector_type(8)));
typedef short s16x4 __attribute__((ext_vector_type(4)));
typedef float f32x2 __attribute__((ext_vector_type(2)));
typedef float f32x4 __attribute__((ext_vector_type(4)));
typedef float f32x16 __attribute__((ext_vector_type(16)));
typedef unsigned u32x4 __attribute__((ext_vector_type(4)));
typedef unsigned u32x2 __attribute__((ext_vector_type(2)));

constexpr int M = 32768, D = 1024, SEQ = 4096, FF = 2816;
constexpr int IN_COLS = 6656, PA_LD = 3584, PB_LD = 3072, U_LD = 5632;
constexpr float EPS = 1e-6f;
constexpr float LOG2E = 1.4426950408889634f;

constexpr size_t MiB = 1u << 20;
constexpr size_t WS_SSQ = 0;
constexpr size_t WS_ROPE = 1 * MiB;
constexpr size_t WS_WIN = 3 * MiB;
constexpr size_t WS_WCAT = 16 * MiB;
constexpr size_t WS_WO = 19 * MiB;
constexpr size_t WS_XN = 21 * MiB;
constexpr size_t WS_PROJ = 85 * MiB;
constexpr size_t WS_PB = WS_PROJ + 224 * MiB;
constexpr size_t WS_WUP = WS_PROJ + 352 * MiB;
constexpr size_t WS_WDN = WS_WUP + 11 * MiB;
constexpr size_t WS_END0 = WS_PROJ + 416 * MiB;
constexpr size_t WS_SIDE = WS_END0;
constexpr int SD_SP = 0, SD_YB = 8 * 6656, SD_MO = SD_YB + 8 * 1024, SD_UU = SD_MO + 8 * 1024, SD_DD = SD_UU + 8 * 5632, SD_LAYER = SD_DD + 8 * 1024;
constexpr size_t WS_XS = WS_SIDE + (size_t)2 * SD_LAYER * 4;
constexpr size_t WS_BAR = WS_XS + 262144;
constexpr size_t WS_CNT = WS_BAR + 16384;
constexpr size_t WS_END = WS_CNT + 32768;

__device__ __forceinline__ unsigned pk_bf16(float lo, float hi) {
    typedef __bf16 b2 __attribute__((ext_vector_type(2))); f32x2 v = {lo, hi}; b2 b = __builtin_convertvector(v, b2); return __builtin_bit_cast(unsigned, b);
}
__device__ __forceinline__ float bf_lo(unsigned w) { return __uint_as_float(w << 16); }
__device__ __forceinline__ float bf_hi(unsigned w) { return __uint_as_float(w & 0xffff0000u); }
__device__ __forceinline__ float sigmoidf_(float x) { return __builtin_amdgcn_rcpf(1.f + __builtin_amdgcn_exp2f(-x * LOG2E)); }
__device__ __forceinline__ float shx(float v, int o) {
    int l = (int)__builtin_amdgcn_mbcnt_hi(~0u, __builtin_amdgcn_mbcnt_lo(~0u, 0u)); asm volatile("" : "+v"(l));
    return __int_as_float(__builtin_amdgcn_ds_bpermute((l ^ o) << 2, __float_as_int(v)));
}
__device__ __forceinline__ float wave_sum(float v) {
#pragma unroll
    for (int o = 1; o < 64; o <<= 1) v += shx(v, o);
    return v;
}

namespace pg8 {
constexpr int BM = 256, BK = 64, HALF = 128, HTB = HALF * BK * 2, STAGE_BYTES = 8 * HTB, NXCD = 8, WGM = 8;
__host__ __device__ __forceinline__ int lds_byte(int r, int c) { const int st = (r >> 4) * 2 + (c >> 5), rr = r & 15, cc = c & 31, ob = rr * 64 + cc * 2; return st * 1024 + (ob ^ (((ob >> 9) & 1) << 5)); }
__host__ __device__ __forceinline__ void stage_rc(int b, int& R, int& C) { const int st = b / 1024, sb = b % 1024, swz = sb ^ (((sb >> 9) & 1) << 5); R = (st >> 1) * 16 + swz / 64; C = (st & 1) * 32 + (swz % 64) / 2; }
__host__ __device__ __forceinline__ int perm32(int rho) { const int n = rho >> 4, i = rho & 15; return 8 * (i >> 2) + 4 * n + (i & 3); }

struct Unit { int pm, pn, arow; };
struct Gemm { const bf16_t* A; const bf16_t* Bt; int lda, ldb, M, N, K; };

struct StaticOrder {
    int nM, nN, nwg, G, c; bool ovl;
    __device__ void init(int M_, int N_, int G_, int c_, bool ovl_ = false) { ovl = ovl_; nM = ovl ? (M_ / 4096) * 17 : M_ / BM; nN = N_ / BM; nwg = nM * nN; G = G_; c = c_; }
    __device__ bool next(int i, Unit& u) const {
        const long L = (long)i * G + c; if (L >= nwg) return false;
        int wgid = (int)L; { const int q = nwg / NXCD, r = nwg % NXCD, xcd = wgid % NXCD, off = wgid / NXCD; wgid = (xcd < r ? xcd * (q + 1) : r * (q + 1) + (xcd - r) * q) + off; }
        const int nig = WGM * nN, gid = wgid / nig, fm = gid * WGM, gsz = (nM - fm) < WGM ? (nM - fm) : WGM;
        u.pm = fm + ((wgid % nig) % gsz); u.pn = (wgid % nig) / gsz;
        u.arow = ovl ? (u.pm / 17) * 4096 + 254 * (u.pm % 17) - 2 : u.pm * BM; return true;
    }
};

template <class Epi>
__device__ __forceinline__ void gemm_phase(LAS unsigned char* lds, const Gemm g, const StaticOrder& S, const Epi& E) {
    int tid_ = threadIdx.x; asm volatile("" : "+v"(tid_));
    const int tid = tid_, wid = __builtin_amdgcn_readfirstlane(tid >> 6), lane = tid & 63, wr = wid >> 2, wc = wid & 3, fr = lane & 15, fq = lane >> 4;
    const int K = g.K, nt = K / BK;
    unsigned voffA[2], voffB[2];
#pragma unroll
    for (int i = 0; i < 2; ++i) { int R, C; stage_rc(tid * 16 + i * 8192, R, C); const int Rb = (R & ~31) + perm32(R & 31);
        voffA[i] = (unsigned)(R * g.lda + C) * 2u; voffB[i] = (unsigned)(Rb * g.ldb + C) * 2u; }
    const size_t kstep = (size_t)(BK * 2);
    const size_t hstepA = (size_t)HALF * g.lda * 2, hstepB = (size_t)HALF * g.ldb * 2;
    const size_t tstepB = 2 * hstepB;
    const unsigned ldsw = (unsigned)wid * 1024u;
    const int aoff = lds_byte(wr * 64 + fr, fq * 8), boff = lds_byte(wc * 32 + fr, fq * 8);
#define PG8_SA(b, h) (((b) * 2 + (h)) * HTB)
#define PG8_SB(b, h) ((4 + (b) * 2 + (h)) * HTB)
#define PG8_STAGE(bufoff, gbase, voff) do { _Pragma("unroll") for (int _i = 0; _i < 2; ++_i) \
        __builtin_amdgcn_global_load_lds((const unsigned*)((const char*)(gbase) + (voff)[_i]), (LAS unsigned*)(lds + (bufoff) + ldsw + _i * 8192), 16, 0, 0); } while (0)
#define PG8_LDA(dst, b, h) do { _Pragma("unroll") for (int m = 0; m < 4; ++m) _Pragma("unroll") for (int k = 0; k < 2; ++k) dst[m][k] = *(const LAS bf16x8*)(lds + PG8_SA(b, h) + aoff + m * 2048 + k * 1024); } while (0)
#define PG8_LDB(dst, b, h) do { _Pragma("unroll") for (int n = 0; n < 2; ++n) _Pragma("unroll") for (int k = 0; k < 2; ++k) dst[n][k] = *(const LAS bf16x8*)(lds + PG8_SB(b, h) + boff + n * 2048 + k * 1024); } while (0)
#define PG8_MMA(ai, bj, At, Bt) do { __builtin_amdgcn_s_setprio(1); _Pragma("unroll") for (int m = 0; m < 4; ++m) _Pragma("unroll") for (int n = 0; n < 2; ++n) _Pragma("unroll") for (int k = 0; k < 2; ++k) \
        acc[ai][bj][m][n] = __builtin_amdgcn_mfma_f32_16x16x32_bf16(Bt[n][k], At[m][k], acc[ai][bj][m][n], 0, 0, 0); __builtin_amdgcn_s_setprio(0); } while (0)
#define PG8_WAIT_V(n) asm volatile("s_waitcnt vmcnt(" #n ")" ::: "memory")
#define PG8_WAIT_L(n) asm volatile("s_waitcnt lgkmcnt(" #n ")" ::: "memory")
#define PG8_BAR __builtin_amdgcn_s_barrier()
#define PG8_SCHED __builtin_amdgcn_sched_barrier(0)
    Unit cur, nxt; int ui = 0;
    if (!S.next(0, cur)) return;
    f32x4 acc[2][2][4][2];
#pragma unroll
    for (int a = 0; a < 2; ++a)
#pragma unroll
        for (int b = 0; b < 2; ++b)
#pragma unroll
            for (int m = 0; m < 4; ++m)
#pragma unroll
                for (int n = 0; n < 2; ++n) acc[a][b][m][n] = (f32x4){0.f, 0.f, 0.f, 0.f};
    bf16x8 At[4][2], B0[2][2], B1[2][2];
    const char* cA = (const char*)g.A + (ptrdiff_t)cur.arow * (ptrdiff_t)(g.lda * 2); const char* cB = (const char*)g.Bt + (size_t)cur.pn * tstepB;
    PG8_STAGE(PG8_SB(0, 0), cB, voffB); PG8_STAGE(PG8_SB(0, 1), cB + hstepB, voffB); PG8_STAGE(PG8_SA(0, 0), cA, voffA); PG8_STAGE(PG8_SA(0, 1), cA + hstepA, voffA);
    if (wr == 1) PG8_BAR;
    PG8_WAIT_V(2); PG8_BAR;
    PG8_STAGE(PG8_SB(1, 0), cB + kstep, voffB); PG8_STAGE(PG8_SA(1, 0), cA + kstep, voffA); PG8_STAGE(PG8_SB(1, 1), cB + hstepB + kstep, voffB);
    PG8_WAIT_V(6); PG8_BAR;
    for (;;) {
        const bool has_next = S.next(ui + 1, nxt);
        const char* nA = has_next ? (const char*)g.A + (ptrdiff_t)nxt.arow * (ptrdiff_t)(g.lda * 2) : cA; const char* nB = has_next ? (const char*)g.Bt + (size_t)nxt.pn * tstepB : cB;
        for (int t = 0; t < nt; t += 2) {
            const bool last = (t == nt - 2);
            const char* a1 = cA + (size_t)(t + 1) * kstep;
            const char* a2 = last ? nA : cA + (size_t)(t + 2) * kstep; const char* b2 = last ? nB : cB + (size_t)(t + 2) * kstep;
            const char* a3 = a2 + kstep; const char* b3 = b2 + kstep;
            PG8_LDB(B0, 0, 0); PG8_LDB(B1, 0, 1); PG8_SCHED; PG8_LDA(At, 0, 0); PG8_STAGE(PG8_SA(1, 1), a1 + hstepA, voffA);
            PG8_WAIT_V(8); PG8_WAIT_L(0); PG8_BAR; PG8_MMA(0, 0, At, B0); PG8_MMA(0, 1, At, B1); PG8_BAR; PG8_SCHED;
            PG8_LDA(At, 0, 1); PG8_STAGE(PG8_SB(0, 0), b2, voffB); PG8_STAGE(PG8_SB(0, 1), b2 + hstepB, voffB); PG8_STAGE(PG8_SA(0, 0), a2, voffA);
            PG8_WAIT_V(8); PG8_WAIT_L(0); PG8_BAR; PG8_MMA(1, 0, At, B0); PG8_MMA(1, 1, At, B1); PG8_BAR; PG8_SCHED;
            PG8_LDB(B0, 1, 0); PG8_LDB(B1, 1, 1); PG8_SCHED; PG8_LDA(At, 1, 0); PG8_STAGE(PG8_SA(0, 1), a2 + hstepA, voffA);
            PG8_WAIT_V(8); PG8_WAIT_L(0); PG8_BAR; PG8_MMA(0, 0, At, B0); PG8_MMA(0, 1, At, B1); PG8_BAR; PG8_SCHED;
            PG8_LDA(At, 1, 1); PG8_STAGE(PG8_SB(1, 0), b3, voffB); PG8_STAGE(PG8_SB(1, 1), b3 + hstepB, voffB); PG8_STAGE(PG8_SA(1, 0), a3, voffA);
            PG8_WAIT_V(8); PG8_WAIT_L(0); PG8_BAR; PG8_MMA(1, 0, At, B0); PG8_MMA(1, 1, At, B1); PG8_BAR; PG8_SCHED;
        }
        if (wr == 0) PG8_BAR;
        E(acc, cur, wr, wc, fr, fq);
        if (!has_next) break;
#pragma unroll
        for (int a = 0; a < 2; ++a)
#pragma unroll
            for (int b = 0; b < 2; ++b)
#pragma unroll
                for (int m = 0; m < 4; ++m)
#pragma unroll
                    for (int n = 0; n < 2; ++n) acc[a][b][m][n] = (f32x4){0.f, 0.f, 0.f, 0.f};
        cur = nxt; cA = nA; cB = nB; ++ui;
        if (wr == 1) PG8_BAR;
    }
    PG8_WAIT_V(0);
    PG8_BAR;
#undef PG8_SA
#undef PG8_SB
#undef PG8_STAGE
#undef PG8_LDA
#undef PG8_LDB
#undef PG8_MMA
#undef PG8_WAIT_V
#undef PG8_WAIT_L
#undef PG8_BAR
#undef PG8_SCHED
}
}

struct EpiP {
    const float* ssq;
    bf16_t* PA; bf16_t* PB;
    const f32x4* rope;
    const float* bgate;
    const float* xin; float* xout; bf16_t* XN; const float* gnext; float* ssq_out; int wxn;
    bf16_t* U;
    unsigned* cnt;
    bf16_t* H; const float* cw; const float* cb; LAS float* xch;
};
template <int MODE> struct Epi {
    EpiP p;
    __device__ __forceinline__ void operator()(const f32x4 (&acc)[2][2][4][2], const pg8::Unit& u, int wr, int wc, int fr, int fq) const {
        asm volatile("" : "+v"(fr), "+v"(fq));
        const int pn = u.pn;
        const int rowb = u.pm * 256 + wr * 64 + fr;
        const int colw = wc * 32 + 8 * fq;
        if constexpr (MODE == 1) {
            bf16_t* O; int ldc, cb;
            if (pn < 14) { O = p.PA; ldc = PA_LD; cb = pn * 256; } else { O = p.PB; ldc = PB_LD; cb = (pn - 14) * 256; }
            const int kind = (pn < 2) ? 1 : (pn >= 6 && pn < 8) ? 2 : (pn >= 8 && pn < 10) ? 3 : 0;
            float ssv[2][4]; f32x4 rc[2][4][2];
#pragma unroll
            for (int ai = 0; ai < 2; ++ai)
#pragma unroll
                for (int m = 0; m < 4; ++m) { const int row = rowb + ai * 128 + m * 16; ssv[ai][m] = p.ssq[row];
                    if (kind >= 2) { const f32x4* rp = p.rope + ((size_t)(row & 4095) * 64 + wc * 16 + 4 * fq) / 2; rc[ai][m][0] = rp[0]; rc[ai][m][1] = rp[1]; } }
            __builtin_amdgcn_sched_barrier(0);
#pragma unroll
            for (int ai = 0; ai < 2; ++ai)
#pragma unroll
                for (int m = 0; m < 4; ++m) {
                    const int row = rowb + ai * 128 + m * 16;
                    float sc = __builtin_amdgcn_rsqf(ssv[ai][m] * (1.f / 1024.f) + EPS);
                    if (kind == 1) sc *= 0.125f * LOG2E;
#pragma unroll
                    for (int bj = 0; bj < 2; ++bj) {
                        f32x4 v0 = acc[ai][bj][m][0] * sc, v1 = acc[ai][bj][m][1] * sc;
                        if (kind >= 2) {
                            const int head = (pn - (kind == 2 ? 6 : 8)) * 2 + bj;
                            const float lg = __builtin_log2f(1.f - __builtin_exp2f(-5.f - (float)head));
                            const float e = (float)((row & 127) + 1) * lg;
                            const float dsc = (kind == 2) ? __builtin_amdgcn_exp2f(e) * 0.08838834764831845f : __builtin_amdgcn_exp2f(-e);
                            const f32x4 c01 = rc[ai][m][0], c23 = rc[ai][m][1];
                            f32x4 w0, w1;
                            w0[0] = (v0[0] * c01[0] - v0[1] * c01[1]) * dsc; w0[1] = (v0[0] * c01[1] + v0[1] * c01[0]) * dsc;
                            w0[2] = (v0[2] * c01[2] - v0[3] * c01[3]) * dsc; w0[3] = (v0[2] * c01[3] + v0[3] * c01[2]) * dsc;
                            w1[0] = (v1[0] * c23[0] - v1[1] * c23[1]) * dsc; w1[1] = (v1[0] * c23[1] + v1[1] * c23[0]) * dsc;
                            w1[2] = (v1[2] * c23[2] - v1[3] * c23[3]) * dsc; w1[3] = (v1[2] * c23[3] + v1[3] * c23[2]) * dsc;
                            v0 = w0; v1 = w1;
                        }
                        u32x4 w; w.x = pk_bf16(v0[0], v0[1]); w.y = pk_bf16(v0[2], v0[3]); w.z = pk_bf16(v1[0], v1[1]); w.w = pk_bf16(v1[2], v1[3]);
                        *(u32x4*)(O + (size_t)row * ldc + cb + bj * 128 + colw) = w;
                    }
                }
        } else if constexpr (MODE == 2 || MODE == 3) {
            const int goff = (MODE == 2) ? 1024 : 2048, boff = (MODE == 2) ? 0 : 1024;
            f32x4 bb[2][2];
#pragma unroll
            for (int bj = 0; bj < 2; ++bj) { const int col = pn * 256 + bj * 128 + colw; bb[bj][0] = *(const f32x4*)(p.bgate + boff + col); bb[bj][1] = *(const f32x4*)(p.bgate + boff + col + 4); }
#pragma unroll
            for (int aih = 0; aih < 4; ++aih) {
              const int ai = aih >> 1, mb = (aih & 1) * 2;
              u32x4 gwv[4][2], twv[4][2];
#pragma unroll
              for (int m = mb; m < mb + 2; ++m)
#pragma unroll
                for (int bj = 0; bj < 2; ++bj) { const int row = rowb + ai * 128 + m * 16, col = pn * 256 + bj * 128 + colw;
                    gwv[m][bj] = *(const u32x4*)(p.PB + (size_t)row * PB_LD + goff + col);
                    if constexpr (MODE == 3) twv[m][bj] = *(const u32x4*)(p.PA + (size_t)row * PA_LD + 512 + col); }
              __builtin_amdgcn_sched_barrier(0);
#pragma unroll
                for (int m = mb; m < mb + 2; ++m) {
                    const int row = rowb + ai * 128 + m * 16;
#pragma unroll
                    for (int bj = 0; bj < 2; ++bj) {
                        const int col = pn * 256 + bj * 128 + colw;
                        const u32x4 gw = gwv[m][bj];
                        f32x4 g0, g1;
                        g0[0] = bf_lo(gw.x); g0[1] = bf_hi(gw.x); g0[2] = bf_lo(gw.y); g0[3] = bf_hi(gw.y);
                        g1[0] = bf_lo(gw.z); g1[1] = bf_hi(gw.z); g1[2] = bf_lo(gw.w); g1[3] = bf_hi(gw.w);
                        g0 += bb[bj][0]; g1 += bb[bj][1];
                        f32x4 v0 = acc[ai][bj][m][0], v1 = acc[ai][bj][m][1];
#pragma unroll
                        for (int k = 0; k < 4; ++k) { v0[k] *= sigmoidf_(g0[k]); v1[k] *= sigmoidf_(g1[k]); }
                        if constexpr (MODE == 3) {
                            const u32x4 tw = twv[m][bj];
                            v0[0] += bf_lo(tw.x); v0[1] += bf_hi(tw.x); v0[2] += bf_lo(tw.y); v0[3] += bf_hi(tw.y);
                            v1[0] += bf_lo(tw.z); v1[1] += bf_hi(tw.z); v1[2] += bf_lo(tw.w); v1[3] += bf_hi(tw.w);
                        }
                        u32x4 w; w.x = pk_bf16(v0[0], v0[1]); w.y = pk_bf16(v0[2], v0[3]); w.z = pk_bf16(v1[0], v1[1]); w.w = pk_bf16(v1[2], v1[3]);
                        *(u32x4*)(p.PA + (size_t)row * PA_LD + (MODE == 2 ? 512 : 1536) + col) = w;
                    }
                }
            }
        } else if constexpr (MODE == 4) {
            f32x4 gg[2][2];
#pragma unroll
            for (int bj = 0; bj < 2; ++bj) { const int col = pn * 256 + bj * 128 + colw; gg[bj][0] = *(const f32x4*)(p.gnext + col); gg[bj][1] = *(const f32x4*)(p.gnext + col + 4); }
#pragma unroll
            for (int ai = 0; ai < 2; ++ai) {
              f32x4 xv[4][2][2];
#pragma unroll
              for (int m = 0; m < 4; ++m)
#pragma unroll
                for (int bj = 0; bj < 2; ++bj) { const size_t off = (size_t)(rowb + ai * 128 + m * 16) * D + pn * 256 + bj * 128 + colw;
                    xv[m][bj][0] = *(const f32x4*)(p.xin + off); xv[m][bj][1] = *(const f32x4*)(p.xin + off + 4); }
              __builtin_amdgcn_sched_barrier(0);
#pragma unroll
                for (int m = 0; m < 4; ++m) {
                    const int row = rowb + ai * 128 + m * 16;
                    const bool keep = (row & 4095) != 0;
                    float ss = 0.f;
#pragma unroll
                    for (int bj = 0; bj < 2; ++bj) {
                        const int col = pn * 256 + bj * 128 + colw;
                        const size_t off = (size_t)row * D + col;
                        f32x4 x0 = xv[m][bj][0], x1 = xv[m][bj][1];
                        x0 += acc[ai][bj][m][0]; x1 += acc[ai][bj][m][1];
                        if (keep) { *(f32x4*)(p.xout + off) = x0; *(f32x4*)(p.xout + off + 4) = x1; }
                        ss += (x0[0] * x0[0] + x0[1] * x0[1]) + (x0[2] * x0[2] + x0[3] * x0[3]) + (x1[0] * x1[0] + x1[1] * x1[1]) + (x1[2] * x1[2] + x1[3] * x1[3]);
                        x0 *= gg[bj][0]; x1 *= gg[bj][1];
                        u32x4 w; w.x = pk_bf16(x0[0], x0[1]); w.y = pk_bf16(x0[2], x0[3]); w.z = pk_bf16(x1[0], x1[1]); w.w = pk_bf16(x1[2], x1[3]);
                        if (keep && p.wxn) *(u32x4*)(p.XN + off) = w;
                    }
                    ss += shx(ss, 16); ss += shx(ss, 32);
                    if (fq == 0 && keep) unsafeAtomicAdd(p.ssq_out + row, ss);
                }
            }
        } else if constexpr (MODE == 7) {
            f32x4 xn[2][4][2][2];
#pragma unroll
            for (int ai = 0; ai < 2; ++ai) {
#pragma unroll
              for (int m = 0; m < 4; ++m)
#pragma unroll
                for (int bj = 0; bj < 2; ++bj) { const size_t off = (size_t)(rowb + ai * 128 + m * 16) * D + pn * 256 + bj * 128 + colw;
                    xn[ai][m][bj][0] = *(const f32x4*)(p.xin + off); xn[ai][m][bj][1] = *(const f32x4*)(p.xin + off + 4); }
              __builtin_amdgcn_sched_barrier(0);
#pragma unroll
                for (int m = 0; m < 4; ++m) {
                    const int row = rowb + ai * 128 + m * 16;
                    float ss = 0.f;
#pragma unroll
                    for (int bj = 0; bj < 2; ++bj) {
                        f32x4 x0 = xn[ai][m][bj][0] + acc[ai][bj][m][0], x1 = xn[ai][m][bj][1] + acc[ai][bj][m][1];
                        xn[ai][m][bj][0] = x0; xn[ai][m][bj][1] = x1;
                        ss += (x0[0] * x0[0] + x0[1] * x0[1]) + (x0[2] * x0[2] + x0[3] * x0[3]) + (x1[0] * x1[0] + x1[1] * x1[1]) + (x1[2] * x1[2] + x1[3] * x1[3]);
                    }
                    ss += shx(ss, 16); ss += shx(ss, 32);
                    if (fq == 0 && (row & 4095) != 0) unsafeAtomicAdd(p.ssq_out + row, ss);
                }
            }
            asm volatile("s_waitcnt vmcnt(0) lgkmcnt(0)\n\ts_barrier" ::: "memory");
            if (wr == 0 && wc == 0 && fr == 0 && fq == 0) {
                unsigned* c = p.cnt + 64 * u.pm;
                __hip_atomic_fetch_add(c, 1u, __ATOMIC_RELAXED, __HIP_MEMORY_SCOPE_AGENT);
                unsigned spins = 0;
                while (__hip_atomic_load(c, __ATOMIC_RELAXED, __HIP_MEMORY_SCOPE_AGENT) < 4u && ++spins < (1u << 22)) __builtin_amdgcn_s_sleep(1);
            }
            asm volatile("s_waitcnt vmcnt(0) lgkmcnt(0)\n\ts_barrier" ::: "memory");
            f32x4 gg[2][2];
#pragma unroll
            for (int bj = 0; bj < 2; ++bj) { const int col = pn * 256 + bj * 128 + colw; gg[bj][0] = *(const f32x4*)(p.gnext + col); gg[bj][1] = *(const f32x4*)(p.gnext + col + 4); }
            float sq[2][4];
#pragma unroll
            for (int ai = 0; ai < 2; ++ai)
#pragma unroll
                for (int m = 0; m < 4; ++m) sq[ai][m] = __hip_atomic_load(p.ssq_out + rowb + ai * 128 + m * 16, __ATOMIC_RELAXED, __HIP_MEMORY_SCOPE_AGENT);
#pragma unroll
            for (int ai = 0; ai < 2; ++ai)
#pragma unroll
                for (int m = 0; m < 4; ++m) {
                    const int row = rowb + ai * 128 + m * 16;
                    const float rs = __builtin_amdgcn_rsqf(sq[ai][m] * (1.f / 1024.f) + EPS);
                    if ((row & 4095) != 0) {
#pragma unroll
                        for (int bj = 0; bj < 2; ++bj) { const size_t off = (size_t)row * D + pn * 256 + bj * 128 + colw;
                            *(f32x4*)(p.xout + off) = xn[ai][m][bj][0] * rs * gg[bj][0]; *(f32x4*)(p.xout + off + 4) = xn[ai][m][bj][1] * rs * gg[bj][1]; }
                    }
                }
        } else if constexpr (MODE == 6) {
            const int sq_ = u.pm / 17, jt = u.pm - sq_ * 17, p0 = 254 * jt - 2;
            const int colh = pn * 128 + colw;
            float rsv[2][4];
#pragma unroll
            for (int ai = 0; ai < 2; ++ai)
#pragma unroll
                for (int m = 0; m < 4; ++m) { int grow = sq_ * 4096 + p0 + ai * 128 + wr * 64 + m * 16 + fr; grow = grow < 0 ? 0 : (grow > M - 1 ? M - 1 : grow); rsv[ai][m] = p.ssq[grow]; }
            __builtin_amdgcn_sched_barrier(0);
#pragma unroll
            for (int ai = 0; ai < 2; ++ai)
#pragma unroll
                for (int m = 0; m < 4; ++m) rsv[ai][m] = __builtin_amdgcn_rsqf(rsv[ai][m] * (1.f / 1024.f) + EPS);
            if (fr >= 14) {
#pragma unroll
                for (int ai = 0; ai < 2; ++ai) {
                    const float rs = rsv[ai][3];
                    LAS float* d = p.xch + ((((ai * 2 + wr) * 4 + wc) * 4 + fq) * 2 + (fr - 14)) * 8;
                    *(LAS f32x4*)d = acc[ai][0][3][0] * rs; *(LAS f32x4*)(d + 4) = acc[ai][0][3][1] * rs; }
            }
            asm volatile("s_waitcnt lgkmcnt(0)\n\ts_barrier" ::: "memory");
            float w0[8], w1[8], w2[8], cbv[8];
#pragma unroll
            for (int k = 0; k < 8; ++k) { w0[k] = p.cw[colh + k]; w1[k] = p.cw[FF + colh + k]; w2[k] = p.cw[2 * FF + colh + k]; cbv[k] = p.cb[colh + k]; }
#pragma unroll
            for (int ai = 0; ai < 2; ++ai) {
                float r1p[8], r2p[8];
                {
                    const bool has = (wr == 1) || (ai == 1);
                    const int ais = (wr == 1) ? ai : ai - 1, wrs = (wr == 1) ? 0 : 1;
                    f32x4 h62a = (f32x4){0.f, 0.f, 0.f, 0.f}, h62b = h62a, h63a = h62a, h63b = h62a;
                    if (has) { const LAS float* s = p.xch + ((((ais * 2 + wrs) * 4 + wc) * 4 + fq) * 2) * 8;
                        h62a = *(const LAS f32x4*)s; h62b = *(const LAS f32x4*)(s + 4); h63a = *(const LAS f32x4*)(s + 8); h63b = *(const LAS f32x4*)(s + 12); }
#pragma unroll
                    for (int k = 0; k < 4; ++k) { r1p[k] = h63a[k]; r1p[4 + k] = h63b[k]; r2p[k] = (fr == 0) ? h62a[k] : h63a[k]; r2p[4 + k] = (fr == 0) ? h62b[k] : h63b[k]; }
                }
#pragma unroll
                for (int m = 0; m < 4; ++m) {
                    const int lr = ai * 128 + wr * 64 + m * 16 + fr, pos = p0 + lr;
                    const float rs = rsv[ai][m];
                    float y[8];
#pragma unroll
                    for (int k = 0; k < 8; ++k) {
                        const float a0 = (k < 4 ? acc[ai][0][m][0][k & 3] : acc[ai][0][m][1][k & 3]) * rs;
                        const float r1 = __int_as_float(__builtin_amdgcn_update_dpp(0, __float_as_int(a0), 0x121, 0xf, 0xf, false));
                        const float r2 = __int_as_float(__builtin_amdgcn_update_dpp(0, __float_as_int(a0), 0x122, 0xf, 0xf, false));
                        float t1 = (fr == 0) ? r1p[k] : r1, t2 = (fr < 2) ? r2p[k] : r2;
                        r1p[k] = r1; r2p[k] = r2;
                        if (jt == 0 && ai == 0 && m == 0 && wr == 0) { t1 = (pos >= 1) ? t1 : 0.f; t2 = (pos >= 2) ? t2 : 0.f; }
                        const float cv = w0[k] * t2 + w1[k] * t1 + w2[k] * a0 + cbv[k];
                        const float bvv = (k < 4 ? acc[ai][1][m][0][k & 3] : acc[ai][1][m][1][k & 3]) * rs;
                        y[k] = cv * sigmoidf_(cv) * bvv;
                    }
                    if (lr >= 2 && pos < 4096)
                        *(u32x4*)(p.H + (size_t)(sq_ * 4096 + pos) * FF + colh) = (u32x4){pk_bf16(y[0], y[1]), pk_bf16(y[2], y[3]), pk_bf16(y[4], y[5]), pk_bf16(y[6], y[7])};
                }
            }
        } else {
#pragma unroll
            for (int ai = 0; ai < 2; ++ai)
#pragma unroll
                for (int m = 0; m < 4; ++m) {
                    const int row = rowb + ai * 128 + m * 16;
                    const float sc = __builtin_amdgcn_rsqf(p.ssq[row] * (1.f / 1024.f) + EPS);
#pragma unroll
                    for (int bj = 0; bj < 2; ++bj) {
                        const f32x4 v0 = acc[ai][bj][m][0] * sc, v1 = acc[ai][bj][m][1] * sc;
                        u32x4 w; w.x = pk_bf16(v0[0], v0[1]); w.y = pk_bf16(v0[2], v0[3]); w.z = pk_bf16(v1[0], v1[1]); w.w = pk_bf16(v1[2], v1[3]);
                        *(u32x4*)(p.U + (size_t)row * U_LD + pn * 256 + bj * 128 + colw) = w;
                    }
                }
        }
    }
};

namespace sb {
constexpr int PITCH = PA_LD, NW = 8, QB = 256, KVBLK = 64;
constexpr int NSLOT = 3, SLOTB = 8192;
constexpr int LDS_K = 0, LDS_V = NSLOT * SLOTB, LDS_OST = 2 * NSLOT * SLOTB, LDS_BYTES = LDS_OST + NW * 4096;
__device__ __forceinline__ void glds16(const void* gsrc, unsigned lds_dst) { unsigned keep;
    asm volatile("s_mov_b32 %0, m0\n\ts_mov_b32 m0, %2\n\ts_nop 0\n\tglobal_load_lds_dwordx4 %1, off\n\ts_mov_b32 m0, %0" : "=&s"(keep) : "v"(gsrc), "s"(lds_dst) : "memory"); }
__device__ __forceinline__ int crow(int r, int hi) { return (r & 3) + 8 * (r >> 2) + 4 * hi; }
typedef short v4i16_t __attribute__((ext_vector_type(4)));
__device__ __forceinline__ s16x4 vtr(const LAS char* p) { return __builtin_bit_cast(s16x4, __builtin_amdgcn_ds_read_tr16_b64_v4i16((LAS v4i16_t*)p)); }

__device__ __forceinline__ void unit(int b, int h, int qb, bf16_t* PA, LAS char* shm) {
    int tid_ = threadIdx.x; asm volatile("" : "+v"(tid_));
    const int tid = tid_, lane = tid & 63, r32 = lane & 31, hi = lane >> 5; const int wid = __builtin_amdgcn_readfirstlane(tid >> 6);
    const long rowbase = (long)b * SEQ; const int q0 = qb * QB;
    const bf16_t* Qw = PA + (rowbase + q0 + wid * 32) * PITCH + h * 64;
    const bf16_t* Kh = PA + rowbase * PITCH + 512 + h * 64;
    const bf16_t* Vh = PA + rowbase * PITCH + 1024 + h * 64;
    const unsigned lds0 = (unsigned)(uintptr_t)shm;
    const int kperm = ((lane >> 2) & 1) * 32 + (lane >> 5) * 16 + ((lane & 31) >> 3) * 4 + (lane & 3);
    const bf16_t* ksrc = Kh + (long)kperm * PITCH + wid * 8;
    const bf16_t* vsrc = Vh + (long)(16 * (wid & 3) + (lane >> 2)) * PITCH + (wid >> 2) * 32 + (lane & 3) * 8;
    const unsigned kdst = lds0 + LDS_K + wid * 1024, vdst = lds0 + LDS_V + wid * 1024;
#define DMA_KV(t, slot) do { glds16(ksrc + (long)(t) * KVBLK * PITCH, (unsigned)__builtin_amdgcn_readfirstlane(kdst + (slot))); \
                             glds16(vsrc + (long)(t) * KVBLK * PITCH, (unsigned)__builtin_amdgcn_readfirstlane(vdst + (slot))); } while (0)
    const int NT = (q0 + QB) / KVBLK;
    bf16x8 qr[4];
#pragma unroll
    for (int d0 = 0; d0 < 4; ++d0) qr[d0] = *reinterpret_cast<const bf16x8*>(&Qw[(long)r32 * PITCH + d0 * 16 + hi * 8]);
    DMA_KV(NT - 1, 0); DMA_KV(NT - 2, SLOTB);
    asm volatile("" : "+v"(qr[0]), "+v"(qr[1]), "+v"(qr[2]), "+v"(qr[3]));
    f32x16 o[2]; o[0] = f32x16{}; o[1] = f32x16{};
    float carry = 1.f;
    const int qrel = wid * 32 + r32;
    const LAS char* kp0 = shm + LDS_K + hi * 1024 + r32 * 16;
    const LAS char* vp0 = shm + LDS_V + (32 * hi + ((lane & 15) >> 2)) * 64 + ((lane >> 4) & 1) * 32 + (lane & 3) * 8;
    int slot = 0, slot2 = 2 * SLOTB;
    for (int t = NT - 1; t >= 0; --t) {
        if (t >= 1) asm volatile("s_waitcnt vmcnt(2) lgkmcnt(0)\n\ts_barrier" ::: "memory");
        else        asm volatile("s_waitcnt vmcnt(0) lgkmcnt(0)\n\ts_barrier" ::: "memory");
        if (t >= 2) DMA_KV(t - 2, slot2);
        const int jb = t - (NT - 4);
        if (jb <= (wid >> 1)) {
            const LAS char* kb = kp0 + slot; const LAS char* vb = vp0 + slot;
            bf16x8 kf[8];
#pragma unroll
            for (int d0 = 0; d0 < 4; ++d0) { kf[2 * d0] = *(const LAS bf16x8*)(kb + d0 * 2048); kf[2 * d0 + 1] = *(const LAS bf16x8*)(kb + d0 * 2048 + 512); }
            s16x4 vl[8], vh[8];
#pragma unroll
            for (int i = 0; i < 8; ++i) { vl[i] = vtr(vb + (i >> 2) * 4096 + (i & 3) * 512); vh[i] = vtr(vb + (i >> 2) * 4096 + (i & 3) * 512 + 256); }
            __builtin_amdgcn_sched_barrier(0);
            f32x16 p0 = f32x16{}, p1 = f32x16{};
#pragma unroll
            for (int d0 = 0; d0 < 4; ++d0) {
                p0 = __builtin_amdgcn_mfma_f32_32x32x16_bf16(kf[2 * d0], qr[d0], p0, 0, 0, 0);
                p1 = __builtin_amdgcn_mfma_f32_32x32x16_bf16(kf[2 * d0 + 1], qr[d0], p1, 0, 0, 0);
            }
#pragma unroll
            for (int r = 0; r < 16; ++r) { p0[r] = __builtin_amdgcn_exp2f(__builtin_amdgcn_fmed3f(p0[r], 15.f, -3.0e38f)); p1[r] = __builtin_amdgcn_exp2f(__builtin_amdgcn_fmed3f(p1[r], 15.f, -3.0e38f)); }
            if (jb == (wid >> 1)) {
                const int kb0 = 64 * jb + 32 * hi;
#pragma unroll
                for (int r = 0; r < 16; ++r) { if (kb0 + r >= qrel) p0[r] = 0.f; if (kb0 + 16 + r >= qrel) p1[r] = 0.f; }
            }
            float R0, R1, R2, R3;
            { float Q = 1.f;
#pragma unroll
              for (int i = 0; i < 8; ++i) { const float d = Q * p0[i]; p0[i] = d; Q += d; }
              R0 = __builtin_amdgcn_rcpf(Q); }
            { float Q = 1.f;
#pragma unroll
              for (int i = 8; i < 16; ++i) { const float d = Q * p0[i]; p0[i] = d; Q += d; }
              R1 = __builtin_amdgcn_rcpf(Q); }
            { float Q = 1.f;
#pragma unroll
              for (int i = 0; i < 8; ++i) { const float d = Q * p1[i]; p1[i] = d; Q += d; }
              R2 = __builtin_amdgcn_rcpf(Q); }
            { float Q = 1.f;
#pragma unroll
              for (int i = 8; i < 16; ++i) { const float d = Q * p1[i]; p1[i] = d; Q += d; }
              R3 = __builtin_amdgcn_rcpf(Q); }
            const float Tl = (R0 * R1) * (R2 * R3);
            float Tp;
            { const auto rr = __builtin_amdgcn_permlane32_swap(__float_as_uint(Tl), __float_as_uint(Tl), false, false); Tp = __uint_as_float(hi == 0 ? rr[1] : rr[0]); }
            const float base = carry * (hi == 0 ? Tp : 1.f);
            carry = carry * Tl * Tp;
            const float sc3 = base * R3, sc2 = sc3 * R2, sc1 = sc2 * R1, sc0 = sc1 * R0;
#pragma unroll
            for (int i = 0; i < 8; ++i) { p0[i] *= sc0; p0[8 + i] *= sc1; p1[i] *= sc2; p1[8 + i] *= sc3; }
            u32x4 pw0, pw1, pw2, pw3;
            pw0 = (u32x4){pk_bf16(p0[0], p0[1]), pk_bf16(p0[2], p0[3]), pk_bf16(p0[4], p0[5]), pk_bf16(p0[6], p0[7])};
            pw1 = (u32x4){pk_bf16(p0[8], p0[9]), pk_bf16(p0[10], p0[11]), pk_bf16(p0[12], p0[13]), pk_bf16(p0[14], p0[15])};
            pw2 = (u32x4){pk_bf16(p1[0], p1[1]), pk_bf16(p1[2], p1[3]), pk_bf16(p1[4], p1[5]), pk_bf16(p1[6], p1[7])};
            pw3 = (u32x4){pk_bf16(p1[8], p1[9]), pk_bf16(p1[10], p1[11]), pk_bf16(p1[12], p1[13]), pk_bf16(p1[14], p1[15])};
#pragma unroll
            for (int d0 = 0; d0 < 2; ++d0) {
#define PKV(k) (bf16x8){vl[d0 * 4 + k][0], vl[d0 * 4 + k][1], vl[d0 * 4 + k][2], vl[d0 * 4 + k][3], vh[d0 * 4 + k][0], vh[d0 * 4 + k][1], vh[d0 * 4 + k][2], vh[d0 * 4 + k][3]}
                o[d0] = __builtin_amdgcn_mfma_f32_32x32x16_bf16(__builtin_bit_cast(bf16x8, pw0), PKV(0), o[d0], 0, 0, 0);
                o[d0] = __builtin_amdgcn_mfma_f32_32x32x16_bf16(__builtin_bit_cast(bf16x8, pw1), PKV(1), o[d0], 0, 0, 0);
                o[d0] = __builtin_amdgcn_mfma_f32_32x32x16_bf16(__builtin_bit_cast(bf16x8, pw2), PKV(2), o[d0], 0, 0, 0);
                o[d0] = __builtin_amdgcn_mfma_f32_32x32x16_bf16(__builtin_bit_cast(bf16x8, pw3), PKV(3), o[d0], 0, 0, 0);
#undef PKV
            }
        }
        slot2 = slot; slot = (slot == (NSLOT - 1) * SLOTB) ? 0 : slot + SLOTB;
    }
    bf16_t* Ow = PA + (rowbase + q0 + wid * 32) * PITCH + h * 64;
    {
        LAS bf16_t* stg = (LAS bf16_t*)(shm + LDS_OST) + wid * 2048;
#pragma unroll
        for (int r = 0; r < 16; ++r) { const int orow = crow(r, hi);
#pragma unroll
            for (int d0 = 0; d0 < 2; ++d0) stg[orow * 64 + d0 * 32 + r32] = (bf16_t)(pk_bf16(o[d0][r], 0.f) & 0xffffu); }
        asm volatile("s_waitcnt lgkmcnt(0)" ::: "memory");
#pragma unroll
        for (int i = 0; i < 4; ++i) { const int row = i * 8 + (lane >> 3), ch = lane & 7; const u32x4 v = *(const LAS u32x4*)(stg + row * 64 + ch * 8); *(u32x4*)(Ow + (long)row * PITCH + ch * 8) = v; }
    }
    asm volatile("s_waitcnt vmcnt(0) lgkmcnt(0)\n\ts_barrier" ::: "memory");
#undef DMA_KV
}
}

namespace ret {
constexpr int RS = 272;
constexpr int L_Q = 0, L_K = 128 * RS, L_P = 2 * 128 * RS, L_V = 3 * 128 * RS, L_S = L_V + 128 * 64, LDS_BYTES = L_S + 2 * 32 * RS;
typedef short v4i16_t __attribute__((ext_vector_type(4)));
__device__ __forceinline__ s16x4 vtr(const LAS char* p) { return __builtin_bit_cast(s16x4, __builtin_amdgcn_ds_read_tr16_b64_v4i16((LAS v4i16_t*)p)); }
__device__ __forceinline__ bf16x8 cat(s16x4 a, s16x4 b) { return (bf16x8){a[0], a[1], a[2], a[3], b[0], b[1], b[2], b[3]}; }

__device__ __forceinline__ void item(int b, int h, int sl, bf16_t* PA, LAS char* shm) {
    int tid_ = threadIdx.x; asm volatile("" : "+v"(tid_));
    const int tid = tid_, lane = tid & 63, fr = lane & 15, fq = lane >> 4; const int wid = __builtin_amdgcn_readfirstlane(tid >> 6);
    const size_t rowbase = (size_t)b * SEQ;
    const bf16_t* Qg = PA + rowbase * PA_LD + 1536 + h * 128;
    const bf16_t* Kg = PA + rowbase * PA_LD + 2048 + h * 128;
    bf16_t* Vg = PA + rowbase * PA_LD + 2560 + h * 256 + sl * 32;
    const float lg = __builtin_log2f(1.f - __builtin_exp2f(-5.f - (float)h));
    const float gam128 = __builtin_exp2f(128.f * lg);
    for (int i = tid; i < 32 * RS / 4; i += 512) ((LAS unsigned*)(shm + L_S))[i] = 0u;
    u32x4 qA[4], kA[4], vA, qB[4], kB[4], vB;
#define RET_LOAD(c, Q_, K_, V_) do { _Pragma("unroll") for (int i = 0; i < 4; ++i) { const int id = tid + 512 * i, row = id >> 4, ch = id & 15; \
            Q_[i] = *(const u32x4*)(Qg + (size_t)((c) * 128 + row) * PA_LD + ch * 8); K_[i] = *(const u32x4*)(Kg + (size_t)((c) * 128 + row) * PA_LD + ch * 8); } \
        V_ = *(const u32x4*)(Vg + (size_t)((c) * 128 + (tid >> 2)) * PA_LD + (tid & 3) * 8); } while (0)
#define RET_STORE(Q_, K_, V_) do { _Pragma("unroll") for (int i = 0; i < 4; ++i) { const int id = tid + 512 * i, row = id >> 4, ch = id & 15; \
            *(LAS u32x4*)(shm + L_Q + row * RS + ch * 16) = Q_[i]; *(LAS u32x4*)(shm + L_K + row * RS + ch * 16) = K_[i]; } \
        *(LAS u32x4*)(shm + L_V + (tid >> 2) * 64 + (tid & 3) * 16) = V_; } while (0)
    RET_LOAD(0, qA, kA, vA); RET_LOAD(1, qB, kB, vB);
    f32x4 st[2]; st[0] = (f32x4){0.f, 0.f, 0.f, 0.f}; st[1] = st[0];
    auto step = [&](const int c, u32x4 (&Qs)[4], u32x4 (&Ks)[4], u32x4& Vs) __attribute__((always_inline)) {
        RET_STORE(Qs, Ks, Vs);
        asm volatile("s_waitcnt lgkmcnt(0)\n\ts_barrier" ::: "memory");
        if (c + 2 < 32) RET_LOAD(c + 2, Qs, Ks, Vs);
        const LAS char* Scur = shm + L_S + (c & 1) * 32 * RS; LAS char* Snxt = shm + L_S + ((c + 1) & 1) * 32 * RS;
        bf16x8 bq[4];
        {
#pragma unroll
            for (int ks = 0; ks < 4; ++ks) bq[ks] = *(const LAS bf16x8*)(shm + L_Q + (16 * wid + fr) * RS + (ks * 32 + 8 * fq) * 2);
            const int n = 16 * wid + fr;
#pragma unroll
            for (int hb = 0; hb < 2; ++hb) {
                bf16x8 ak[4][4];
#pragma unroll
                for (int mi = 0; mi < 4; ++mi)
#pragma unroll
                    for (int ks = 0; ks < 4; ++ks) ak[mi][ks] = *(const LAS bf16x8*)(shm + L_K + (16 * (4 * hb + mi) + fr) * RS + (ks * 32 + 8 * fq) * 2);
                __builtin_amdgcn_sched_barrier(0);
#pragma unroll
                for (int mi = 0; mi < 4; ++mi) {
                    f32x4 a4 = (f32x4){0.f, 0.f, 0.f, 0.f};
#pragma unroll
                    for (int ks = 0; ks < 4; ++ks) a4 = __builtin_amdgcn_mfma_f32_16x16x32_bf16(ak[mi][ks], bq[ks], a4, 0, 0, 0);
                    const int m0 = 16 * (4 * hb + mi) + 4 * fq;
#pragma unroll
                    for (int k = 0; k < 4; ++k) if (m0 + k > n) a4[k] = 0.f;
                    u32x2 w; w.x = pk_bf16(a4[0], a4[1]); w.y = pk_bf16(a4[2], a4[3]);
                    *(LAS u32x2*)(shm + L_P + n * RS + m0 * 2) = w;
                }
                __builtin_amdgcn_sched_barrier(0);
            }
        }
        bf16x8 vf[4][2];
        {
            bf16x8 kfr[4];
#pragma unroll
            for (int ks = 0; ks < 4; ++ks) {
                const int r0 = 32 * ks + 8 * fq + (fr >> 2);
                const LAS char* ka = shm + L_K + r0 * RS + (16 * wid + 4 * (fr & 3)) * 2;
                kfr[ks] = cat(vtr(ka), vtr(ka + 4 * RS));
#pragma unroll
                for (int eb = 0; eb < 2; ++eb) { const LAS char* va = shm + L_V + r0 * 64 + (16 * eb + 4 * (fr & 3)) * 2; vf[ks][eb] = cat(vtr(va), vtr(va + 4 * 64)); }
            }
            __builtin_amdgcn_sched_barrier(0);
            f32x4 kv[2]; kv[0] = (f32x4){0.f, 0.f, 0.f, 0.f}; kv[1] = kv[0];
#pragma unroll
            for (int ks = 0; ks < 4; ++ks)
#pragma unroll
                for (int eb = 0; eb < 2; ++eb) kv[eb] = __builtin_amdgcn_mfma_f32_16x16x32_bf16(kfr[ks], vf[ks][eb], kv[eb], 0, 0, 0);
#pragma unroll
            for (int eb = 0; eb < 2; ++eb) {
                st[eb] = (st[eb] + kv[eb]) * gam128;
                u32x2 w; w.x = pk_bf16(st[eb][0], st[eb][1]); w.y = pk_bf16(st[eb][2], st[eb][3]);
                *(LAS u32x2*)(Snxt + (16 * eb + fr) * RS + (16 * wid + 4 * fq) * 2) = w;
            }
        }
        asm volatile("s_waitcnt lgkmcnt(0)\n\ts_barrier" ::: "memory");
        {
            bf16x8 bp[4], as_[4][2];
#pragma unroll
            for (int ks = 0; ks < 4; ++ks) {
                bp[ks] = *(const LAS bf16x8*)(shm + L_P + (16 * wid + fr) * RS + (ks * 32 + 8 * fq) * 2);
#pragma unroll
                for (int eb = 0; eb < 2; ++eb) as_[ks][eb] = *(const LAS bf16x8*)(Scur + (16 * eb + fr) * RS + (ks * 32 + 8 * fq) * 2);
            }
            __builtin_amdgcn_sched_barrier(0);
            f32x4 oa[2]; oa[0] = (f32x4){0.f, 0.f, 0.f, 0.f}; oa[1] = oa[0];
#pragma unroll
            for (int ks = 0; ks < 4; ++ks)
#pragma unroll
                for (int eb = 0; eb < 2; ++eb) {
                    oa[eb] = __builtin_amdgcn_mfma_f32_16x16x32_bf16(vf[ks][eb], bp[ks], oa[eb], 0, 0, 0);
                    oa[eb] = __builtin_amdgcn_mfma_f32_16x16x32_bf16(as_[ks][eb], bq[ks], oa[eb], 0, 0, 0);
                }
#pragma unroll
            for (int eb = 0; eb < 2; ++eb) {
                u32x2 w; w.x = pk_bf16(oa[eb][0], oa[eb][1]); w.y = pk_bf16(oa[eb][2], oa[eb][3]);
                *(u32x2*)(Vg + (size_t)(c * 128 + 16 * wid + fr) * PA_LD + 16 * eb + 4 * fq) = w;
            }
        }
    };
    for (int c = 0; c < 32; c += 2) { step(c, qA, kA, vA); step(c + 1, qB, kB, vB); }
    asm volatile("s_waitcnt lgkmcnt(0)\n\ts_barrier" ::: "memory");
#undef RET_LOAD
#undef RET_STORE
}
}


namespace side {
constexpr int RED_OFF = 98304;
__device__ __forceinline__ void gemv_item(LAS unsigned char* lds, const float* W, int ldw, int kb, int n0, float* outp, int ldo) {
    int tid_ = threadIdx.x; asm volatile("" : "+v"(tid_));
    const int tid = tid_, lane = tid & 63, wave = __builtin_amdgcn_readfirstlane(tid >> 6);
    const LAS f32x4* A = (const LAS f32x4*)lds;
    float acc[8];
#pragma unroll
    for (int r = 0; r < 8; ++r) acc[r] = 0.f;
    const int k0 = kb + wave * 32;
    const float* wp = W + (size_t)k0 * ldw + n0 + lane;
    float w[32];
#pragma unroll
    for (int k = 0; k < 32; ++k) w[k] = wp[(size_t)k * ldw];
#pragma unroll
    for (int k = 0; k < 32; ++k) {
        const f32x4 a0 = A[(k0 + k) * 2], a1 = A[(k0 + k) * 2 + 1];
        acc[0] += a0[0] * w[k]; acc[1] += a0[1] * w[k]; acc[2] += a0[2] * w[k]; acc[3] += a0[3] * w[k];
        acc[4] += a1[0] * w[k]; acc[5] += a1[1] * w[k]; acc[6] += a1[2] * w[k]; acc[7] += a1[3] * w[k];
    }
    LAS float* red = (LAS float*)(lds + RED_OFF);
#pragma unroll
    for (int r = 0; r < 8; ++r) red[(wave * 8 + r) * 64 + lane] = acc[r];
    __syncthreads();
    { float s = 0.f;
#pragma unroll
      for (int ww = 0; ww < 8; ++ww) s += red[(ww * 8 + wave) * 64 + lane];
      unsafeAtomicAdd(outp + (size_t)wave * ldo + n0 + lane, s); }
    __syncthreads();
}
__device__ __forceinline__ void prep_norm(LAS unsigned char* lds, const float* xa, size_t xa_stride, const float* add, const float* g, bool wr, float* outw, bf16_t* XNw, float* ssqw, float* xsw, bool normw = false) {
    int tid_ = threadIdx.x; asm volatile("" : "+v"(tid_));
    const int lane = tid_ & 63, r = __builtin_amdgcn_readfirstlane(tid_ >> 6);
    const size_t rowoff = (size_t)r * SEQ * D;
    float v[16]; float s = 0.f;
#pragma unroll
    for (int j = 0; j < 16; ++j) { const int k = lane + 64 * j; v[j] = xa[(size_t)r * xa_stride + k] + (add ? add[r * D + k] : 0.f); s += v[j] * v[j]; }
    s = wave_sum(s);
    const float rs = 1.f / sqrtf(s * (1.f / 1024.f) + EPS);
    LAS float* A = (LAS float*)lds;
#pragma unroll
    for (int j = 0; j < 16; ++j) { const int k = lane + 64 * j; const float gk = g[k]; A[k * 8 + r] = v[j] * gk * rs;
        if (wr) { outw[rowoff + k] = normw ? v[j] * gk * rs : v[j]; XNw[rowoff + k] = (bf16_t)(pk_bf16(v[j] * gk, 0.f) & 0xffffu); if (xsw) xsw[r * D + k] = v[j]; } }
    if (wr && lane == 0) ssqw[(size_t)r * SEQ] = s;
    __syncthreads();
}
__device__ __forceinline__ float silu_(float x) { return x / (1.f + __expf(-x)); }
__device__ __forceinline__ float sigm_(float x) { return 1.f / (1.f + __expf(-x)); }
}


__device__ __forceinline__ unsigned xb_ld(unsigned* p)              { return __hip_atomic_load(p, __ATOMIC_RELAXED, __HIP_MEMORY_SCOPE_AGENT); }
__device__ __forceinline__ unsigned xb_add(unsigned* p, unsigned v) { return __hip_atomic_fetch_add(p, v, __ATOMIC_RELAXED, __HIP_MEMORY_SCOPE_AGENT); }
__device__ __forceinline__ unsigned xb_xcc_id() { return (unsigned)__builtin_amdgcn_s_getreg((3 << 11) | 20) & 0xFu; }
#define XB_TMO      128
#define XB_XCNT(j)  (256  + 64 * (j))
#define XB_XSUB(j)  (1280 + 64 * (j))
#define XB_XGEN(j)  (2304 + 64 * (j))
#define XB_TOP      3328
#define XB_TOPGEN   3392
#define XCD_BAR_WORDS 3456
#define XB_SPIN_CAP (1u << 18)

#define XB_SPIN(cond, bar) do { unsigned _sp = 0; while (cond) { __builtin_amdgcn_s_sleep(1); \
    if ((++_sp & 255u) == 0u) { if (xb_ld(&(bar)[XB_TMO])) break; if (_sp > XB_SPIN_CAP) { atomicAdd(&(bar)[XB_TMO], 1u); break; } } } } while (0)

struct XcdBarrier {
    unsigned* bar; unsigned x;
    volatile LAS unsigned* st;
};

__device__ __forceinline__ XcdBarrier xcd_barrier_post(unsigned* bar, volatile LAS unsigned* st) {
    XcdBarrier b; b.bar = bar; b.x = xb_xcc_id(); b.st = st;
    if (threadIdx.x == 0) (void)xb_add(&bar[XB_XCNT(b.x)], 1u);
    return b;
}
__device__ __forceinline__ void xcd_barrier_complete(unsigned* bar, unsigned x, unsigned& nloc, unsigned& nx) {
    const unsigned G = gridDim.x * gridDim.y * gridDim.z;
    unsigned sum, cnt, mine, sp = 0u;
    for (;;) {
        sum = 0u; cnt = 0u; mine = 0u;
#pragma unroll
        for (unsigned j = 0; j < 16; ++j) { const unsigned c = xb_ld(&bar[XB_XCNT(j)]); sum += c; cnt += (c > 0u) ? 1u : 0u; mine = (j == x) ? c : mine; }
        if (sum == G) break;
        __builtin_amdgcn_s_sleep(1);
        if ((++sp & 255u) == 0u) { if (xb_ld(&bar[XB_TMO])) break; if (sp > XB_SPIN_CAP) { atomicAdd(&bar[XB_TMO], 1u); break; } }
    }
    nloc = mine > 0u ? mine : 1u; nx = cnt > 0u ? cnt : 1u;
}

__device__ __forceinline__ void xcd_barrier(const XcdBarrier& b) {
    asm volatile("s_waitcnt vmcnt(0)" ::: "memory");
    __syncthreads();
    if (threadIdx.x == 0) {
        unsigned* bar = b.bar;
        __builtin_amdgcn_s_waitcnt(0);
        unsigned nloc = b.st[0], nx = b.st[1];
        if (nloc == 0u) { xcd_barrier_complete(bar, b.x, nloc, nx); b.st[0] = nloc; b.st[1] = nx; }
        const unsigned old = xb_add(&bar[XB_XSUB(b.x)], 1u);
        const unsigned gen = old / nloc;
        if (old + 1u == (gen + 1u) * nloc) {
            __builtin_amdgcn_fence(__ATOMIC_RELEASE, "agent");
            asm volatile("s_waitcnt vmcnt(0)" ::: "memory");
            const unsigned og = xb_add(&bar[XB_TOP], 1u);
            const unsigned tg = og / nx;
            if (og + 1u == (tg + 1u) * nx) xb_add(&bar[XB_TOPGEN], 1u);
            else XB_SPIN(xb_ld(&bar[XB_TOPGEN]) == tg, bar);
            __builtin_amdgcn_fence(__ATOMIC_ACQUIRE, "agent");
            xb_add(&bar[XB_XGEN(b.x)], 1u);
            asm volatile("s_waitcnt vmcnt(0)" ::: "memory");
        } else {
            XB_SPIN(xb_ld(&bar[XB_XGEN(b.x)]) == gen, bar);
            __builtin_amdgcn_fence(__ATOMIC_ACQUIRE, "agent");
            asm volatile("s_waitcnt vmcnt(0)" ::: "memory");
        }
    }
    __syncthreads();
}


struct Args { const float* in[14]; float* out; unsigned char* ws; };

__device__ __forceinline__ int rope_prow(int n) { if (n >= 1536 && n < 2560) { const int j = (n - 1536) & 127, base = n - j; return base + (j < 64 ? 2 * j : 2 * (j - 64) + 1); } return n; }
#define TI_LOAD(wv, W, N, item) do { const int nblk_ = (N) / 32, k0_ = 64 * ((item) / nblk_), n0_ = 32 * ((item) % nblk_); \
    _Pragma("unroll") for (int i = 0; i < 32; ++i) wv[i] = (W)[(size_t)(k0_ + 2 * i + (lane >> 5)) * (N) + n0_ + (lane & 31)]; } while (0)
#define TI_STORE(wv, WT, N, ldt, koff, perm, item) do { const int nblk_ = (N) / 32, k0_ = 64 * ((item) / nblk_), n0_ = 32 * ((item) % nblk_); \
    _Pragma("unroll") for (int i = 0; i < 32; ++i) scr[(2 * i + (lane >> 5)) * 33 + (lane & 31)] = wv[i]; \
    asm volatile("s_waitcnt lgkmcnt(0)" ::: "memory"); \
    const int c_ = lane & 7; \
    _Pragma("unroll") for (int j = 0; j < 4; ++j) { const int n_ = (lane >> 3) + 8 * j; const LAS float* s_ = scr + (8 * c_) * 33 + n_; \
        u32x4 o_; o_.x = pk_bf16(s_[0 * 33], s_[1 * 33]); o_.y = pk_bf16(s_[2 * 33], s_[3 * 33]); o_.z = pk_bf16(s_[4 * 33], s_[5 * 33]); o_.w = pk_bf16(s_[6 * 33], s_[7 * 33]); \
        const int nn_ = n0_ + n_; \
        const int dr_ = ((perm) == 1) ? rope_prow(nn_) : ((perm) == 2) ? ((nn_ < FF) ? ((nn_ >> 7) * 256 + (nn_ & 127)) : (((nn_ - FF) >> 7) * 256 + 128 + ((nn_ - FF) & 127))) : nn_; \
        *(u32x4*)((WT) + (size_t)dr_ * (ldt) + (koff) + k0_ + 8 * c_) = o_; } \
    asm volatile("s_waitcnt lgkmcnt(0)" ::: "memory"); } while (0)
__device__ __forceinline__ void convert_mixer(const Args& a, int l, LAS unsigned char* lds, int gw, int NGW, int wave, int lane) {
    LAS float* scr = (LAS float*)(lds + wave * 16384);
    bf16_t* win = (bf16_t*)(a.ws + WS_WIN); bf16_t* wcat = (bf16_t*)(a.ws + WS_WCAT); bf16_t* wo = (bf16_t*)(a.ws + WS_WO);
    const float* w_in = a.in[2] + (size_t)l * D * IN_COLS; const float* sbw = a.in[4] + (size_t)l * 512 * D;
    const float* rw = a.in[6] + (size_t)l * D * D; const float* w_o = a.in[7] + (size_t)l * D * D;
    constexpr int I0 = (D / 64) * (IN_COLS / 32), I1 = (512 / 64) * (D / 32), I2 = (D / 64) * (D / 32), I3 = I2, NI = I0 + I1 + I2 + I3;
#define RES_MIX(it_, W_, WT_, N_, ldt_, koff_, perm_, item_) do { int r_ = (it_); \
        if (r_ < I0) { W_ = w_in; WT_ = win; N_ = IN_COLS; ldt_ = D; koff_ = 0; perm_ = 1; item_ = r_; } \
        else if (r_ < I0 + I1) { W_ = sbw; WT_ = wcat; N_ = D; ldt_ = 1536; koff_ = 0; perm_ = 0; item_ = r_ - I0; } \
        else if (r_ < I0 + I1 + I2) { W_ = rw; WT_ = wcat; N_ = D; ldt_ = 1536; koff_ = 512; perm_ = 0; item_ = r_ - I0 - I1; } \
        else { W_ = w_o; WT_ = wo; N_ = D; ldt_ = D; koff_ = 0; perm_ = 0; item_ = r_ - I0 - I1 - I2; } } while (0)
    for (int it = gw; it < NI; it += 2 * NGW) {
        const bool two = it + NGW < NI;
        const float *Wa, *Wb; bf16_t *Ta, *Tb; int Na, Nb, la, lb, ka, kb, pa, pb, ia, ib;
        RES_MIX(it, Wa, Ta, Na, la, ka, pa, ia); RES_MIX(two ? it + NGW : it, Wb, Tb, Nb, lb, kb, pb, ib);
        float wa[32], wb[32];
        TI_LOAD(wa, Wa, Na, ia);
        if (two) TI_LOAD(wb, Wb, Nb, ib);
        TI_STORE(wa, Ta, Na, la, ka, pa, ia);
        if (two) TI_STORE(wb, Tb, Nb, lb, kb, pb, ib);
    }
#undef RES_MIX
}
__device__ __forceinline__ void convert_ffn(const Args& a, int l, LAS unsigned char* lds, int gw, int NGW, int wave, int lane) {
    LAS float* scr = (LAS float*)(lds + wave * 16384);
    bf16_t* wup = (bf16_t*)(a.ws + WS_WUP); bf16_t* wdn = (bf16_t*)(a.ws + WS_WDN);
    const float* w_up = a.in[9] + (size_t)l * D * U_LD; const float* w_dn = a.in[12] + (size_t)l * FF * D;
    constexpr int I0 = (D / 64) * (U_LD / 32), I1 = (FF / 64) * (D / 32), NI = I0 + I1;
#define RES_FFN(it_, W_, WT_, N_, ldt_, koff_, perm_, item_) do { int r_ = (it_); \
        if (r_ < I0) { W_ = w_up; WT_ = wup; N_ = U_LD; ldt_ = D; koff_ = 0; perm_ = 2; item_ = r_; } \
        else { W_ = w_dn; WT_ = wdn; N_ = D; ldt_ = FF; koff_ = 0; perm_ = 0; item_ = r_ - I0; } } while (0)
    for (int it = gw; it < NI; it += 2 * NGW) {
        const bool two = it + NGW < NI;
        const float *Wa, *Wb; bf16_t *Ta, *Tb; int Na, Nb, la, lb, ka, kb, pa, pb, ia, ib;
        RES_FFN(it, Wa, Ta, Na, la, ka, pa, ia); RES_FFN(two ? it + NGW : it, Wb, Tb, Nb, lb, kb, pb, ib);
        float wa[32], wb[32];
        TI_LOAD(wa, Wa, Na, ia);
        if (two) TI_LOAD(wb, Wb, Nb, ib);
        TI_STORE(wa, Ta, Na, la, ka, pa, ia);
        if (two) TI_STORE(wb, Tb, Nb, lb, kb, pb, ib);
    }
#undef RES_FFN
}
#undef TI_LOAD
#undef TI_STORE

__global__ void __launch_bounds__(512, 2) fwd_kernel(Args a) {
    extern __shared__ __attribute__((aligned(16))) unsigned char lds_raw[];
    LAS unsigned char* lds = (LAS unsigned char*)lds_raw;
    cg::grid_group grid = cg::this_grid();
    const int G = gridDim.x, bx = blockIdx.x;
    if (threadIdx.x < 8) ((LAS unsigned*)(lds + 131072))[threadIdx.x] = 0u;
    __syncthreads();
    const int vcu = (G % 8 == 0) ? (bx % 8) * (G / 8) + bx / 8 : bx;
    const int NGW = G * 8, NGT = G * 512;
#define PHASE_IDS() int tid_ = threadIdx.x; asm volatile("" : "+v"(tid_)); const int tid = tid_, lane = tid & 63, wave = __builtin_amdgcn_readfirstlane(tid >> 6); \
    const int gw = vcu * 8 + wave, gtid = bx * 512 + tid; (void)gw; (void)gtid; (void)lane;
#define ws ({ __attribute__((address_space(1))) unsigned char* p_ = (__attribute__((address_space(1))) unsigned char*)a.ws; asm volatile("" : "+s"(p_)); (unsigned char*)p_; })
#define w_ssq ((float*)(ws + WS_SSQ))
#define w_rope ((f32x4*)(ws + WS_ROPE))
#define w_win ((bf16_t*)(ws + WS_WIN))
#define w_wcat ((bf16_t*)(ws + WS_WCAT))
#define w_wo ((bf16_t*)(ws + WS_WO))
#define w_XN ((bf16_t*)(ws + WS_XN))
#define w_PA ((bf16_t*)(ws + WS_PROJ))
#define w_PB ((bf16_t*)(ws + WS_PB))
#define w_U ((bf16_t*)(ws + WS_PROJ))
#define w_wup ((bf16_t*)(ws + WS_WUP))
#define w_wdn ((bf16_t*)(ws + WS_WDN))
#define w_SIDE ((float*)(ws + WS_SIDE))
#define w_XS ((float*)(ws + WS_XS))
    const float* x = a.in[0]; float* out = a.out;
#ifdef DIAG
    unsigned long long* ts_ = (unsigned long long*)(ws + WS_XS + 65536);
#define STAMP(i) do { if (bx == 0 && threadIdx.x == 0) ts_[i] = __builtin_amdgcn_s_memrealtime(); } while (0)
#else
#define STAMP(i) do {} while (0)
#endif

    {
    PHASE_IDS();
    convert_mixer(a, 0, lds, gw, NGW, wave, lane);
    for (int i = gtid; i < 4096 * 64; i += NGT) {
        const int pos = i >> 6, k = i & 63;
        const float inv = __builtin_exp2f(-(float)k * (13.287712379549449f / 64.f));
        const double ang = (double)((float)pos * inv);
        double rev = ang * 0.15915494309189535; rev -= __builtin_rint(rev);
        f32x2 cs; cs.x = __builtin_amdgcn_cosf((float)rev); cs.y = __builtin_amdgcn_sinf((float)rev);
        ((f32x2*)w_rope)[i] = cs;
    }
    for (int i = gtid; i < 4 * M; i += NGT) w_ssq[M + i] = 0.f;
    for (int i = gtid; i < 2 * SD_LAYER; i += NGT) w_SIDE[i] = 0.f;
    for (int i = gtid; i < 4096; i += NGT) ((unsigned*)(ws + WS_BAR))[i] = 0u;
    for (int i = gtid; i < 8192; i += NGT) ((unsigned*)(ws + WS_CNT))[i] = 0u;
    {
        const float* g0 = a.in[1];
        const f32x4* gr = (const f32x4*)g0 + lane;
        for (int m = gw; m < M; m += 4 * NGW) {
            f32x4 v[4][4];
#pragma unroll
            for (int u = 0; u < 4; ++u) { const f32x4* xr = (const f32x4*)(x + (size_t)(m + u * NGW) * D) + lane;
#pragma unroll
                for (int j = 0; j < 4; ++j) v[u][j] = xr[64 * j]; }
            __builtin_amdgcn_sched_barrier(0);
#pragma unroll
            for (int u = 0; u < 4; ++u) {
                float s = 0.f;
#pragma unroll
                for (int j = 0; j < 4; ++j) s += (v[u][j][0] * v[u][j][0] + v[u][j][1] * v[u][j][1]) + (v[u][j][2] * v[u][j][2] + v[u][j][3] * v[u][j][3]);
                s = wave_sum(s);
                if (lane == 0) w_ssq[m + u * NGW] = s;
                u32x2* o8 = (u32x2*)(w_XN + (size_t)(m + u * NGW) * D) + lane;
#pragma unroll
                for (int j = 0; j < 4; ++j) { const f32x4 w = v[u][j] * gr[64 * j]; u32x2 o; o.x = pk_bf16(w[0], w[1]); o.y = pk_bf16(w[2], w[3]); o8[64 * j] = o; }
            }
        }
    }
    }
    grid.sync(); STAMP(0);
    const XcdBarrier xbar = xcd_barrier_post((unsigned*)(ws + WS_BAR), (volatile LAS unsigned*)(lds + 131072));

#pragma unroll 1
    for (int l = 0; l < 2; ++l) {
        const float* bgate = a.in[3] + (size_t)l * 2048;
        float* SP = w_SIDE + (size_t)l * SD_LAYER + SD_SP; float* YB = w_SIDE + (size_t)l * SD_LAYER + SD_YB; float* MO = w_SIDE + (size_t)l * SD_LAYER + SD_MO;
        float* UU = w_SIDE + (size_t)l * SD_LAYER + SD_UU; float* DD = w_SIDE + (size_t)l * SD_LAYER + SD_DD;
        {
            side::prep_norm(lds, (l == 0) ? x : w_XS, (l == 0) ? (size_t)SEQ * D : (size_t)D, nullptr, a.in[1] + (size_t)l * D, false, nullptr, nullptr, nullptr, nullptr);
            const float* w_in = a.in[2] + (size_t)l * D * IN_COLS;
            for (int it = bx; it < 320; it += G) side::gemv_item(lds, w_in, IN_COLS, (it & 3) * 256, 1536 + (it >> 2) * 64, SP, IN_COLS);
        }
        {
            pg8::Gemm g{w_XN, w_win, D, D, M, IN_COLS, D}; pg8::StaticOrder S; S.init(M, IN_COLS, G, bx);
            Epi<1> E; E.p = EpiP{}; E.p.ssq = w_ssq + (size_t)(2 * l) * M; E.p.PA = w_PA; E.p.PB = w_PB; E.p.rope = w_rope;
            pg8::gemm_phase(lds, g, S, E);
        }
        xcd_barrier(xbar); STAMP(l * 8 + 1);
        if (bx < 64) {
            {
                PHASE_IDS();
                const int r = wave, hh = lane >> 4, sub = lane & 15;
                const float* sp = SP + (size_t)r * IN_COLS;
                float dq = 0.f;
#pragma unroll
                for (int j = 0; j < 8; ++j) dq += sp[1536 + hh * 128 + sub * 8 + j] * sp[2048 + hh * 128 + sub * 8 + j];
#pragma unroll
                for (int o = 1; o < 16; o <<= 1) dq += shx(dq, o);
                const float w0 = dq * 0.08838834764831845f;
                float ov[16]; float s = 0.f;
#pragma unroll
                for (int j = 0; j < 16; ++j) { ov[j] = w0 * sp[2560 + hh * 256 + sub * 16 + j]; s += ov[j]; }
#pragma unroll
                for (int o = 1; o < 16; o <<= 1) s += shx(s, o);
                const float mu = s * (1.f / 256.f); float q = 0.f;
#pragma unroll
                for (int j = 0; j < 16; ++j) { ov[j] -= mu; q += ov[j] * ov[j]; }
#pragma unroll
                for (int o = 1; o < 16; o <<= 1) q += shx(q, o);
                const float rstd = 1.f / sqrtf(q * (1.f / 256.f) + EPS);
                const float* rn = a.in[5] + (size_t)l * D;
                LAS float* A = (LAS float*)lds;
#pragma unroll
                for (int j = 0; j < 16; ++j) { const int e = hh * 256 + sub * 16 + j; A[e * 8 + r] = ov[j] * rstd * rn[e] * side::silu_(sp[3584 + e]); }
                __syncthreads();
            }
            const float* rw = a.in[6] + (size_t)l * D * D;
            for (int it = bx; it < 64; it += G) side::gemv_item(lds, rw, D, (it & 3) * 256, (it >> 2) * 64, YB, D);
        }
        for (int j = vcu; j < 256; j += G) ret::item(j >> 5, (j >> 3) & 3, j & 7, w_PA, (LAS char*)lds);
        STAMP(20 + l);
        for (int j = vcu; j < 256; j += G) {
            const int bh = j >> 2, s = j & 3;
            sb::unit(bh >> 3, bh & 7, 15 - s, w_PA, (LAS char*)lds);
            sb::unit(bh >> 3, bh & 7, 8 + s, w_PA, (LAS char*)lds);
            sb::unit(bh >> 3, bh & 7, 7 - s, w_PA, (LAS char*)lds);
            sb::unit(bh >> 3, bh & 7, s, w_PA, (LAS char*)lds);
        }
        xcd_barrier(xbar); STAMP(l * 8 + 2);
        if (bx < 64) {
            {
                PHASE_IDS();
                LAS float* A = (LAS float*)lds;
#pragma unroll 8
                for (int i = tid; i < 8 * D; i += 512) { const int r = i >> 10, k = i & 1023; A[k * 8 + r] = side::sigm_(SP[(size_t)r * IN_COLS + 5632 + k] + bgate[1024 + k]) * YB[r * D + k]; }
                __syncthreads();
            }
            const float* w_o = a.in[7] + (size_t)l * D * D;
            for (int it = bx; it < 64; it += G) side::gemv_item(lds, w_o, D, (it & 3) * 256, (it >> 2) * 64, MO, D);
        }
        {
            PHASE_IDS();
            const float* rg = a.in[5] + (size_t)l * D;
            auto norm_row = [&](bf16_t* op, const u32x4 o0, const u32x4 o1, const u32x4 g0, const u32x4 g1) {
                float v[16], gv[16];
                v[0] = bf_lo(o0.x); v[1] = bf_hi(o0.x); v[2] = bf_lo(o0.y); v[3] = bf_hi(o0.y); v[4] = bf_lo(o0.z); v[5] = bf_hi(o0.z); v[6] = bf_lo(o0.w); v[7] = bf_hi(o0.w);
                v[8] = bf_lo(o1.x); v[9] = bf_hi(o1.x); v[10] = bf_lo(o1.y); v[11] = bf_hi(o1.y); v[12] = bf_lo(o1.z); v[13] = bf_hi(o1.z); v[14] = bf_lo(o1.w); v[15] = bf_hi(o1.w);
                gv[0] = bf_lo(g0.x); gv[1] = bf_hi(g0.x); gv[2] = bf_lo(g0.y); gv[3] = bf_hi(g0.y); gv[4] = bf_lo(g0.z); gv[5] = bf_hi(g0.z); gv[6] = bf_lo(g0.w); gv[7] = bf_hi(g0.w);
                gv[8] = bf_lo(g1.x); gv[9] = bf_hi(g1.x); gv[10] = bf_lo(g1.y); gv[11] = bf_hi(g1.y); gv[12] = bf_lo(g1.z); gv[13] = bf_hi(g1.z); gv[14] = bf_lo(g1.w); gv[15] = bf_hi(g1.w);
                float s = 0.f;
#pragma unroll
                for (int k = 0; k < 16; ++k) s += v[k];
#pragma unroll
                for (int o = 1; o < 16; o <<= 1) s += shx(s, o);
                const float mu = s * (1.f / 256.f); float q = 0.f;
#pragma unroll
                for (int k = 0; k < 16; ++k) { v[k] -= mu; q += v[k] * v[k]; }
#pragma unroll
                for (int o = 1; o < 16; o <<= 1) q += shx(q, o);
                const float rstd = __builtin_amdgcn_rsqf(q * (1.f / 256.f) + EPS);
                const f32x4* rgp = (const f32x4*)(rg + 16 * lane);
                unsigned w[8];
#pragma unroll
                for (int k4 = 0; k4 < 4; ++k4) { const f32x4 gg = rgp[k4];
                    float y[4];
#pragma unroll
                    for (int k = 0; k < 4; ++k) { const float gx = gv[4 * k4 + k]; y[k] = v[4 * k4 + k] * rstd * gg[k] * gx * sigmoidf_(gx); }
                    w[2 * k4] = pk_bf16(y[0], y[1]); w[2 * k4 + 1] = pk_bf16(y[2], y[3]); }
                *(u32x4*)op = (u32x4){w[0], w[1], w[2], w[3]}; *(u32x4*)(op + 8) = (u32x4){w[4], w[5], w[6], w[7]};
            };
            for (int m = gw; m < M; m += 4 * NGW) {
                u32x4 o0[4], o1[4], g0[4], g1[4];
#pragma unroll
                for (int u = 0; u < 4; ++u) { const int mm = m + u * NGW; const bf16_t* op = w_PA + (size_t)mm * PA_LD + 2560 + 16 * lane; const bf16_t* gp = w_PB + (size_t)mm * PB_LD + 16 * lane;
                    o0[u] = *(const u32x4*)op; o1[u] = *(const u32x4*)(op + 8); g0[u] = *(const u32x4*)gp; g1[u] = *(const u32x4*)(gp + 8); }
                __builtin_amdgcn_sched_barrier(0);
#pragma unroll
                for (int u = 0; u < 4; ++u) norm_row(w_PA + (size_t)(m + u * NGW) * PA_LD + 2560 + 16 * lane, o0[u], o1[u], g0[u], g1[u]);
            }
            __syncthreads();
            pg8::Gemm g{w_PA, w_wcat, PA_LD, 1536, M, D, 512}; pg8::StaticOrder S; S.init(M, D, G, bx);
            Epi<2> E; E.p = EpiP{}; E.p.PA = w_PA; E.p.PB = w_PB; E.p.bgate = bgate;
            pg8::gemm_phase(lds, g, S, E);
        }
        xcd_barrier(xbar); STAMP(l * 8 + 3);
        {
            pg8::Gemm g{w_PA + 2560, w_wcat + 512, PA_LD, 1536, M, D, D}; pg8::StaticOrder S; S.init(M, D, G, bx);
            Epi<3> E; E.p = EpiP{}; E.p.PA = w_PA; E.p.PB = w_PB; E.p.bgate = bgate;
            pg8::gemm_phase(lds, g, S, E);
        }
        xcd_barrier(xbar); STAMP(l * 8 + 4);
        {
            side::prep_norm(lds, (l == 0) ? x : w_XS, (l == 0) ? (size_t)SEQ * D : (size_t)D, MO, a.in[8] + (size_t)l * D, bx == 0, out, w_XN, w_ssq + (size_t)(2 * l + 1) * M, nullptr);
            const float* w_up = a.in[9] + (size_t)l * D * U_LD;
            for (int it = bx; it < 352; it += G) side::gemv_item(lds, w_up, U_LD, (it & 3) * 256, (it >> 2) * 64, UU, U_LD);
        }
        {
            PHASE_IDS();
            convert_ffn(a, l, lds, gw, NGW, wave, lane);
            __syncthreads();
            pg8::Gemm g{w_PA + 1536, w_wo, PA_LD, D, M, D, D}; pg8::StaticOrder S; S.init(M, D, G, bx);
            Epi<4> E; E.p = EpiP{}; E.p.xin = (l == 0) ? x : out; E.p.xout = out; E.p.XN = w_XN; E.p.gnext = a.in[8] + (size_t)l * D; E.p.ssq_out = w_ssq + (size_t)(2 * l + 1) * M; E.p.wxn = 1;
            pg8::gemm_phase(lds, g, S, E);
        }
        xcd_barrier(xbar); STAMP(l * 8 + 5);
        const int b5 = (G > 176) ? bx - 176 : bx, nb5 = (G > 176) ? G - 176 : G;
        if (b5 >= 0) {
            {
                PHASE_IDS();
                const float* cw2 = a.in[10] + (size_t)l * 3 * FF + 2 * FF; const float* cbb = a.in[11] + (size_t)l * FF;
                LAS float* A = (LAS float*)lds;
#pragma unroll 11
                for (int i = tid; i < 8 * FF; i += 512) { const int r = i / FF, k = i - r * FF; A[k * 8 + r] = side::silu_(cw2[k] * UU[r * U_LD + k] + cbb[k]) * UU[r * U_LD + FF + k]; }
                __syncthreads();
            }
            const float* w_dn = a.in[12] + (size_t)l * FF * D;
            for (int it = b5; it < 176; it += nb5) side::gemv_item(lds, w_dn, D, (it / 16) * 256, (it & 15) * 64, DD, D);
        }
        {
            PHASE_IDS();
            if (l == 0) { convert_mixer(a, 1, lds, gw, NGW, wave, lane); __syncthreads(); }
            pg8::Gemm g{w_XN, w_wup, D, D, M, U_LD, D}; pg8::StaticOrder S; S.init(M, U_LD, G, bx, true);
            Epi<6> E; E.p = EpiP{}; E.p.ssq = w_ssq + (size_t)(2 * l + 1) * M; E.p.H = w_U; E.p.cw = a.in[10] + (size_t)l * 3 * FF; E.p.cb = a.in[11] + (size_t)l * FF;
            E.p.xch = (LAS float*)(lds + 131072 + 1024);
            pg8::gemm_phase(lds, g, S, E);
        }
        xcd_barrier(xbar); STAMP(l * 8 + 6); STAMP(l * 8 + 7);
        if (bx == 0)
            side::prep_norm(lds, out, (size_t)SEQ * D, DD, (l == 0) ? a.in[1] + D : a.in[13], true, out, w_XN, w_ssq + (size_t)(2 * l + 2) * M, w_XS, l == 1);
        if (l == 0) {
            pg8::Gemm g{w_U, w_wdn, FF, FF, M, D, FF}; pg8::StaticOrder S; S.init(M, D, G, bx);
            Epi<4> E; E.p = EpiP{}; E.p.xin = out; E.p.xout = out; E.p.XN = w_XN; E.p.gnext = a.in[1] + D; E.p.ssq_out = w_ssq + (size_t)2 * M; E.p.wxn = 1;
            pg8::gemm_phase(lds, g, S, E);
            xcd_barrier(xbar); STAMP(8);
        } else {
            pg8::Gemm g{w_U, w_wdn, FF, FF, M, D, FF}; pg8::StaticOrder S; S.init(M, D, G, bx);
            Epi<7> E; E.p = EpiP{}; E.p.xin = out; E.p.xout = out; E.p.gnext = a.in[13]; E.p.ssq_out = w_ssq + (size_t)4 * M; E.p.cnt = (unsigned*)(ws + WS_CNT);
            pg8::gemm_phase(lds, g, S, E);
            STAMP(16);
        }
    }
#ifdef DIAG
    xcd_barrier(xbar);
#endif
    STAMP(31);
#ifdef DIAG
    __syncthreads();
    if (bx == 0 && threadIdx.x == 0) {
        asm volatile("s_waitcnt vmcnt(0)" ::: "memory");
        const float tA = (float)(ts_[DIAG_A1] - ts_[DIAG_A0]) * 0.01f, tB = (float)(ts_[DIAG_B1] - ts_[DIAG_B0]) * 0.01f;
        out[3 * 1024 + 7] += tA * 1e-3f;
        for (int i = 0; i < 2048; ++i) out[1024 + i] += tB * 1e-4f;
    }
#endif
}

#undef ws
#undef w_ssq
#undef w_rope
#undef w_win
#undef w_wcat
#undef w_wo
#undef w_XN
#undef w_PA
#undef w_PB
#undef w_U
#undef w_wup
#undef w_wdn
#undef w_SIDE
#undef w_XS
constexpr int LDS_BYTES = 131072 + 1024 + 4096;
static_assert(ret::LDS_BYTES <= 131072 && sb::LDS_BYTES <= 131072 && pg8::STAGE_BYTES <= 131072, "LDS map");

extern "C" void kernel_launch(void* const* d_in, const int* in_sizes, int n_in, void* d_out, int out_size, void* d_ws, size_t ws_size, hipStream_t stream) {
    static int grid = 0;
    if (grid == 0) {
        int dev = 0, cus = 0, per_cu = 0;
        hipGetDevice(&dev);
        hipDeviceGetAttribute(&cus, hipDeviceAttributeMultiprocessorCount, dev);
        hipFuncSetAttribute((const void*)fwd_kernel, hipFuncAttributeMaxDynamicSharedMemorySize, LDS_BYTES);
        hipOccupancyMaxActiveBlocksPerMultiprocessor(&per_cu, (const void*)fwd_kernel, 512, LDS_BYTES);
        (void)hipGetLastError();
        if (per_cu < 1) per_cu = 1;
        if (cus < 1) cus = 256;
        grid = cus;
        if (ws_size < WS_END) fprintf(stderr, "kernel_launch: workspace too small: %zu < %zu\n", ws_size, (size_t)WS_END);
    }
    Args a{};
    for (int i = 0; i < 14; ++i) a.in[i] = (const float*)d_in[i];
    a.out = (float*)d_out; a.ws = (unsigned char*)d_ws;
    void* args[] = {&a};
    hipError_t e = hipLaunchCooperativeKernel((const void*)fwd_kernel, dim3(grid), dim3(512), args, LDS_BYTES, stream);
    if (e != hipSuccess) fprintf(stderr, "cooperative launch failed: %s (grid %d)\n", hipGetErrorString(e), grid);
}
```

```cpp
#include <hip/hip_runtime.h>
#include <hip/hip_cooperative_groups.h>
#include <cstdio>
#include <cstdint>
namespace cg = cooperative_groups;

#define LAS __attribute__((address_space(3)))
typedef unsigned short bf16_t;
typedef short bf16x8 __attribute__((ext_vector_type(8)));
typedef short s16x4 __attribute__((ext_vector_type(4)));
typedef float f32x2 __attribute__((ext_vector_type(2)));
typedef float f32x4 __attribute__((ext_vector_type(4)));
typedef float f32x16 __attribute__((ext_vector_type(16)));
typedef unsigned u32x4 __attribute__((ext_vector_type(4)));
typedef unsigned u32x2 __attribute__((ext_vector_type(2)));

constexpr int M = 32768, D = 1024, SEQ = 4096, FF = 2816;
constexpr int IN_COLS = 6656, PA_LD = 3584, PB_LD = 3072, U_LD = 5632;
constexpr float EPS = 1e-6f;
constexpr float LOG2E = 1.4426950408889634f;

constexpr size_t MiB = 1u << 20;
constexpr size_t WS_SSQ = 0;
constexpr size_t WS_ROPE = 1 * MiB;
constexpr size_t WS_WIN = 3 * MiB;
constexpr size_t WS_WCAT = 16 * MiB;
constexpr size_t WS_WO = 19 * MiB;
constexpr size_t WS_XN = 21 * MiB;
constexpr size_t WS_PROJ = 85 * MiB;
constexpr size_t WS_PB = WS_PROJ + 224 * MiB;
constexpr size_t WS_WUP = WS_PROJ + 352 * MiB;
constexpr size_t WS_WDN = WS_WUP + 11 * MiB;
constexpr size_t WS_END0 = WS_PROJ + 416 * MiB;
constexpr size_t WS_SIDE = WS_END0;
constexpr int SD_SP = 0, SD_YB = 8 * 6656, SD_MO = SD_YB + 8 * 1024, SD_UU = SD_MO + 8 * 1024, SD_DD = SD_UU + 8 * 5632, SD_LAYER = SD_DD + 8 * 1024;
constexpr size_t WS_XS = WS_SIDE + (size_t)2 * SD_LAYER * 4;
constexpr size_t WS_BAR = WS_XS + 262144;
constexpr size_t WS_CNT = WS_BAR + 16384;
constexpr size_t WS_END = WS_CNT + 32768;

__device__ __forceinline__ unsigned pk_bf16(float lo, float hi) {
    typedef __bf16 b2 __attribute__((ext_vector_type(2))); f32x2 v = {lo, hi}; b2 b = __builtin_convertvector(v, b2); return __builtin_bit_cast(unsigned, b);
}
__device__ __forceinline__ float bf_lo(unsigned w) { return __uint_as_float(w << 16); }
__device__ __forceinline__ float bf_hi(unsigned w) { return __uint_as_float(w & 0xffff0000u); }
__device__ __forceinline__ float sigmoidf_(float x) { return __builtin_amdgcn_rcpf(1.f + __builtin_amdgcn_exp2f(-x * LOG2E)); }
__device__ __forceinline__ float shx(float v, int o) {
    int l = (int)__builtin_amdgcn_mbcnt_hi(~0u, __builtin_amdgcn_mbcnt_lo(~0u, 0u)); asm volatile("" : "+v"(l));
    return __int_as_float(__builtin_amdgcn_ds_bpermute((l ^ o) << 2, __float_as_int(v)));
}
__device__ __forceinline__ float wave_sum(float v) {
#pragma unroll
    for (int o = 1; o < 64; o <<= 1) v += shx(v, o);
    return v;
}

namespace pg8 {
constexpr int BM = 256, BK = 64, HALF = 128, HTB = HALF * BK * 2, STAGE_BYTES = 8 * HTB, NXCD = 8, WGM = 8;
__host__ __device__ __forceinline__ int lds_byte(int r, int c) { const int st = (r >> 4) * 2 + (c >> 5), rr = r & 15, cc = c & 31, ob = rr * 64 + cc * 2; return st * 1024 + (ob ^ (((ob >> 9) & 1) << 5)); }
__host__ __device__ __forceinline__ void stage_rc(int b, int& R, int& C) { const int st = b / 1024, sb = b % 1024, swz = sb ^ (((sb >> 9) & 1) << 5); R = (st >> 1) * 16 + swz / 64; C = (st & 1) * 32 + (swz % 64) / 2; }
__host__ __device__ __forceinline__ int perm32(int rho) { const int n = rho >> 4, i = rho & 15; return 8 * (i >> 2) + 4 * n + (i & 3); }

struct Unit { int pm, pn, arow; };
struct Gemm { const bf16_t* A; const bf16_t* Bt; int lda, ldb, M, N, K; };

struct StaticOrder {
    int nM, nN, nwg, G, c; bool ovl;
    __device__ void init(int M_, int N_, int G_, int c_, bool ovl_ = false) { ovl = ovl_; nM = ovl ? (M_ / 4096) * 17 : M_ / BM; nN = N_ / BM; nwg = nM * nN; G = G_; c = c_; }
    __device__ bool next(int i, Unit& u) const {
        const long L = (long)i * G + c; if (L >= nwg) return false;
        int wgid = (int)L; { const int q = nwg / NXCD, r = nwg % NXCD, xcd = wgid % NXCD, off = wgid / NXCD; wgid = (xcd < r ? xcd * (q + 1) : r * (q + 1) + (xcd - r) * q) + off; }
        const int nig = WGM * nN, gid = wgid / nig, fm = gid * WGM, gsz = (nM - fm) < WGM ? (nM - fm) : WGM;
        u.pm = fm + ((wgid % nig) % gsz); u.pn = (wgid % nig) / gsz;
        u.arow = ovl ? (u.pm / 17) * 4096 + 254 * (u.pm % 17) - 2 : u.pm * BM; return true;
    }
};

template <class Epi>
__device__ __forceinline__ void gemm_phase(LAS unsigned char* lds, const Gemm g, const StaticOrder& S, const Epi& E) {
    int tid_ = threadIdx.x; asm volatile("" : "+v"(tid_));
    const int tid = tid_, wid = __builtin_amdgcn_readfirstlane(tid >> 6), lane = tid & 63, wr = wid >> 2, wc = wid & 3, fr = lane & 15, fq = lane >> 4;
    const int K = g.K, nt = K / BK;
    unsigned voffA[2], voffB[2];
#pragma unroll
    for (int i = 0; i < 2; ++i) { int R, C; stage_rc(tid * 16 + i * 8192, R, C); const int Rb = (R & ~31) + perm32(R & 31);
        voffA[i] = (unsigned)(R * g.lda + C) * 2u; voffB[i] = (unsigned)(Rb * g.ldb + C) * 2u; }
    const size_t kstep = (size_t)(BK * 2);
    const size_t hstepA = (size_t)HALF * g.lda * 2, hstepB = (size_t)HALF * g.ldb * 2;
    const size_t tstepB = 2 * hstepB;
    const unsigned ldsw = (unsigned)wid * 1024u;
    const int aoff = lds_byte(wr * 64 + fr, fq * 8), boff = lds_byte(wc * 32 + fr, fq * 8);
#define PG8_SA(b, h) (((b) * 2 + (h)) * HTB)
#define PG8_SB(b, h) ((4 + (b) * 2 + (h)) * HTB)
#define PG8_STAGE(bufoff, gbase, voff) do { _Pragma("unroll") for (int _i = 0; _i < 2; ++_i) \
        __builtin_amdgcn_global_load_lds((const unsigned*)((const char*)(gbase) + (voff)[_i]), (LAS unsigned*)(lds + (bufoff) + ldsw + _i * 8192), 16, 0, 0); } while (0)
#define PG8_LDA(dst, b, h) do { _Pragma("unroll") for (int m = 0; m < 4; ++m) _Pragma("unroll") for (int k = 0; k < 2; ++k) dst[m][k] = *(const LAS bf16x8*)(lds + PG8_SA(b, h) + aoff + m * 2048 + k * 1024); } while (0)
#define PG8_LDB(dst, b, h) do { _Pragma("unroll") for (int n = 0; n < 2; ++n) _Pragma("unroll") for (int k = 0; k < 2; ++k) dst[n][k] = *(const LAS bf16x8*)(lds + PG8_SB(b, h) + boff + n * 2048 + k * 1024); } while (0)
#define PG8_MMA(ai, bj, At, Bt) do { __builtin_amdgcn_s_setprio(1); _Pragma("unroll") for (int m = 0; m < 4; ++m) _Pragma("unroll") for (int n = 0; n < 2; ++n) _Pragma("unroll") for (int k = 0; k < 2; ++k) \
        acc[ai][bj][m][n] = __builtin_amdgcn_mfma_f32_16x16x32_bf16(Bt[n][k], At[m][k], acc[ai][bj][m][n], 0, 0, 0); __builtin_amdgcn_s_setprio(0); } while (0)
#define PG8_WAIT_V(n) asm volatile("s_waitcnt vmcnt(" #n ")" ::: "memory")
#define PG8_WAIT_L(n) asm volatile("s_waitcnt lgkmcnt(" #n ")" ::: "memory")
#define PG8_BAR __builtin_amdgcn_s_barrier()
#define PG8_SCHED __builtin_amdgcn_sched_barrier(0)
    Unit cur, nxt; int ui = 0;
    if (!S.next(0, cur)) return;
    f32x4 acc[2][2][4][2];
#pragma unroll
    for (int a = 0; a < 2; ++a)
#pragma unroll
        for (int b = 0; b < 2; ++b)
#pragma unroll
            for (int m = 0; m < 4; ++m)
#pragma unroll
                for (int n = 0; n < 2; ++n) acc[a][b][m][n] = (f32x4){0.f, 0.f, 0.f, 0.f};
    bf16x8 At[4][2], B0[2][2], B1[2][2];
    const char* cA = (const char*)g.A + (ptrdiff_t)cur.arow * (ptrdiff_t)(g.lda * 2); const char* cB = (const char*)g.Bt + (size_t)cur.pn * tstepB;
    PG8_STAGE(PG8_SB(0, 0), cB, voffB); PG8_STAGE(PG8_SB(0, 1), cB + hstepB, voffB); PG8_STAGE(PG8_SA(0, 0), cA, voffA); PG8_STAGE(PG8_SA(0, 1), cA + hstepA, voffA);
    if (wr == 1) PG8_BAR;
    PG8_WAIT_V(2); PG8_BAR;
    PG8_STAGE(PG8_SB(1, 0), cB + kstep, voffB); PG8_STAGE(PG8_SA(1, 0), cA + kstep, voffA); PG8_STAGE(PG8_SB(1, 1), cB + hstepB + kstep, voffB);
    PG8_WAIT_V(6); PG8_BAR;
    for (;;) {
        const bool has_next = S.next(ui + 1, nxt);
        const char* nA = has_next ? (const char*)g.A + (ptrdiff_t)nxt.arow * (ptrdiff_t)(g.lda * 2) : cA; const char* nB = has_next ? (const char*)g.Bt + (size_t)nxt.pn * tstepB : cB;
        for (int t = 0; t < nt; t += 2) {
            const bool last = (t == nt - 2);
            const char* a1 = cA + (size_t)(t + 1) * kstep;
            const char* a2 = last ? nA : cA + (size_t)(t + 2) * kstep; const char* b2 = last ? nB : cB + (size_t)(t + 2) * kstep;
            const char* a3 = a2 + kstep; const char* b3 = b2 + kstep;
            PG8_LDB(B0, 0, 0); PG8_LDB(B1, 0, 1); PG8_SCHED; PG8_LDA(At, 0, 0); PG8_STAGE(PG8_SA(1, 1), a1 + hstepA, voffA);
            PG8_WAIT_V(8); PG8_WAIT_L(0); PG8_BAR; PG8_MMA(0, 0, At, B0); PG8_MMA(0, 1, At, B1); PG8_BAR; PG8_SCHED;
            PG8_LDA(At, 0, 1); PG8_STAGE(PG8_SB(0, 0), b2, voffB); PG8_STAGE(PG8_SB(0, 1), b2 + hstepB, voffB); PG8_STAGE(PG8_SA(0, 0), a2, voffA);
            PG8_WAIT_V(8); PG8_WAIT_L(0); PG8_BAR; PG8_MMA(1, 0, At, B0); PG8_MMA(1, 1, At, B1); PG8_BAR; PG8_SCHED;
            PG8_LDB(B0, 1, 0); PG8_LDB(B1, 1, 1); PG8_SCHED; PG8_LDA(At, 1, 0); PG8_STAGE(PG8_SA(0, 1), a2 + hstepA, voffA);
            PG8_WAIT_V(8); PG8_WAIT_L(0); PG8_BAR; PG8_MMA(0, 0, At, B0); PG8_MMA(0, 1, At, B1); PG8_BAR; PG8_SCHED;
            PG8_LDA(At, 1, 1); PG8_STAGE(PG8_SB(1, 0), b3, voffB); PG8_STAGE(PG8_SB(1, 1), b3 + hstepB, voffB); PG8_STAGE(PG8_SA(1, 0), a3, voffA);
            PG8_WAIT_V(8); PG8_WAIT_L(0); PG8_BAR; PG8_MMA(1, 0, At, B0); PG8_MMA(1, 1, At, B1); PG8_BAR; PG8_SCHED;
        }
        if (wr == 0) PG8_BAR;
        E(acc, cur, wr, wc, fr, fq);
        if (!has_next) break;
#pragma unroll
        for (int a = 0; a < 2; ++a)
#pragma unroll
            for (int b = 0; b < 2; ++b)
#pragma unroll
                for (int m = 0; m < 4; ++m)
#pragma unroll
                    for (int n = 0; n < 2; ++n) acc[a][b][m][n] = (f32x4){0.f, 0.f, 0.f, 0.f};
        cur = nxt; cA = nA; cB = nB; ++ui;
        if (wr == 1) PG8_BAR;
    }
    PG8_WAIT_V(0);
    PG8_BAR;
#undef PG8_SA
#undef PG8_SB
#undef PG8_STAGE
#undef PG8_LDA
#undef PG8_LDB
#undef PG8_MMA
#undef PG8_WAIT_V
#undef PG8_WAIT_L
#undef PG8_BAR
#undef PG8_SCHED
}
}

struct EpiP {
    const float* ssq;
    bf16_t* PA; bf16_t* PB;
    const f32x4* rope;
    const float* bgate;
    const float* xin; float* xout; bf16_t* XN; const float* gnext; float* ssq_out; int wxn;
    bf16_t* U;
    unsigned* cnt;
    bf16_t* H; const float* cw; const float* cb; LAS float* xch;
};
template <int MODE> struct Epi {
    EpiP p;
    __device__ __forceinline__ void operator()(const f32x4 (&acc)[2][2][4][2], const pg8::Unit& u, int wr, int wc, int fr, int fq) const {
        asm volatile("" : "+v"(fr), "+v"(fq));
        const int pn = u.pn;
        const int rowb = u.pm * 256 + wr * 64 + fr;
        const int colw = wc * 32 + 8 * fq;
        if constexpr (MODE == 1) {
            bf16_t* O; int ldc, cb;
            if (pn < 14) { O = p.PA; ldc = PA_LD; cb = pn * 256; } else { O = p.PB; ldc = PB_LD; cb = (pn - 14) * 256; }
            const int kind = (pn < 2) ? 1 : (pn >= 6 && pn < 8) ? 2 : (pn >= 8 && pn < 10) ? 3 : 0;
            float ssv[2][4]; f32x4 rc[2][4][2];
#pragma unroll
            for (int ai = 0; ai < 2; ++ai)
#pragma unroll
                for (int m = 0; m < 4; ++m) { const int row = rowb + ai * 128 + m * 16; ssv[ai][m] = p.ssq[row];
                    if (kind >= 2) { const f32x4* rp = p.rope + ((size_t)(row & 4095) * 64 + wc * 16 + 4 * fq) / 2; rc[ai][m][0] = rp[0]; rc[ai][m][1] = rp[1]; } }
            __builtin_amdgcn_sched_barrier(0);
#pragma unroll
            for (int ai = 0; ai < 2; ++ai)
#pragma unroll
                for (int m = 0; m < 4; ++m) {
                    const int row = rowb + ai * 128 + m * 16;
                    float sc = __builtin_amdgcn_rsqf(ssv[ai][m] * (1.f / 1024.f) + EPS);
                    if (kind == 1) sc *= 0.125f * LOG2E;
#pragma unroll
                    for (int bj = 0; bj < 2; ++bj) {
                        f32x4 v0 = acc[ai][bj][m][0] * sc, v1 = acc[ai][bj][m][1] * sc;
                        if (kind >= 2) {
                            const int head = (pn - (kind == 2 ? 6 : 8)) * 2 + bj;
                            const float lg = __builtin_log2f(1.f - __builtin_exp2f(-5.f - (float)head));
                            const float e = (float)((row & 127) + 1) * lg;
                            const float dsc = (kind == 2) ? __builtin_amdgcn_exp2f(e) * 0.08838834764831845f : __builtin_amdgcn_exp2f(-e);
                            const f32x4 c01 = rc[ai][m][0], c23 = rc[ai][m][1];
                            f32x4 w0, w1;
                            w0[0] = (v0[0] * c01[0] - v0[1] * c01[1]) * dsc; w0[1] = (v0[0] * c01[1] + v0[1] * c01[0]) * dsc;
                            w0[2] = (v0[2] * c01[2] - v0[3] * c01[3]) * dsc; w0[3] = (v0[2] * c01[3] + v0[3] * c01[2]) * dsc;
                            w1[0] = (v1[0] * c23[0] - v1[1] * c23[1]) * dsc; w1[1] = (v1[0] * c23[1] + v1[1] * c23[0]) * dsc;
                            w1[2] = (v1[2] * c23[2] - v1[3] * c23[3]) * dsc; w1[3] = (v1[2] * c23[3] + v1[3] * c23[2]) * dsc;
                            v0 = w0; v1 = w1;
                        }
                        u32x4 w; w.x = pk_bf16(v0[0], v0[1]); w.y = pk_bf16(v0[2], v0[3]); w.z = pk_bf16(v1[0], v1[1]); w.w = pk_bf16(v1[2], v1[3]);
                        *(u32x4*)(O + (size_t)row * ldc + cb + bj * 128 + colw) = w;
                    }
                }
        } else if constexpr (MODE == 2 || MODE == 3) {
            const int goff = (MODE == 2) ? 1024 : 2048, boff = (MODE == 2) ? 0 : 1024;
            f32x4 bb[2][2];
#pragma unroll
            for (int bj = 0; bj < 2; ++bj) { const int col = pn * 256 + bj * 128 + colw; bb[bj][0] = *(const f32x4*)(p.bgate + boff + col); bb[bj][1] = *(const f32x4*)(p.bgate + boff + col + 4); }
#pragma unroll
            for (int aih = 0; aih < 4; ++aih) {
              const int ai = aih >> 1, mb = (aih & 1) * 2;
              u32x4 gwv[4][2], twv[4][2];
#pragma unroll
              for (int m = mb; m < mb + 2; ++m)
#pragma unroll
                for (int bj = 0; bj < 2; ++bj) { const int row = rowb + ai * 128 + m * 16, col = pn * 256 + bj * 128 + colw;
                    gwv[m][bj] = *(const u32x4*)(p.PB + (size_t)row * PB_LD + goff + col);
                    if constexpr (MODE == 3) twv[m][bj] = *(const u32x4*)(p.PA + (size_t)row * PA_LD + 512 + col); }
              __builtin_amdgcn_sched_barrier(0);
#pragma unroll
                for (int m = mb; m < mb + 2; ++m) {
                    const int row = rowb + ai * 128 + m * 16;
#pragma unroll
                    for (int bj = 0; bj < 2; ++bj) {
                        const int col = pn * 256 + bj * 128 + colw;
                        const u32x4 gw = gwv[m][bj];
                        f32x4 g0, g1;
                        g0[0] = bf_lo(gw.x); g0[1] = bf_hi(gw.x); g0[2] = bf_lo(gw.y); g0[3] = bf_hi(gw.y);
                        g1[0] = bf_lo(gw.z); g1[1] = bf_hi(gw.z); g1[2] = bf_lo(gw.w); g1[3] = bf_hi(gw.w);
                        g0 += bb[bj][0]; g1 += bb[bj][1];
                        f32x4 v0 = acc[ai][bj][m][0], v1 = acc[ai][bj][m][1];
#pragma unroll
                        for (int k = 0; k < 4; ++k) { v0[k] *= sigmoidf_(g0[k]); v1[k] *= sigmoidf_(g1[k]); }
                        if constexpr (MODE == 3) {
                            const u32x4 tw = twv[m][bj];
                            v0[0] += bf_lo(tw.x); v0[1] += bf_hi(tw.x); v0[2] += bf_lo(tw.y); v0[3] += bf_hi(tw.y);
                            v1[0] += bf_lo(tw.z); v1[1] += bf_hi(tw.z); v1[2] += bf_lo(tw.w); v1[3] += bf_hi(tw.w);
                        }
                        u32x4 w; w.x = pk_bf16(v0[0], v0[1]); w.y = pk_bf16(v0[2], v0[3]); w.z = pk_bf16(v1[0], v1[1]); w.w = pk_bf16(v1[2], v1[3]);
                        *(u32x4*)(p.PA + (size_t)row * PA_LD + (MODE == 2 ? 512 : 1536) + col) = w;
                    }
                }
            }
        } else if constexpr (MODE == 4) {
            f32x4 gg[2][2];
#pragma unroll
            for (int bj = 0; bj < 2; ++bj) { const int col = pn * 256 + bj * 128 + colw; gg[bj][0] = *(const f32x4*)(p.gnext + col); gg[bj][1] = *(const f32x4*)(p.gnext + col + 4); }
#pragma unroll
            for (int ai = 0; ai < 2; ++ai) {
              f32x4 xv[4][2][2];
#pragma unroll
              for (int m = 0; m < 4; ++m)
#pragma unroll
                for (int bj = 0; bj < 2; ++bj) { const size_t off = (size_t)(rowb + ai * 128 + m * 16) * D + pn * 256 + bj * 128 + colw;
                    xv[m][bj][0] = *(const f32x4*)(p.xin + off); xv[m][bj][1] = *(const f32x4*)(p.xin + off + 4); }
              __builtin_amdgcn_sched_barrier(0);
#pragma unroll
                for (int m = 0; m < 4; ++m) {
                    const int row = rowb + ai * 128 + m * 16;
                    const bool keep = (row & 4095) != 0;
                    float ss = 0.f;
#pragma unroll
                    for (int bj = 0; bj < 2; ++bj) {
                        const int col = pn * 256 + bj * 128 + colw;
                        const size_t off = (size_t)row * D + col;
                        f32x4 x0 = xv[m][bj][0], x1 = xv[m][bj][1];
                        x0 += acc[ai][bj][m][0]; x1 += acc[ai][bj][m][1];
                        if (keep) { *(f32x4*)(p.xout + off) = x0; *(f32x4*)(p.xout + off + 4) = x1; }
                        ss += (x0[0] * x0[0] + x0[1] * x0[1]) + (x0[2] * x0[2] + x0[3] * x0[3]) + (x1[0] * x1[0] + x1[1] * x1[1]) + (x1[2] * x1[2] + x1[3] * x1[3]);
                        x0 *= gg[bj][0]; x1 *= gg[bj][1];
                        u32x4 w; w.x = pk_bf16(x0[0], x0[1]); w.y = pk_bf16(x0[2], x0[3]); w.z = pk_bf16(x1[0], x1[1]); w.w = pk_bf16(x1[2], x1[3]);
                        if (keep && p.wxn) *(u32x4*)(p.XN + off) = w;
                    }
                    ss += shx(ss, 16); ss += shx(ss, 32);
                    if (fq == 0 && keep) unsafeAtomicAdd(p.ssq_out + row, ss);
                }
            }
        } else if constexpr (MODE == 7) {
            f32x4 xn[2][4][2][2];
#pragma unroll
            for (int ai = 0; ai < 2; ++ai) {
#pragma unroll
              for (int m = 0; m < 4; ++m)
#pragma unroll
                for (int bj = 0; bj < 2; ++bj) { const size_t off = (size_t)(rowb + ai * 128 + m * 16) * D + pn * 256 + bj * 128 + colw;
                    xn[ai][m][bj][0] = *(const f32x4*)(p.xin + off); xn[ai][m][bj][1] = *(const f32x4*)(p.xin + off + 4); }
              __builtin_amdgcn_sched_barrier(0);
#pragma unroll
                for (int m = 0; m < 4; ++m) {
                    const int row = rowb + ai * 128 + m * 16;
                    float ss = 0.f;
#pragma unroll
                    for (int bj = 0; bj < 2; ++bj) {
                        f32x4 x0 = xn[ai][m][bj][0] + acc[ai][bj][m][0], x1 = xn[ai][m][bj][1] + acc[ai][bj][m][1];
                        xn[ai][m][bj][0] = x0; xn[ai][m][bj][1] = x1;
                        ss += (x0[0] * x0[0] + x0[1] * x0[1]) + (x0[2] * x0[2] + x0[3] * x0[3]) + (x1[0] * x1[0] + x1[1] * x1[1]) + (x1[2] * x1[2] + x1[3] * x1[3]);
                    }
                    ss += shx(ss, 16); ss += shx(ss, 32);
                    if (fq == 0 && (row & 4095) != 0) unsafeAtomicAdd(p.ssq_out + row, ss);
                }
            }
            asm volatile("s_waitcnt vmcnt(0) lgkmcnt(0)\n\ts_barrier" ::: "memory");
            if (wr == 0 && wc == 0 && fr == 0 && fq == 0) {
                unsigned* c = p.cnt + 64 * u.pm;
                __hip_atomic_fetch_add(c, 1u, __ATOMIC_RELAXED, __HIP_MEMORY_SCOPE_AGENT);
                unsigned spins = 0;
                while (__hip_atomic_load(c, __ATOMIC_RELAXED, __HIP_MEMORY_SCOPE_AGENT) < 4u && ++spins < (1u << 22)) __builtin_amdgcn_s_sleep(1);
            }
            asm volatile("s_waitcnt vmcnt(0) lgkmcnt(0)\n\ts_barrier" ::: "memory");
            f32x4 gg[2][2];
#pragma unroll
            for (int bj = 0; bj < 2; ++bj) { const int col = pn * 256 + bj * 128 + colw; gg[bj][0] = *(const f32x4*)(p.gnext + col); gg[bj][1] = *(const f32x4*)(p.gnext + col + 4); }
            float sq[2][4];
#pragma unroll
            for (int ai = 0; ai < 2; ++ai)
#pragma unroll
                for (int m = 0; m < 4; ++m) sq[ai][m] = __hip_atomic_load(p.ssq_out + rowb + ai * 128 + m * 16, __ATOMIC_RELAXED, __HIP_MEMORY_SCOPE_AGENT);
#pragma unroll
            for (int ai = 0; ai < 2; ++ai)
#pragma unroll
                for (int m = 0; m < 4; ++m) {
                    const int row = rowb + ai * 128 + m * 16;
                    const float rs = __builtin_amdgcn_rsqf(sq[ai][m] * (1.f / 1024.f) + EPS);
                    if ((row & 4095) != 0) {
#pragma unroll
                        for (int bj = 0; bj < 2; ++bj) { const size_t off = (size_t)row * D + pn * 256 + bj * 128 + colw;
                            *(f32x4*)(p.xout + off) = xn[ai][m][bj][0] * rs * gg[bj][0]; *(f32x4*)(p.xout + off + 4) = xn[ai][m][bj][1] * rs * gg[bj][1]; }
                    }
                }
        } else if constexpr (MODE == 6) {
            const int sq_ = u.pm / 17, jt = u.pm - sq_ * 17, p0 = 254 * jt - 2;
            const int colh = pn * 128 + colw;
            float rsv[2][4];
#pragma unroll
            for (int ai = 0; ai < 2; ++ai)
#pragma unroll
                for (int m = 0; m < 4; ++m) { int grow = sq_ * 4096 + p0 + ai * 128 + wr * 64 + m * 16 + fr; grow = grow < 0 ? 0 : (grow > M - 1 ? M - 1 : grow); rsv[ai][m] = p.ssq[grow]; }
            float w0[8], w1[8], w2[8], cbv[8];
#pragma unroll
            for (int k = 0; k < 8; ++k) { w0[k] = p.cw[colh + k]; w1[k] = p.cw[FF + colh + k]; w2[k] = p.cw[2 * FF + colh + k]; cbv[k] = p.cb[colh + k]; }
            __builtin_amdgcn_sched_barrier(0);
#pragma unroll
            for (int ai = 0; ai < 2; ++ai)
#pragma unroll
                for (int m = 0; m < 4; ++m) rsv[ai][m] = __builtin_amdgcn_rsqf(rsv[ai][m] * (1.f / 1024.f) + EPS);
            if (fr >= 14) {
#pragma unroll
                for (int ai = 0; ai < 2; ++ai) {
                    const float rs = rsv[ai][3];
                    LAS float* d = p.xch + ((((ai * 2 + wr) * 4 + wc) * 4 + fq) * 2 + (fr - 14)) * 8;
                    *(LAS f32x4*)d = acc[ai][0][3][0] * rs; *(LAS f32x4*)(d + 4) = acc[ai][0][3][1] * rs; }
            }
            asm volatile("s_waitcnt lgkmcnt(0)\n\ts_barrier" ::: "memory");
#pragma unroll
            for (int ai = 0; ai < 2; ++ai) {
                float r1p[8], r2p[8];
                {
                    const bool has = (wr == 1) || (ai == 1);
                    const int ais = (wr == 1) ? ai : ai - 1, wrs = (wr == 1) ? 0 : 1;
                    f32x4 h62a = (f32x4){0.f, 0.f, 0.f, 0.f}, h62b = h62a, h63a = h62a, h63b = h62a;
                    if (has) { const LAS float* s = p.xch + ((((ais * 2 + wrs) * 4 + wc) * 4 + fq) * 2) * 8;
                        h62a = *(const LAS f32x4*)s; h62b = *(const LAS f32x4*)(s + 4); h63a = *(const LAS f32x4*)(s + 8); h63b = *(const LAS f32x4*)(s + 12); }
#pragma unroll
                    for (int k = 0; k < 4; ++k) { r1p[k] = h63a[k]; r1p[4 + k] = h63b[k]; r2p[k] = (fr == 0) ? h62a[k] : h63a[k]; r2p[4 + k] = (fr == 0) ? h62b[k] : h63b[k]; }
                }
#pragma unroll
                for (int m = 0; m < 4; ++m) {
                    const int lr = ai * 128 + wr * 64 + m * 16 + fr, pos = p0 + lr;
                    const float rs = rsv[ai][m];
                    float y[8];
#pragma unroll
                    for (int k = 0; k < 8; ++k) {
                        const float a0 = (k < 4 ? acc[ai][0][m][0][k & 3] : acc[ai][0][m][1][k & 3]) * rs;
                        const float r1 = __int_as_float(__builtin_amdgcn_update_dpp(0, __float_as_int(a0), 0x121, 0xf, 0xf, false));
                        const float r2 = __int_as_float(__builtin_amdgcn_update_dpp(0, __float_as_int(a0), 0x122, 0xf, 0xf, false));
                        float t1 = (fr == 0) ? r1p[k] : r1, t2 = (fr < 2) ? r2p[k] : r2;
                        r1p[k] = r1; r2p[k] = r2;
                        if (jt == 0 && ai == 0 && m == 0 && wr == 0) { t1 = (pos >= 1) ? t1 : 0.f; t2 = (pos >= 2) ? t2 : 0.f; }
                        const float cv = w0[k] * t2 + w1[k] * t1 + w2[k] * a0 + cbv[k];
                        const float bvv = (k < 4 ? acc[ai][1][m][0][k & 3] : acc[ai][1][m][1][k & 3]) * rs;
                        y[k] = cv * sigmoidf_(cv) * bvv;
                    }
                    if (lr >= 2 && pos < 4096)
                        *(u32x4*)(p.H + (size_t)(sq_ * 4096 + pos) * FF + colh) = (u32x4){pk_bf16(y[0], y[1]), pk_bf16(y[2], y[3]), pk_bf16(y[4], y[5]), pk_bf16(y[6], y[7])};
                }
            }
        } else {
#pragma unroll
            for (int ai = 0; ai < 2; ++ai)
#pragma unroll
                for (int m = 0; m < 4; ++m) {
                    const int row = rowb + ai * 128 + m * 16;
                    const float sc = __builtin_amdgcn_rsqf(p.ssq[row] * (1.f / 1024.f) + EPS);
#pragma unroll
                    for (int bj = 0; bj < 2; ++bj) {
                        const f32x4 v0 = acc[ai][bj][m][0] * sc, v1 = acc[ai][bj][m][1] * sc;
                        u32x4 w; w.x = pk_bf16(v0[0], v0[1]); w.y = pk_bf16(v0[2], v0[3]); w.z = pk_bf16(v1[0], v1[1]); w.w = pk_bf16(v1[2], v1[3]);
                        *(u32x4*)(p.U + (size_t)row * U_LD + pn * 256 + bj * 128 + colw) = w;
                    }
                }
        }
    }
};

namespace sb {
constexpr int PITCH = PA_LD, NW = 8, QB = 256, KVBLK = 64;
constexpr int NSLOT = 3, SLOTB = 8192;
constexpr int LDS_K = 0, LDS_V = NSLOT * SLOTB, LDS_OST = 2 * NSLOT * SLOTB, LDS_BYTES = LDS_OST + NW * 4096;
__device__ __forceinline__ void glds16(const void* gsrc, unsigned lds_dst) { unsigned keep;
    asm volatile("s_mov_b32 %0, m0\n\ts_mov_b32 m0, %2\n\ts_nop 0\n\tglobal_load_lds_dwordx4 %1, off\n\ts_mov_b32 m0, %0" : "=&s"(keep) : "v"(gsrc), "s"(lds_dst) : "memory"); }
__device__ __forceinline__ int crow(int r, int hi) { return (r & 3) + 8 * (r >> 2) + 4 * hi; }
typedef short v4i16_t __attribute__((ext_vector_type(4)));
__device__ __forceinline__ s16x4 vtr(const LAS char* p) { return __builtin_bit_cast(s16x4, __builtin_amdgcn_ds_read_tr16_b64_v4i16((LAS v4i16_t*)p)); }

__device__ __forceinline__ void unit(int b, int h, int qb, bf16_t* PA, LAS char* shm) {
    int tid_ = threadIdx.x; asm volatile("" : "+v"(tid_));
    const int tid = tid_, lane = tid & 63, r32 = lane & 31, hi = lane >> 5; const int wid = __builtin_amdgcn_readfirstlane(tid >> 6);
    const long rowbase = (long)b * SEQ; const int q0 = qb * QB;
    const bf16_t* Qw = PA + (rowbase + q0 + wid * 32) * PITCH + h * 64;
    const bf16_t* Kh = PA + rowbase * PITCH + 512 + h * 64;
    const bf16_t* Vh = PA + rowbase * PITCH + 1024 + h * 64;
    const unsigned lds0 = (unsigned)(uintptr_t)shm;
    const int kperm = ((lane >> 2) & 1) * 32 + (lane >> 5) * 16 + ((lane & 31) >> 3) * 4 + (lane & 3);
    const bf16_t* ksrc = Kh + (long)kperm * PITCH + wid * 8;
    const bf16_t* vsrc = Vh + (long)(16 * (wid & 3) + (lane >> 2)) * PITCH + (wid >> 2) * 32 + (lane & 3) * 8;
    const unsigned kdst = lds0 + LDS_K + wid * 1024, vdst = lds0 + LDS_V + wid * 1024;
#define DMA_KV(t, slot) do { glds16(ksrc + (long)(t) * KVBLK * PITCH, (unsigned)__builtin_amdgcn_readfirstlane(kdst + (slot))); \
                             glds16(vsrc + (long)(t) * KVBLK * PITCH, (unsigned)__builtin_amdgcn_readfirstlane(vdst + (slot))); } while (0)
    const int NT = (q0 + QB) / KVBLK;
    bf16x8 qr[4];
#pragma unroll
    for (int d0 = 0; d0 < 4; ++d0) qr[d0] = *reinterpret_cast<const bf16x8*>(&Qw[(long)r32 * PITCH + d0 * 16 + hi * 8]);
    DMA_KV(NT - 1, 0); DMA_KV(NT - 2, SLOTB);
    asm volatile("" : "+v"(qr[0]), "+v"(qr[1]), "+v"(qr[2]), "+v"(qr[3]));
    f32x16 o[2]; o[0] = f32x16{}; o[1] = f32x16{};
    float carry = 1.f;
    const int qrel = wid * 32 + r32;
    const LAS char* kp0 = shm + LDS_K + hi * 1024 + r32 * 16;
    const LAS char* vp0 = shm + LDS_V + (32 * hi + ((lane & 15) >> 2)) * 64 + ((lane >> 4) & 1) * 32 + (lane & 3) * 8;
    int slot = 0, slot2 = 2 * SLOTB;
    for (int t = NT - 1; t >= 0; --t) {
        if (t >= 1) asm volatile("s_waitcnt vmcnt(2) lgkmcnt(0)\n\ts_barrier" ::: "memory");
        else        asm volatile("s_waitcnt vmcnt(0) lgkmcnt(0)\n\ts_barrier" ::: "memory");
        if (t >= 2) DMA_KV(t - 2, slot2);
        const int jb = t - (NT - 4);
        if (jb <= (wid >> 1)) {
            const LAS char* kb = kp0 + slot; const LAS char* vb = vp0 + slot;
            bf16x8 kf[8];
#pragma unroll
            for (int d0 = 0; d0 < 4; ++d0) { kf[2 * d0] = *(const LAS bf16x8*)(kb + d0 * 2048); kf[2 * d0 + 1] = *(const LAS bf16x8*)(kb + d0 * 2048 + 512); }
            s16x4 vl[8], vh[8];
#pragma unroll
            for (int i = 0; i < 8; ++i) { vl[i] = vtr(vb + (i >> 2) * 4096 + (i & 3) * 512); vh[i] = vtr(vb + (i >> 2) * 4096 + (i & 3) * 512 + 256); }
            __builtin_amdgcn_sched_barrier(0);
            f32x16 p0 = f32x16{}, p1 = f32x16{};
#pragma unroll
            for (int d0 = 0; d0 < 4; ++d0) {
                p0 = __builtin_amdgcn_mfma_f32_32x32x16_bf16(kf[2 * d0], qr[d0], p0, 0, 0, 0);
                p1 = __builtin_amdgcn_mfma_f32_32x32x16_bf16(kf[2 * d0 + 1], qr[d0], p1, 0, 0, 0);
            }
#pragma unroll
            for (int r = 0; r < 16; ++r) { p0[r] = __builtin_amdgcn_exp2f(__builtin_amdgcn_fmed3f(p0[r], 15.f, -3.0e38f)); p1[r] = __builtin_amdgcn_exp2f(__builtin_amdgcn_fmed3f(p1[r], 15.f, -3.0e38f)); }
            if (jb == (wid >> 1)) {
                const int kb0 = 64 * jb + 32 * hi;
#pragma unroll
                for (int r = 0; r < 16; ++r) { if (kb0 + r >= qrel) p0[r] = 0.f; if (kb0 + 16 + r >= qrel) p1[r] = 0.f; }
            }
            float R0, R1, R2, R3;
            { float Q = 1.f;
#pragma unroll
              for (int i = 0; i < 8; ++i) { const float d = Q * p0[i]; p0[i] = d; Q += d; }
              R0 = __builtin_amdgcn_rcpf(Q); }
            { float Q = 1.f;
#pragma unroll
              for (int i = 8; i < 16; ++i) { const float d = Q * p0[i]; p0[i] = d; Q += d; }
              R1 = __builtin_amdgcn_rcpf(Q); }
            { float Q = 1.f;
#pragma unroll
              for (int i = 0; i < 8; ++i) { const float d = Q * p1[i]; p1[i] = d; Q += d; }
              R2 = __builtin_amdgcn_rcpf(Q); }
            { float Q = 1.f;
#pragma unroll
              for (int i = 8; i < 16; ++i) { const float d = Q * p1[i]; p1[i] = d; Q += d; }
              R3 = __builtin_amdgcn_rcpf(Q); }
            const float Tl = (R0 * R1) * (R2 * R3);
            float Tp;
            { const auto rr = __builtin_amdgcn_permlane32_swap(__float_as_uint(Tl), __float_as_uint(Tl), false, false); Tp = __uint_as_float(hi == 0 ? rr[1] : rr[0]); }
            const float base = carry * (hi == 0 ? Tp : 1.f);
            carry = carry * Tl * Tp;
            const float sc3 = base * R3, sc2 = sc3 * R2, sc1 = sc2 * R1, sc0 = sc1 * R0;
#pragma unroll
            for (int i = 0; i < 8; ++i) { p0[i] *= sc0; p0[8 + i] *= sc1; p1[i] *= sc2; p1[8 + i] *= sc3; }
            u32x4 pw0, pw1, pw2, pw3;
            pw0 = (u32x4){pk_bf16(p0[0], p0[1]), pk_bf16(p0[2], p0[3]), pk_bf16(p0[4], p0[5]), pk_bf16(p0[6], p0[7])};
            pw1 = (u32x4){pk_bf16(p0[8], p0[9]), pk_bf16(p0[10], p0[11]), pk_bf16(p0[12], p0[13]), pk_bf16(p0[14], p0[15])};
            pw2 = (u32x4){pk_bf16(p1[0], p1[1]), pk_bf16(p1[2], p1[3]), pk_bf16(p1[4], p1[5]), pk_bf16(p1[6], p1[7])};
            pw3 = (u32x4){pk_bf16(p1[8], p1[9]), pk_bf16(p1[10], p1[11]), pk_bf16(p1[12], p1[13]), pk_bf16(p1[14], p1[15])};
#pragma unroll
            for (int d0 = 0; d0 < 2; ++d0) {
#define PKV(k) (bf16x8){vl[d0 * 4 + k][0], vl[d0 * 4 + k][1], vl[d0 * 4 + k][2], vl[d0 * 4 + k][3], vh[d0 * 4 + k][0], vh[d0 * 4 + k][1], vh[d0 * 4 + k][2], vh[d0 * 4 + k][3]}
                o[d0] = __builtin_amdgcn_mfma_f32_32x32x16_bf16(__builtin_bit_cast(bf16x8, pw0), PKV(0), o[d0], 0, 0, 0);
                o[d0] = __builtin_amdgcn_mfma_f32_32x32x16_bf16(__builtin_bit_cast(bf16x8, pw1), PKV(1), o[d0], 0, 0, 0);
                o[d0] = __builtin_amdgcn_mfma_f32_32x32x16_bf16(__builtin_bit_cast(bf16x8, pw2), PKV(2), o[d0], 0, 0, 0);
                o[d0] = __builtin_amdgcn_mfma_f32_32x32x16_bf16(__builtin_bit_cast(bf16x8, pw3), PKV(3), o[d0], 0, 0, 0);
#undef PKV
            }
        }
        slot2 = slot; slot = (slot == (NSLOT - 1) * SLOTB) ? 0 : slot + SLOTB;
    }
    bf16_t* Ow = PA + (rowbase + q0 + wid * 32) * PITCH + h * 64;
    {
        LAS bf16_t* stg = (LAS bf16_t*)(shm + LDS_OST) + wid * 2048;
#pragma unroll
        for (int r = 0; r < 16; ++r) { const int orow = crow(r, hi);
#pragma unroll
            for (int d0 = 0; d0 < 2; ++d0) stg[orow * 64 + d0 * 32 + r32] = (bf16_t)(pk_bf16(o[d0][r], 0.f) & 0xffffu); }
        asm volatile("s_waitcnt lgkmcnt(0)" ::: "memory");
#pragma unroll
        for (int i = 0; i < 4; ++i) { const int row = i * 8 + (lane >> 3), ch = lane & 7; const u32x4 v = *(const LAS u32x4*)(stg + row * 64 + ch * 8); *(u32x4*)(Ow + (long)row * PITCH + ch * 8) = v; }
    }
    asm volatile("s_waitcnt vmcnt(0) lgkmcnt(0)\n\ts_barrier" ::: "memory");
#undef DMA_KV
}
}

namespace ret {
constexpr int RS = 272;
constexpr int L_Q = 0, L_K = 128 * RS, L_P = 2 * 128 * RS, L_V = 3 * 128 * RS, L_S = L_V + 128 * 64, LDS_BYTES = L_S + 2 * 32 * RS;
typedef short v4i16_t __attribute__((ext_vector_type(4)));
__device__ __forceinline__ s16x4 vtr(const LAS char* p) { return __builtin_bit_cast(s16x4, __builtin_amdgcn_ds_read_tr16_b64_v4i16((LAS v4i16_t*)p)); }
__device__ __forceinline__ bf16x8 cat(s16x4 a, s16x4 b) { return (bf16x8){a[0], a[1], a[2], a[3], b[0], b[1], b[2], b[3]}; }

__device__ __forceinline__ void item(int b, int h, int sl, bf16_t* PA, LAS char* shm) {
    int tid_ = threadIdx.x; asm volatile("" : "+v"(tid_));
    const int tid = tid_, lane = tid & 63, fr = lane & 15, fq = lane >> 4; const int wid = __builtin_amdgcn_readfirstlane(tid >> 6);
    const size_t rowbase = (size_t)b * SEQ;
    const bf16_t* Qg = PA + rowbase * PA_LD + 1536 + h * 128;
    const bf16_t* Kg = PA + rowbase * PA_LD + 2048 + h * 128;
    bf16_t* Vg = PA + rowbase * PA_LD + 2560 + h * 256 + sl * 32;
    const float lg = __builtin_log2f(1.f - __builtin_exp2f(-5.f - (float)h));
    const float gam128 = __builtin_exp2f(128.f * lg);
    for (int i = tid; i < 32 * RS / 4; i += 512) ((LAS unsigned*)(shm + L_S))[i] = 0u;
    u32x4 qA[4], kA[4], vA, qB[4], kB[4], vB;
#define RET_LOAD(c, Q_, K_, V_) do { _Pragma("unroll") for (int i = 0; i < 4; ++i) { const int id = tid + 512 * i, row = id >> 4, ch = id & 15; \
            Q_[i] = *(const u32x4*)(Qg + (size_t)((c) * 128 + row) * PA_LD + ch * 8); K_[i] = *(const u32x4*)(Kg + (size_t)((c) * 128 + row) * PA_LD + ch * 8); } \
        V_ = *(const u32x4*)(Vg + (size_t)((c) * 128 + (tid >> 2)) * PA_LD + (tid & 3) * 8); } while (0)
#define RET_STORE(Q_, K_, V_) do { _Pragma("unroll") for (int i = 0; i < 4; ++i) { const int id = tid + 512 * i, row = id >> 4, ch = id & 15; \
            *(LAS u32x4*)(shm + L_Q + row * RS + ch * 16) = Q_[i]; *(LAS u32x4*)(shm + L_K + row * RS + ch * 16) = K_[i]; } \
        *(LAS u32x4*)(shm + L_V + (tid >> 2) * 64 + (tid & 3) * 16) = V_; } while (0)
    RET_LOAD(0, qA, kA, vA); RET_LOAD(1, qB, kB, vB);
    f32x4 st[2]; st[0] = (f32x4){0.f, 0.f, 0.f, 0.f}; st[1] = st[0];
    auto step = [&](const int c, u32x4 (&Qs)[4], u32x4 (&Ks)[4], u32x4& Vs) __attribute__((always_inline)) {
        RET_STORE(Qs, Ks, Vs);
        asm volatile("s_waitcnt lgkmcnt(0)\n\ts_barrier" ::: "memory");
        if (c + 2 < 32) RET_LOAD(c + 2, Qs, Ks, Vs);
        const LAS char* Scur = shm + L_S + (c & 1) * 32 * RS; LAS char* Snxt = shm + L_S + ((c + 1) & 1) * 32 * RS;
        bf16x8 bq[4];
        {
#pragma unroll
            for (int ks = 0; ks < 4; ++ks) bq[ks] = *(const LAS bf16x8*)(shm + L_Q + (16 * wid + fr) * RS + (ks * 32 + 8 * fq) * 2);
            const int n = 16 * wid + fr;
#pragma unroll
            for (int hb = 0; hb < 2; ++hb) {
                bf16x8 ak[4][4];
#pragma unroll
                for (int mi = 0; mi < 4; ++mi)
#pragma unroll
                    for (int ks = 0; ks < 4; ++ks) ak[mi][ks] = *(const LAS bf16x8*)(shm + L_K + (16 * (4 * hb + mi) + fr) * RS + (ks * 32 + 8 * fq) * 2);
                __builtin_amdgcn_sched_barrier(0);
#pragma unroll
                for (int mi = 0; mi < 4; ++mi) {
                    f32x4 a4 = (f32x4){0.f, 0.f, 0.f, 0.f};
#pragma unroll
                    for (int ks = 0; ks < 4; ++ks) a4 = __builtin_amdgcn_mfma_f32_16x16x32_bf16(ak[mi][ks], bq[ks], a4, 0, 0, 0);
                    const int m0 = 16 * (4 * hb + mi) + 4 * fq;
#pragma unroll
                    for (int k = 0; k < 4; ++k) if (m0 + k > n) a4[k] = 0.f;
                    u32x2 w; w.x = pk_bf16(a4[0], a4[1]); w.y = pk_bf16(a4[2], a4[3]);
                    *(LAS u32x2*)(shm + L_P + n * RS + m0 * 2) = w;
                }
                __builtin_amdgcn_sched_barrier(0);
            }
        }
        bf16x8 vf[4][2];
        {
            bf16x8 kfr[4];
#pragma unroll
            for (int ks = 0; ks < 4; ++ks) {
                const int r0 = 32 * ks + 8 * fq + (fr >> 2);
                const LAS char* ka = shm + L_K + r0 * RS + (16 * wid + 4 * (fr & 3)) * 2;
                kfr[ks] = cat(vtr(ka), vtr(ka + 4 * RS));
#pragma unroll
                for (int eb = 0; eb < 2; ++eb) { const LAS char* va = shm + L_V + r0 * 64 + (16 * eb + 4 * (fr & 3)) * 2; vf[ks][eb] = cat(vtr(va), vtr(va + 4 * 64)); }
            }
            __builtin_amdgcn_sched_barrier(0);
            f32x4 kv[2]; kv[0] = (f32x4){0.f, 0.f, 0.f, 0.f}; kv[1] = kv[0];
#pragma unroll
            for (int ks = 0; ks < 4; ++ks)
#pragma unroll
                for (int eb = 0; eb < 2; ++eb) kv[eb] = __builtin_amdgcn_mfma_f32_16x16x32_bf16(kfr[ks], vf[ks][eb], kv[eb], 0, 0, 0);
#pragma unroll
            for (int eb = 0; eb < 2; ++eb) {
                st[eb] = (st[eb] + kv[eb]) * gam128;
                u32x2 w; w.x = pk_bf16(st[eb][0], st[eb][1]); w.y = pk_bf16(st[eb][2], st[eb][3]);
                *(LAS u32x2*)(Snxt + (16 * eb + fr) * RS + (16 * wid + 4 * fq) * 2) = w;
            }
        }
        asm volatile("s_waitcnt lgkmcnt(0)\n\ts_barrier" ::: "memory");
        {
            bf16x8 bp[4], as_[4][2];
#pragma unroll
            for (int ks = 0; ks < 4; ++ks) {
                bp[ks] = *(const LAS bf16x8*)(shm + L_P + (16 * wid + fr) * RS + (ks * 32 + 8 * fq) * 2);
#pragma unroll
                for (int eb = 0; eb < 2; ++eb) as_[ks][eb] = *(const LAS bf16x8*)(Scur + (16 * eb + fr) * RS + (ks * 32 + 8 * fq) * 2);
            }
            __builtin_amdgcn_sched_barrier(0);
            f32x4 oa[2]; oa[0] = (f32x4){0.f, 0.f, 0.f, 0.f}; oa[1] = oa[0];
#pragma unroll
            for (int ks = 0; ks < 4; ++ks)
#pragma unroll
                for (int eb = 0; eb < 2; ++eb) {
                    oa[eb] = __builtin_amdgcn_mfma_f32_16x16x32_bf16(vf[ks][eb], bp[ks], oa[eb], 0, 0, 0);
                    oa[eb] = __builtin_amdgcn_mfma_f32_16x16x32_bf16(as_[ks][eb], bq[ks], oa[eb], 0, 0, 0);
                }
#pragma unroll
            for (int eb = 0; eb < 2; ++eb) {
                u32x2 w; w.x = pk_bf16(oa[eb][0], oa[eb][1]); w.y = pk_bf16(oa[eb][2], oa[eb][3]);
                *(u32x2*)(Vg + (size_t)(c * 128 + 16 * wid + fr) * PA_LD + 16 * eb + 4 * fq) = w;
            }
        }
    };
    for (int c = 0; c < 32; c += 2) { step(c, qA, kA, vA); step(c + 1, qB, kB, vB); }
    asm volatile("s_waitcnt lgkmcnt(0)\n\ts_barrier" ::: "memory");
#undef RET_LOAD
#undef RET_STORE
}
}


namespace side {
constexpr int RED_OFF = 98304;
__device__ __forceinline__ void gemv_item(LAS unsigned char* lds, const float* W, int ldw, int kb, int n0, float* outp, int ldo) {
    int tid_ = threadIdx.x; asm volatile("" : "+v"(tid_));
    const int tid = tid_, lane = tid & 63, wave = __builtin_amdgcn_readfirstlane(tid >> 6);
    const LAS f32x4* A = (const LAS f32x4*)lds;
    float acc[8];
#pragma unroll
    for (int r = 0; r < 8; ++r) acc[r] = 0.f;
    const int k0 = kb + wave * 32;
    const float* wp = W + (size_t)k0 * ldw + n0 + lane;
    float w[32];
#pragma unroll
    for (int k = 0; k < 32; ++k) w[k] = wp[(size_t)k * ldw];
#pragma unroll
    for (int k = 0; k < 32; ++k) {
        const f32x4 a0 = A[(k0 + k) * 2], a1 = A[(k0 + k) * 2 + 1];
        acc[0] += a0[0] * w[k]; acc[1] += a0[1] * w[k]; acc[2] += a0[2] * w[k]; acc[3] += a0[3] * w[k];
        acc[4] += a1[0] * w[k]; acc[5] += a1[1] * w[k]; acc[6] += a1[2] * w[k]; acc[7] += a1[3] * w[k];
    }
    LAS float* red = (LAS float*)(lds + RED_OFF);
#pragma unroll
    for (int r = 0; r < 8; ++r) red[(wave * 8 + r) * 64 + lane] = acc[r];
    __syncthreads();
    { float s = 0.f;
#pragma unroll
      for (int ww = 0; ww < 8; ++ww) s += red[(ww * 8 + wave) * 64 + lane];
      unsafeAtomicAdd(outp + (size_t)wave * ldo + n0 + lane, s); }
    __syncthreads();
}
__device__ __forceinline__ void prep_norm(LAS unsigned char* lds, const float* xa, size_t xa_stride, const float* add, const float* g, bool wr, float* outw, bf16_t* XNw, float* ssqw, float* xsw, bool normw = false) {
    int tid_ = threadIdx.x; asm volatile("" : "+v"(tid_));
    const int lane = tid_ & 63, r = __builtin_amdgcn_readfirstlane(tid_ >> 6);
    const size_t rowoff = (size_t)r * SEQ * D;
    float v[16]; float s = 0.f;
#pragma unroll
    for (int j = 0; j < 16; ++j) { const int k = lane + 64 * j; v[j] = xa[(size_t)r * xa_stride + k] + (add ? add[r * D + k] : 0.f); s += v[j] * v[j]; }
    s = wave_sum(s);
    const float rs = 1.f / sqrtf(s * (1.f / 1024.f) + EPS);
    LAS float* A = (LAS float*)lds;
#pragma unroll
    for (int j = 0; j < 16; ++j) { const int k = lane + 64 * j; const float gk = g[k]; A[k * 8 + r] = v[j] * gk * rs;
        if (wr) { outw[rowoff + k] = normw ? v[j] * gk * rs : v[j]; XNw[rowoff + k] = (bf16_t)(pk_bf16(v[j] * gk, 0.f) & 0xffffu); if (xsw) xsw[r * D + k] = v[j]; } }
    if (wr && lane == 0) ssqw[(size_t)r * SEQ] = s;
    __syncthreads();
}
__device__ __forceinline__ float silu_(float x) { return x / (1.f + __expf(-x)); }
__device__ __forceinline__ float sigm_(float x) { return 1.f / (1.f + __expf(-x)); }
}


__device__ __forceinline__ unsigned xb_ld(unsigned* p)              { return __hip_atomic_load(p, __ATOMIC_RELAXED, __HIP_MEMORY_SCOPE_AGENT); }
__device__ __forceinline__ unsigned xb_add(unsigned* p, unsigned v) { return __hip_atomic_fetch_add(p, v, __ATOMIC_RELAXED, __HIP_MEMORY_SCOPE_AGENT); }
__device__ __forceinline__ unsigned xb_xcc_id() { return (unsigned)__builtin_amdgcn_s_getreg((3 << 11) | 20) & 0xFu; }
#define XB_TMO      128
#define XB_XCNT(j)  (256  + 64 * (j))
#define XB_XSUB(j)  (1280 + 64 * (j))
#define XB_XGEN(j)  (2304 + 64 * (j))
#define XB_TOP      3328
#define XB_TOPGEN   3392
#define XCD_BAR_WORDS 3456
#define XB_SPIN_CAP (1u << 18)

#define XB_SPIN(cond, bar) do { unsigned _sp = 0; while (cond) { __builtin_amdgcn_s_sleep(1); \
    if ((++_sp & 255u) == 0u) { if (xb_ld(&(bar)[XB_TMO])) break; if (_sp > XB_SPIN_CAP) { atomicAdd(&(bar)[XB_TMO], 1u); break; } } } } while (0)

struct XcdBarrier {
    unsigned* bar; unsigned x;
    volatile LAS unsigned* st;
};

__device__ __forceinline__ XcdBarrier xcd_barrier_post(unsigned* bar, volatile LAS unsigned* st) {
    XcdBarrier b; b.bar = bar; b.x = xb_xcc_id(); b.st = st;
    if (threadIdx.x == 0) (void)xb_add(&bar[XB_XCNT(b.x)], 1u);
    return b;
}
__device__ __forceinline__ void xcd_barrier_complete(unsigned* bar, unsigned x, unsigned& nloc, unsigned& nx) {
    const unsigned G = gridDim.x * gridDim.y * gridDim.z;
    unsigned sum, cnt, mine, sp = 0u;
    for (;;) {
        sum = 0u; cnt = 0u; mine = 0u;
#pragma unroll
        for (unsigned j = 0; j < 16; ++j) { const unsigned c = xb_ld(&bar[XB_XCNT(j)]); sum += c; cnt += (c > 0u) ? 1u : 0u; mine = (j == x) ? c : mine; }
        if (sum == G) break;
        __builtin_amdgcn_s_sleep(1);
        if ((++sp & 255u) == 0u) { if (xb_ld(&bar[XB_TMO])) break; if (sp > XB_SPIN_CAP) { atomicAdd(&bar[XB_TMO], 1u); break; } }
    }
    nloc = mine > 0u ? mine : 1u; nx = cnt > 0u ? cnt : 1u;
}

__device__ __forceinline__ void xcd_barrier(const XcdBarrier& b) {
    asm volatile("s_waitcnt vmcnt(0)" ::: "memory");
    __syncthreads();
    if (threadIdx.x == 0) {
        unsigned* bar = b.bar;
        __builtin_amdgcn_s_waitcnt(0);
        unsigned nloc = b.st[0], nx = b.st[1];
        if (nloc == 0u) { xcd_barrier_complete(bar, b.x, nloc, nx); b.st[0] = nloc; b.st[1] = nx; }
        const unsigned old = xb_add(&bar[XB_XSUB(b.x)], 1u);
        const unsigned gen = old / nloc;
        if (old + 1u == (gen + 1u) * nloc) {
            __builtin_amdgcn_fence(__ATOMIC_RELEASE, "agent");
            asm volatile("s_waitcnt vmcnt(0)" ::: "memory");
            const unsigned og = xb_add(&bar[XB_TOP], 1u);
            const unsigned tg = og / nx;
            if (og + 1u == (tg + 1u) * nx) xb_add(&bar[XB_TOPGEN], 1u);
            else XB_SPIN(xb_ld(&bar[XB_TOPGEN]) == tg, bar);
            __builtin_amdgcn_fence(__ATOMIC_ACQUIRE, "agent");
            xb_add(&bar[XB_XGEN(b.x)], 1u);
            asm volatile("s_waitcnt vmcnt(0)" ::: "memory");
        } else {
            XB_SPIN(xb_ld(&bar[XB_XGEN(b.x)]) == gen, bar);
            __builtin_amdgcn_fence(__ATOMIC_ACQUIRE, "agent");
            asm volatile("s_waitcnt vmcnt(0)" ::: "memory");
        }
    }
    __syncthreads();
}


struct Args { const float* in[14]; float* out; unsigned char* ws; };

__device__ __forceinline__ int rope_prow(int n) { if (n >= 1536 && n < 2560) { const int j = (n - 1536) & 127, base = n - j; return base + (j < 64 ? 2 * j : 2 * (j - 64) + 1); } return n; }
#define TI_LOAD(wv, W, N, item) do { const int nblk_ = (N) / 32, k0_ = 64 * ((item) / nblk_), n0_ = 32 * ((item) % nblk_); \
    _Pragma("unroll") for (int i = 0; i < 32; ++i) wv[i] = (W)[(size_t)(k0_ + 2 * i + (lane >> 5)) * (N) + n0_ + (lane & 31)]; } while (0)
#define TI_STORE(wv, WT, N, ldt, koff, perm, item) do { const int nblk_ = (N) / 32, k0_ = 64 * ((item) / nblk_), n0_ = 32 * ((item) % nblk_); \
    _Pragma("unroll") for (int i = 0; i < 32; ++i) scr[(2 * i + (lane >> 5)) * 33 + (lane & 31)] = wv[i]; \
    asm volatile("s_waitcnt lgkmcnt(0)" ::: "memory"); \
    const int c_ = lane & 7; \
    _Pragma("unroll") for (int j = 0; j < 4; ++j) { const int n_ = (lane >> 3) + 8 * j; const LAS float* s_ = scr + (8 * c_) * 33 + n_; \
        u32x4 o_; o_.x = pk_bf16(s_[0 * 33], s_[1 * 33]); o_.y = pk_bf16(s_[2 * 33], s_[3 * 33]); o_.z = pk_bf16(s_[4 * 33], s_[5 * 33]); o_.w = pk_bf16(s_[6 * 33], s_[7 * 33]); \
        const int nn_ = n0_ + n_; \
        const int dr_ = ((perm) == 1) ? rope_prow(nn_) : ((perm) == 2) ? ((nn_ < FF) ? ((nn_ >> 7) * 256 + (nn_ & 127)) : (((nn_ - FF) >> 7) * 256 + 128 + ((nn_ - FF) & 127))) : nn_; \
        *(u32x4*)((WT) + (size_t)dr_ * (ldt) + (koff) + k0_ + 8 * c_) = o_; } \
    asm volatile("s_waitcnt lgkmcnt(0)" ::: "memory"); } while (0)
__device__ __forceinline__ void convert_mixer(const Args& a, int l, LAS unsigned char* lds, int gw, int NGW, int wave, int lane) {
    LAS float* scr = (LAS float*)(lds + wave * 16384);
    bf16_t* win = (bf16_t*)(a.ws + WS_WIN); bf16_t* wcat = (bf16_t*)(a.ws + WS_WCAT); bf16_t* wo = (bf16_t*)(a.ws + WS_WO);
    const float* w_in = a.in[2] + (size_t)l * D * IN_COLS; const float* sbw = a.in[4] + (size_t)l * 512 * D;
    const float* rw = a.in[6] + (size_t)l * D * D; const float* w_o = a.in[7] + (size_t)l * D * D;
    constexpr int I0 = (D / 64) * (IN_COLS / 32), I1 = (512 / 64) * (D / 32), I2 = (D / 64) * (D / 32), I3 = I2, NI = I0 + I1 + I2 + I3;
#define RES_MIX(it_, W_, WT_, N_, ldt_, koff_, perm_, item_) do { int r_ = (it_); \
        if (r_ < I0) { W_ = w_in; WT_ = win; N_ = IN_COLS; ldt_ = D; koff_ = 0; perm_ = 1; item_ = r_; } \
        else if (r_ < I0 + I1) { W_ = sbw; WT_ = wcat; N_ = D; ldt_ = 1536; koff_ = 0; perm_ = 0; item_ = r_ - I0; } \
        else if (r_ < I0 + I1 + I2) { W_ = rw; WT_ = wcat; N_ = D; ldt_ = 1536; koff_ = 512; perm_ = 0; item_ = r_ - I0 - I1; } \
        else { W_ = w_o; WT_ = wo; N_ = D; ldt_ = D; koff_ = 0; perm_ = 0; item_ = r_ - I0 - I1 - I2; } } while (0)
    for (int it = gw; it < NI; it += 2 * NGW) {
        const bool two = it + NGW < NI;
        const float *Wa, *Wb; bf16_t *Ta, *Tb; int Na, Nb, la, lb, ka, kb, pa, pb, ia, ib;
        RES_MIX(it, Wa, Ta, Na, la, ka, pa, ia); RES_MIX(two ? it + NGW : it, Wb, Tb, Nb, lb, kb, pb, ib);
        float wa[32], wb[32];
        TI_LOAD(wa, Wa, Na, ia);
        if (two) TI_LOAD(wb, Wb, Nb, ib);
        TI_STORE(wa, Ta, Na, la, ka, pa, ia);
        if (two) TI_STORE(wb, Tb, Nb, lb, kb, pb, ib);
    }
#undef RES_MIX
}
__device__ __forceinline__ void convert_ffn(const Args& a, int l, LAS unsigned char* lds, int gw, int NGW, int wave, int lane) {
    LAS float* scr = (LAS float*)(lds + wave * 16384);
    bf16_t* wup = (bf16_t*)(a.ws + WS_WUP); bf16_t* wdn = (bf16_t*)(a.ws + WS_WDN);
    const float* w_up = a.in[9] + (size_t)l * D * U_LD; const float* w_dn = a.in[12] + (size_t)l * FF * D;
    constexpr int I0 = (D / 64) * (U_LD / 32), I1 = (FF / 64) * (D / 32), NI = I0 + I1;
#define RES_FFN(it_, W_, WT_, N_, ldt_, koff_, perm_, item_) do { int r_ = (it_); \
        if (r_ < I0) { W_ = w_up; WT_ = wup; N_ = U_LD; ldt_ = D; koff_ = 0; perm_ = 2; item_ = r_; } \
        else { W_ = w_dn; WT_ = wdn; N_ = D; ldt_ = FF; koff_ = 0; perm_ = 0; item_ = r_ - I0; } } while (0)
    for (int it = gw; it < NI; it += 2 * NGW) {
        const bool two = it + NGW < NI;
        const float *Wa, *Wb; bf16_t *Ta, *Tb; int Na, Nb, la, lb, ka, kb, pa, pb, ia, ib;
        RES_FFN(it, Wa, Ta, Na, la, ka, pa, ia); RES_FFN(two ? it + NGW : it, Wb, Tb, Nb, lb, kb, pb, ib);
        float wa[32], wb[32];
        TI_LOAD(wa, Wa, Na, ia);
        if (two) TI_LOAD(wb, Wb, Nb, ib);
        TI_STORE(wa, Ta, Na, la, ka, pa, ia);
        if (two) TI_STORE(wb, Tb, Nb, lb, kb, pb, ib);
    }
#undef RES_FFN
}
#undef TI_LOAD
#undef TI_STORE

__global__ void __launch_bounds__(512, 2) fwd_kernel(Args a) {
    extern __shared__ __attribute__((aligned(16))) unsigned char lds_raw[];
    LAS unsigned char* lds = (LAS unsigned char*)lds_raw;
    cg::grid_group grid = cg::this_grid();
    const int G = gridDim.x, bx = blockIdx.x;
    if (threadIdx.x < 8) ((LAS unsigned*)(lds + 131072))[threadIdx.x] = 0u;
    __syncthreads();
    const int vcu = (G % 8 == 0) ? (bx % 8) * (G / 8) + bx / 8 : bx;
    const int NGW = G * 8, NGT = G * 512;
#define PHASE_IDS() int tid_ = threadIdx.x; asm volatile("" : "+v"(tid_)); const int tid = tid_, lane = tid & 63, wave = __builtin_amdgcn_readfirstlane(tid >> 6); \
    const int gw = vcu * 8 + wave, gtid = bx * 512 + tid; (void)gw; (void)gtid; (void)lane;
#define ws ({ __attribute__((address_space(1))) unsigned char* p_ = (__attribute__((address_space(1))) unsigned char*)a.ws; asm volatile("" : "+s"(p_)); (unsigned char*)p_; })
#define w_ssq ((float*)(ws + WS_SSQ))
#define w_rope ((f32x4*)(ws + WS_ROPE))
#define w_win ((bf16_t*)(ws + WS_WIN))
#define w_wcat ((bf16_t*)(ws + WS_WCAT))
#define w_wo ((bf16_t*)(ws + WS_WO))
#define w_XN ((bf16_t*)(ws + WS_XN))
#define w_PA ((bf16_t*)(ws + WS_PROJ))
#define w_PB ((bf16_t*)(ws + WS_PB))
#define w_U ((bf16_t*)(ws + WS_PROJ))
#define w_wup ((bf16_t*)(ws + WS_WUP))
#define w_wdn ((bf16_t*)(ws + WS_WDN))
#define w_SIDE ((float*)(ws + WS_SIDE))
#define w_XS ((float*)(ws + WS_XS))
    const float* x = a.in[0]; float* out = a.out;
#ifdef DIAG
    unsigned long long* ts_ = (unsigned long long*)(ws + WS_XS + 65536);
#define STAMP(i) do { if (bx == 0 && threadIdx.x == 0) ts_[i] = __builtin_amdgcn_s_memrealtime(); } while (0)
#else
#define STAMP(i) do {} while (0)
#endif

    {
    PHASE_IDS();
    convert_mixer(a, 0, lds, gw, NGW, wave, lane);
    for (int i = gtid; i < 4096 * 64; i += NGT) {
        const int pos = i >> 6, k = i & 63;
        const float inv = __builtin_exp2f(-(float)k * (13.287712379549449f / 64.f));
        const double ang = (double)((float)pos * inv);
        double rev = ang * 0.15915494309189535; rev -= __builtin_rint(rev);
        f32x2 cs; cs.x = __builtin_amdgcn_cosf((float)rev); cs.y = __builtin_amdgcn_sinf((float)rev);
        ((f32x2*)w_rope)[i] = cs;
    }
    for (int i = gtid; i < 4 * M; i += NGT) w_ssq[M + i] = 0.f;
    for (int i = gtid; i < 2 * SD_LAYER; i += NGT) w_SIDE[i] = 0.f;
    for (int i = gtid; i < 4096; i += NGT) ((unsigned*)(ws + WS_BAR))[i] = 0u;
    for (int i = gtid; i < 8192; i += NGT) ((unsigned*)(ws + WS_CNT))[i] = 0u;
    {
        const float* g0 = a.in[1];
        const f32x4* gr = (const f32x4*)g0 + lane;
        for (int m = gw; m < M; m += 4 * NGW) {
            f32x4 v[4][4];
#pragma unroll
            for (int u = 0; u < 4; ++u) { const f32x4* xr = (const f32x4*)(x + (size_t)(m + u * NGW) * D) + lane;
#pragma unroll
                for (int j = 0; j < 4; ++j) v[u][j] = xr[64 * j]; }
            __builtin_amdgcn_sched_barrier(0);
#pragma unroll
            for (int u = 0; u < 4; ++u) {
                float s = 0.f;
#pragma unroll
                for (int j = 0; j < 4; ++j) s += (v[u][j][0] * v[u][j][0] + v[u][j][1] * v[u][j][1]) + (v[u][j][2] * v[u][j][2] + v[u][j][3] * v[u][j][3]);
                s = wave_sum(s);
                if (lane == 0) w_ssq[m + u * NGW] = s;
                u32x2* o8 = (u32x2*)(w_XN + (size_t)(m + u * NGW) * D) + lane;
#pragma unroll
                for (int j = 0; j < 4; ++j) { const f32x4 w = v[u][j] * gr[64 * j]; u32x2 o; o.x = pk_bf16(w[0], w[1]); o.y = pk_bf16(w[2], w[3]); o8[64 * j] = o; }
            }
        }
    }
    }
    grid.sync(); STAMP(0);
    const XcdBarrier xbar = xcd_barrier_post((unsigned*)(ws + WS_BAR), (volatile LAS unsigned*)(lds + 131072));

#pragma unroll 1
    for (int l = 0; l < 2; ++l) {
        const float* bgate = a.in[3] + (size_t)l * 2048;
        float* SP = w_SIDE + (size_t)l * SD_LAYER + SD_SP; float* YB = w_SIDE + (size_t)l * SD_LAYER + SD_YB; float* MO = w_SIDE + (size_t)l * SD_LAYER + SD_MO;
        float* UU = w_SIDE + (size_t)l * SD_LAYER + SD_UU; float* DD = w_SIDE + (size_t)l * SD_LAYER + SD_DD;
        {
            side::prep_norm(lds, (l == 0) ? x : w_XS, (l == 0) ? (size_t)SEQ * D : (size_t)D, nullptr, a.in[1] + (size_t)l * D, false, nullptr, nullptr, nullptr, nullptr);
            const float* w_in = a.in[2] + (size_t)l * D * IN_COLS;
            for (int it = bx; it < 320; it += G) side::gemv_item(lds, w_in, IN_COLS, (it & 3) * 256, 1536 + (it >> 2) * 64, SP, IN_COLS);
        }
        {
            pg8::Gemm g{w_XN, w_win, D, D, M, IN_COLS, D}; pg8::StaticOrder S; S.init(M, IN_COLS, G, bx);
            Epi<1> E; E.p = EpiP{}; E.p.ssq = w_ssq + (size_t)(2 * l) * M; E.p.PA = w_PA; E.p.PB = w_PB; E.p.rope = w_rope;
            pg8::gemm_phase(lds, g, S, E);
        }
        xcd_barrier(xbar); STAMP(l * 8 + 1);
        if (bx < 64) {
            {
                PHASE_IDS();
                const int r = wave, hh = lane >> 4, sub = lane & 15;
                const float* sp = SP + (size_t)r * IN_COLS;
                float dq = 0.f;
#pragma unroll
                for (int j = 0; j < 8; ++j) dq += sp[1536 + hh * 128 + sub * 8 + j] * sp[2048 + hh * 128 + sub * 8 + j];
#pragma unroll
                for (int o = 1; o < 16; o <<= 1) dq += shx(dq, o);
                const float w0 = dq * 0.08838834764831845f;
                float ov[16]; float s = 0.f;
#pragma unroll
                for (int j = 0; j < 16; ++j) { ov[j] = w0 * sp[2560 + hh * 256 + sub * 16 + j]; s += ov[j]; }
#pragma unroll
                for (int o = 1; o < 16; o <<= 1) s += shx(s, o);
                const float mu = s * (1.f / 256.f); float q = 0.f;
#pragma unroll
                for (int j = 0; j < 16; ++j) { ov[j] -= mu; q += ov[j] * ov[j]; }
#pragma unroll
                for (int o = 1; o < 16; o <<= 1) q += shx(q, o);
                const float rstd = 1.f / sqrtf(q * (1.f / 256.f) + EPS);
                const float* rn = a.in[5] + (size_t)l * D;
                LAS float* A = (LAS float*)lds;
#pragma unroll
                for (int j = 0; j < 16; ++j) { const int e = hh * 256 + sub * 16 + j; A[e * 8 + r] = ov[j] * rstd * rn[e] * side::silu_(sp[3584 + e]); }
                __syncthreads();
            }
            const float* rw = a.in[6] + (size_t)l * D * D;
            for (int it = bx; it < 64; it += G) side::gemv_item(lds, rw, D, (it & 3) * 256, (it >> 2) * 64, YB, D);
        }
        for (int j = vcu; j < 256; j += G) ret::item(j >> 5, (j >> 3) & 3, j & 7, w_PA, (LAS char*)lds);
        STAMP(20 + l);
        for (int j = vcu; j < 256; j += G) {
            const int bh = j >> 2, s = j & 3;
            sb::unit(bh >> 3, bh & 7, 15 - s, w_PA, (LAS char*)lds);
            sb::unit(bh >> 3, bh & 7, 8 + s, w_PA, (LAS char*)lds);
            sb::unit(bh >> 3, bh & 7, 7 - s, w_PA, (LAS char*)lds);
            sb::unit(bh >> 3, bh & 7, s, w_PA, (LAS char*)lds);
        }
        xcd_barrier(xbar); STAMP(l * 8 + 2);
        if (bx < 64) {
            {
                PHASE_IDS();
                LAS float* A = (LAS float*)lds;
#pragma unroll 8
                for (int i = tid; i < 8 * D; i += 512) { const int r = i >> 10, k = i & 1023; A[k * 8 + r] = side::sigm_(SP[(size_t)r * IN_COLS + 5632 + k] + bgate[1024 + k]) * YB[r * D + k]; }
                __syncthreads();
            }
            const float* w_o = a.in[7] + (size_t)l * D * D;
            for (int it = bx; it < 64; it += G) side::gemv_item(lds, w_o, D, (it & 3) * 256, (it >> 2) * 64, MO, D);
        }
        {
            PHASE_IDS();
            const float* rg = a.in[5] + (size_t)l * D;
            auto norm_row = [&](bf16_t* op, const u32x4 o0, const u32x4 o1, const u32x4 g0, const u32x4 g1) {
                float v[16], gv[16];
                v[0] = bf_lo(o0.x); v[1] = bf_hi(o0.x); v[2] = bf_lo(o0.y); v[3] = bf_hi(o0.y); v[4] = bf_lo(o0.z); v[5] = bf_hi(o0.z); v[6] = bf_lo(o0.w); v[7] = bf_hi(o0.w);
                v[8] = bf_lo(o1.x); v[9] = bf_hi(o1.x); v[10] = bf_lo(o1.y); v[11] = bf_hi(o1.y); v[12] = bf_lo(o1.z); v[13] = bf_hi(o1.z); v[14] = bf_lo(o1.w); v[15] = bf_hi(o1.w);
                gv[0] = bf_lo(g0.x); gv[1] = bf_hi(g0.x); gv[2] = bf_lo(g0.y); gv[3] = bf_hi(g0.y); gv[4] = bf_lo(g0.z); gv[5] = bf_hi(g0.z); gv[6] = bf_lo(g0.w); gv[7] = bf_hi(g0.w);
                gv[8] = bf_lo(g1.x); gv[9] = bf_hi(g1.x); gv[10] = bf_lo(g1.y); gv[11] = bf_hi(g1.y); gv[12] = bf_lo(g1.z); gv[13] = bf_hi(g1.z); gv[14] = bf_lo(g1.w); gv[15] = bf_hi(g1.w);
                float s = 0.f;
#pragma unroll
                for (int k = 0; k < 16; ++k) s += v[k];
#pragma unroll
                for (int o = 1; o < 16; o <<= 1) s += shx(s, o);
                const float mu = s * (1.f / 256.f); float q = 0.f;
#pragma unroll
                for (int k = 0; k < 16; ++k) { v[k] -= mu; q += v[k] * v[k]; }
#pragma unroll
                for (int o = 1; o < 16; o <<= 1) q += shx(q, o);
                const float rstd = __builtin_amdgcn_rsqf(q * (1.f / 256.f) + EPS);
                const f32x4* rgp = (const f32x4*)(rg + 16 * lane);
                unsigned w[8];
#pragma unroll
                for (int k4 = 0; k4 < 4; ++k4) { const f32x4 gg = rgp[k4];
                    float y[4];
#pragma unroll
                    for (int k = 0; k < 4; ++k) { const float gx = gv[4 * k4 + k]; y[k] = v[4 * k4 + k] * rstd * gg[k] * gx * sigmoidf_(gx); }
                    w[2 * k4] = pk_bf16(y[0], y[1]); w[2 * k4 + 1] = pk_bf16(y[2], y[3]); }
                *(u32x4*)op = (u32x4){w[0], w[1], w[2], w[3]}; *(u32x4*)(op + 8) = (u32x4){w[4], w[5], w[6], w[7]};
            };
            for (int m = gw; m < M; m += 4 * NGW) {
                u32x4 o0[4], o1[4], g0[4], g1[4];
#pragma unroll
                for (int u = 0; u < 4; ++u) { const int mm = m + u * NGW; const bf16_t* op = w_PA + (size_t)mm * PA_LD + 2560 + 16 * lane; const bf16_t* gp = w_PB + (size_t)mm * PB_LD + 16 * lane;
                    o0[u] = *(const u32x4*)op; o1[u] = *(const u32x4*)(op + 8); g0[u] = *(const u32x4*)gp; g1[u] = *(const u32x4*)(gp + 8); }
                __builtin_amdgcn_sched_barrier(0);
#pragma unroll
                for (int u = 0; u < 4; ++u) norm_row(w_PA + (size_t)(m + u * NGW) * PA_LD + 2560 + 16 * lane, o0[u], o1[u], g0[u], g1[u]);
            }
            __syncthreads();
            pg8::Gemm g{w_PA, w_wcat, PA_LD, 1536, M, D, 512}; pg8::StaticOrder S; S.init(M, D, G, bx);
            Epi<2> E; E.p = EpiP{}; E.p.PA = w_PA; E.p.PB = w_PB; E.p.bgate = bgate;
            pg8::gemm_phase(lds, g, S, E);
        }
        xcd_barrier(xbar); STAMP(l * 8 + 3);
        {
            pg8::Gemm g{w_PA + 2560, w_wcat + 512, PA_LD, 1536, M, D, D}; pg8::StaticOrder S; S.init(M, D, G, bx);
            Epi<3> E; E.p = EpiP{}; E.p.PA = w_PA; E.p.PB = w_PB; E.p.bgate = bgate;
            pg8::gemm_phase(lds, g, S, E);
        }
        xcd_barrier(xbar); STAMP(l * 8 + 4);
        {
            side::prep_norm(lds, (l == 0) ? x : w_XS, (l == 0) ? (size_t)SEQ * D : (size_t)D, MO, a.in[8] + (size_t)l * D, bx == 0, out, w_XN, w_ssq + (size_t)(2 * l + 1) * M, nullptr);
            const float* w_up = a.in[9] + (size_t)l * D * U_LD;
            for (int it = bx; it < 352; it += G) side::gemv_item(lds, w_up, U_LD, (it & 3) * 256, (it >> 2) * 64, UU, U_LD);
        }
        {
            PHASE_IDS();
            convert_ffn(a, l, lds, gw, NGW, wave, lane);
            __syncthreads();
            pg8::Gemm g{w_PA + 1536, w_wo, PA_LD, D, M, D, D}; pg8::StaticOrder S; S.init(M, D, G, bx);
            Epi<4> E; E.p = EpiP{}; E.p.xin = (l == 0) ? x : out; E.p.xout = out; E.p.XN = w_XN; E.p.gnext = a.in[8] + (size_t)l * D; E.p.ssq_out = w_ssq + (size_t)(2 * l + 1) * M; E.p.wxn = 1;
            pg8::gemm_phase(lds, g, S, E);
        }
        xcd_barrier(xbar); STAMP(l * 8 + 5);
        const int b5 = (G > 176) ? bx - 176 : bx, nb5 = (G > 176) ? G - 176 : G;
        if (b5 >= 0) {
            {
                PHASE_IDS();
                const float* cw2 = a.in[10] + (size_t)l * 3 * FF + 2 * FF; const float* cbb = a.in[11] + (size_t)l * FF;
                LAS float* A = (LAS float*)lds;
#pragma unroll 11
                for (int i = tid; i < 8 * FF; i += 512) { const int r = i / FF, k = i - r * FF; A[k * 8 + r] = side::silu_(cw2[k] * UU[r * U_LD + k] + cbb[k]) * UU[r * U_LD + FF + k]; }
                __syncthreads();
            }
            const float* w_dn = a.in[12] + (size_t)l * FF * D;
            for (int it = b5; it < 176; it += nb5) side::gemv_item(lds, w_dn, D, (it / 16) * 256, (it & 15) * 64, DD, D);
        }
        {
            PHASE_IDS();
            if (l == 0) { convert_mixer(a, 1, lds, gw, NGW, wave, lane); __syncthreads(); }
            pg8::Gemm g{w_XN, w_wup, D, D, M, U_LD, D}; pg8::StaticOrder S; S.init(M, U_LD, G, bx, true);
            Epi<6> E; E.p = EpiP{}; E.p.ssq = w_ssq + (size_t)(2 * l + 1) * M; E.p.H = w_U; E.p.cw = a.in[10] + (size_t)l * 3 * FF; E.p.cb = a.in[11] + (size_t)l * FF;
            E.p.xch = (LAS float*)(lds + 131072 + 1024);
            pg8::gemm_phase(lds, g, S, E);
        }
        xcd_barrier(xbar); STAMP(l * 8 + 6); STAMP(l * 8 + 7);
        if (bx == 0)
            side::prep_norm(lds, out, (size_t)SEQ * D, DD, (l == 0) ? a.in[1] + D : a.in[13], true, out, w_XN, w_ssq + (size_t)(2 * l + 2) * M, w_XS, l == 1);
        if (l == 0) {
            pg8::Gemm g{w_U, w_wdn, FF, FF, M, D, FF}; pg8::StaticOrder S; S.init(M, D, G, bx);
            Epi<4> E; E.p = EpiP{}; E.p.xin = out; E.p.xout = out; E.p.XN = w_XN; E.p.gnext = a.in[1] + D; E.p.ssq_out = w_ssq + (size_t)2 * M; E.p.wxn = 1;
            pg8::gemm_phase(lds, g, S, E);
            xcd_barrier(xbar); STAMP(8);
        } else {
            pg8::Gemm g{w_U, w_wdn, FF, FF, M, D, FF}; pg8::StaticOrder S; S.init(M, D, G, bx);
            Epi<7> E; E.p = EpiP{}; E.p.xin = out; E.p.xout = out; E.p.gnext = a.in[13]; E.p.ssq_out = w_ssq + (size_t)4 * M; E.p.cnt = (unsigned*)(ws + WS_CNT);
            pg8::gemm_phase(lds, g, S, E);
            STAMP(16);
        }
    }
#ifdef DIAG
    xcd_barrier(xbar);
#endif
    STAMP(31);
#ifdef DIAG
    __syncthreads();
    if (bx == 0 && threadIdx.x == 0) {
        asm volatile("s_waitcnt vmcnt(0)" ::: "memory");
        const float tA = (float)(ts_[DIAG_A1] - ts_[DIAG_A0]) * 0.01f, tB = (float)(ts_[DIAG_B1] - ts_[DIAG_B0]) * 0.01f;
        out[3 * 1024 + 7] += tA * 1e-3f;
        for (int i = 0; i < 2048; ++i) out[1024 + i] += tB * 1e-4f;
    }
#endif
}

#undef ws
#undef w_ssq
#undef w_rope
#undef w_win
#undef w_wcat
#undef w_wo
#undef w_XN
#undef w_PA
#undef w_PB
#undef w_U
#undef w_wup
#undef w_wdn
#undef w_SIDE
#undef w_XS
constexpr int LDS_BYTES = 131072 + 1024 + 4096;
static_assert(ret::LDS_BYTES <= 131072 && sb::LDS_BYTES <= 131072 && pg8::STAGE_BYTES <= 131072, "LDS map");

extern "C" void kernel_launch(void* const* d_in, const int* in_sizes, int n_in, void* d_out, int out_size, void* d_ws, size_t ws_size, hipStream_t stream) {
    static int grid = 0;
    if (grid == 0) {
        int dev = 0, cus = 0, per_cu = 0;
        hipGetDevice(&dev);
        hipDeviceGetAttribute(&cus, hipDeviceAttributeMultiprocessorCount, dev);
        hipFuncSetAttribute((const void*)fwd_kernel, hipFuncAttributeMaxDynamicSharedMemorySize, LDS_BYTES);
        hipOccupancyMaxActiveBlocksPerMultiprocessor(&per_cu, (const void*)fwd_kernel, 512, LDS_BYTES);
        (void)hipGetLastError();
        if (per_cu < 1) per_cu = 1;
        if (cus < 1) cus = 256;
        grid = cus;
        if (ws_size < WS_END) fprintf(stderr, "kernel_launch: workspace too small: %zu < %zu\n", ws_size, (size_t)WS_END);
    }
    Args a{};
    for (int i = 0; i < 14; ++i) a.in[i] = (const float*)d_in[i];
    a.out = (float*)d_out; a.ws = (unsigned char*)d_ws;
    void* args[] = {&a};
    hipError_t e = hipLaunchCooperativeKernel((const void*)fwd_kernel, dim3(grid), dim3(512), args, LDS_BYTES, stream);
    if (e != hipSuccess) fprintf(stderr, "cooperative launch failed: %s (grid %d)\n", hipGetErrorString(e), grid);
}
```
